# Optimizing an MI355X kernel written in HIP

```python
import math, functools
import jax, jax.numpy as jnp
from jax import lax
import numpy as np

D_MODEL = 1024
BATCH = 8
SEQ = 2048
DEPTH = 1
DEC_BATCH = 16
DEC_SEQ = 64
PAST_LEN = 2048

CHUNK = 64
A_HEADS = 8
A_HEAD_DIM = 64
A_PAST_CHUNKS = 8
A_BAND = A_PAST_CHUNKS * CHUNK
A_REL_CLIP = 128
B_HEADS = 8
B_HEAD_DIM = 64
Q_BLOCK = 128
D_FF = 2816
CONV_W = 3
EPS = 1e-6
A_WIDTH = A_HEADS * A_HEAD_DIM
B_WIDTH = B_HEADS * B_HEAD_DIM
IN_SIZES = [A_WIDTH, A_WIDTH, A_WIDTH, B_WIDTH, B_WIDTH, B_WIDTH, B_HEADS, D_MODEL, D_MODEL]
IN_COLS = sum(IN_SIZES)
IN_SPLITS = [int(o) for o in np.cumsum(IN_SIZES)[:-1]]

kernel_name = 'streaming_band_fox_hybrid_step'


def rmsnorm(x, g):
    xf = x.astype(jnp.float32)
    y = xf * lax.rsqrt(jnp.mean(xf * xf, axis=-1, keepdims=True) + EPS) * g.astype(jnp.float32)
    return y.astype(x.dtype)


def split_in_proj(z, b_f):
    lead = z.shape[:-1]
    parts = jnp.split(z, IN_SPLITS, axis=-1)
    q_a, k_a, v_a = [p.reshape(lead + (A_HEADS, A_HEAD_DIM)) for p in parts[0:3]]
    q_b, k_b, v_b = [p.reshape(lead + (B_HEADS, B_HEAD_DIM)) for p in parts[3:6]]
    log_f = jax.nn.log_sigmoid((parts[6] + b_f).astype(jnp.float32))
    return q_a, k_a, v_a, q_b, k_b, v_b, log_f, parts[7], parts[8]


def rel_bias(rel_table, dist):
    idx = jnp.clip(dist, -A_REL_CLIP, A_REL_CLIP) + A_REL_CLIP
    return rel_table[:, idx].astype(jnp.float32)


def band_attn_prompt(q, k, v, rel_table):
    b, s, h, d = q.shape
    nc = s // CHUNK
    band = (A_PAST_CHUNKS + 1) * CHUNK
    pad = jnp.zeros((b, A_BAND, h, d), k.dtype)
    kp = jnp.concatenate([pad, k], axis=1).reshape(b, nc + A_PAST_CHUNKS, CHUNK, h, d)
    vp = jnp.concatenate([pad.astype(v.dtype), v], axis=1).reshape(b, nc + A_PAST_CHUNKS, CHUNK, h, d)
    kb = jnp.concatenate([kp[:, j:j + nc] for j in range(A_PAST_CHUNKS + 1)], axis=2)
    vb = jnp.concatenate([vp[:, j:j + nc] for j in range(A_PAST_CHUNKS + 1)], axis=2)
    qc = q.reshape(b, nc, CHUNK, h, d)
    scores = jnp.einsum('bcqhd,bckhd->bhcqk', qc, kb).astype(jnp.float32) * (d ** -0.5)
    koff = jnp.arange(band) - A_BAND
    dist = jnp.arange(CHUNK)[:, None] - koff[None, :]
    bias = rel_bias(rel_table, dist)
    kpos = jnp.arange(nc)[:, None] * CHUNK + koff[None, :]
    scores = jnp.where((kpos >= 0)[None, None, :, None, :], scores + bias[None, :, None], -jnp.inf)
    p = jax.nn.softmax(scores, axis=-1)
    out = jnp.einsum('bhcqk,bckhd->bcqhd', p.astype(v.dtype), vb)
    return out.reshape(b, s, h * d)


def band_attn_sample(q, k, v, k_cache, v_cache, rel_table):
    b, t, h, d = q.shape
    L = k_cache.shape[1]
    kk = jnp.concatenate([k_cache.astype(k.dtype), k], axis=1)
    vv = jnp.concatenate([v_cache.astype(v.dtype), v], axis=1)
    scores = jnp.einsum('bqhd,bkhd->bhqk', q, kk).astype(jnp.float32) * (d ** -0.5)
    kpos = jnp.concatenate([jnp.arange(-L, 0), jnp.arange(t)])
    dist = jnp.arange(t)[:, None] - kpos[None, :]
    p = jax.nn.softmax(scores + rel_bias(rel_table, dist)[None], axis=-1)
    out = jnp.einsum('bhqk,bkhd->bqhd', p.astype(v.dtype), vv)
    return out.reshape(b, t, h * d)


def forget_attn_prompt(q, k, v, log_f):
    b, s, h, d = q.shape
    nb = s // Q_BLOCK
    c = jnp.cumsum(log_f, axis=1).transpose(0, 2, 1)
    qb = q.reshape(b, nb, Q_BLOCK, h, d).transpose(1, 0, 2, 3, 4)
    cb = c.reshape(b, h, nb, Q_BLOCK).transpose(2, 0, 1, 3)
    kpos = jnp.arange(s)

    def one_block(args):
        qi, ci, i = args
        sc = jnp.einsum('bqhd,bkhd->bhqk', qi, k).astype(jnp.float32) * (d ** -0.5)
        sc = sc + ci[..., None] - c[:, :, None, :]
        qpos = i * Q_BLOCK + jnp.arange(Q_BLOCK)
        sc = jnp.where((kpos[None, :] <= qpos[:, None])[None, None], sc, -jnp.inf)
        p = jax.nn.softmax(sc, axis=-1)
        return jnp.einsum('bhqk,bkhd->bqhd', p.astype(v.dtype), v)

    out = lax.map(one_block, (qb, cb, jnp.arange(nb)))
    return out.transpose(1, 0, 2, 3, 4).reshape(b, s, h * d)


def forget_attn_sample(q, k, v, log_f, k_cache, v_cache, logf_cache):
    b, t, h, d = q.shape
    L = k_cache.shape[1]
    kk = jnp.concatenate([k_cache.astype(k.dtype), k], axis=1)
    vv = jnp.concatenate([v_cache.astype(v.dtype), v], axis=1)
    c = jnp.cumsum(jnp.concatenate([logf_cache.astype(jnp.float32), log_f], axis=1), axis=1).transpose(0, 2, 1)
    sc = jnp.einsum('bqhd,bkhd->bhqk', q, kk).astype(jnp.float32) * (d ** -0.5)
    sc = sc + c[:, :, L:, None] - c[:, :, None, :]
    kpos = jnp.arange(L + t)
    qpos = L + jnp.arange(t)
    sc = jnp.where((kpos[None, :] <= qpos[:, None])[None, None], sc, -jnp.inf)
    p = jax.nn.softmax(sc, axis=-1)
    out = jnp.einsum('bhqk,bkhd->bqhd', p.astype(v.dtype), vv)
    return out.reshape(b, t, h * d)


def conv_ffn(h, buf, w_up, conv_w, conv_b, w_down):
    t = h.shape[1]
    u = h @ w_up
    ext = jnp.concatenate([buf.astype(u.dtype), u], axis=1)
    y = conv_b
    for j in range(CONV_W):
        y = y + ext[:, j:j + t] * conv_w[j]
    gate, val = jnp.split(y, 2, axis=-1)
    return (jax.nn.gelu(gate) * val) @ w_down, ext[:, -(CONV_W - 1):]


def layer(x, attn_a, attn_b, conv_buf, g_pre_mix, g_post_mix, g_pre_ffn, g_post_ffn,
          w_in, b_f, w_proj_a, w_proj_b, w_out, w_up, conv_w, conv_b, w_down):
    h = rmsnorm(x, g_pre_mix)
    q_a, k_a, v_a, q_b, k_b, v_b, log_f, g_a, g_b = split_in_proj(h @ w_in, b_f)
    o_a = attn_a(q_a, k_a, v_a)
    o_b = attn_b(q_b, k_b, v_b, log_f)
    merged = jax.nn.sigmoid(g_a) * (o_a @ w_proj_a) + jax.nn.sigmoid(g_b) * (o_b @ w_proj_b)
    x = x + rmsnorm(merged @ w_out, g_post_mix)
    f, new_buf = conv_ffn(rmsnorm(x, g_pre_ffn), conv_buf, w_up, conv_w, conv_b, w_down)
    x = x + rmsnorm(f, g_post_ffn)
    return x, (k_a, v_a, k_b, v_b, log_f, new_buf)


def setup_inputs(seed: int = 0) -> dict:
    key = jax.random.key(seed)
    ks = jax.random.split(key, 24)
    nrm = jax.random.normal
    a_len = min(A_BAND, PAST_LEN)
    f32 = jnp.float32
    return {
        'x_prompt': nrm(ks[0], (BATCH, SEQ, D_MODEL), f32),
        'x_sample': nrm(ks[1], (DEC_BATCH, DEC_SEQ, D_MODEL), f32),
        'cache_k_a': nrm(ks[2], (DEPTH, DEC_BATCH, a_len, A_HEADS, A_HEAD_DIM), f32),
        'cache_v_a': nrm(ks[3], (DEPTH, DEC_BATCH, a_len, A_HEADS, A_HEAD_DIM), f32),
        'cache_k_b': nrm(ks[4], (DEPTH, DEC_BATCH, PAST_LEN, B_HEADS, B_HEAD_DIM), f32),
        'cache_v_b': nrm(ks[5], (DEPTH, DEC_BATCH, PAST_LEN, B_HEADS, B_HEAD_DIM), f32),
        'cache_logf_b': jax.nn.log_sigmoid(2.0 + nrm(ks[6], (DEPTH, DEC_BATCH, PAST_LEN, B_HEADS), f32)),
        'state_conv_ffn': nrm(ks[7], (DEPTH, DEC_BATCH, CONV_W - 1, 2 * D_FF), f32),
        'g_pre_mix': 1.0 + 0.05 * nrm(ks[8], (DEPTH, D_MODEL), f32),
        'g_post_mix': 1.0 + 0.05 * nrm(ks[9], (DEPTH, D_MODEL), f32),
        'g_pre_ffn': 1.0 + 0.05 * nrm(ks[10], (DEPTH, D_MODEL), f32),
        'g_post_ffn': 1.0 + 0.05 * nrm(ks[11], (DEPTH, D_MODEL), f32),
        'w_in': nrm(ks[12], (DEPTH, D_MODEL, IN_COLS), f32) * D_MODEL ** -0.5,
        'b_f': 2.0 + 0.5 * nrm(ks[13], (DEPTH, B_HEADS), f32),
        'rel_table': 0.5 * nrm(ks[14], (DEPTH, A_HEADS, 2 * A_REL_CLIP + 1), f32),
        'w_proj_a': nrm(ks[15], (DEPTH, A_WIDTH, D_MODEL), f32) * A_WIDTH ** -0.5,
        'w_proj_b': nrm(ks[16], (DEPTH, B_WIDTH, D_MODEL), f32) * B_WIDTH ** -0.5,
        'w_out': nrm(ks[17], (DEPTH, D_MODEL, D_MODEL), f32) * D_MODEL ** -0.5,
        'w_up': nrm(ks[18], (DEPTH, D_MODEL, 2 * D_FF), f32) * D_MODEL ** -0.5,
        'conv_w': nrm(ks[19], (DEPTH, CONV_W, 2 * D_FF), f32) * CONV_W ** -0.5,
        'conv_b': 0.02 * nrm(ks[20], (DEPTH, 2 * D_FF), f32),
        'w_down': nrm(ks[21], (DEPTH, D_FF, D_MODEL), f32) * D_FF ** -0.5,
    }


def reference(x_prompt, x_sample, cache_k_a, cache_v_a, cache_k_b, cache_v_b, cache_logf_b,
              state_conv_ffn, g_pre_mix, g_post_mix, g_pre_ffn, g_post_ffn, w_in, b_f, rel_table,
              w_proj_a, w_proj_b, w_out, w_up, conv_w, conv_b, w_down):
    x_p, x_s = x_prompt, x_sample
    p_states, s_states = [], []
    for l in range(DEPTH):
        w = (g_pre_mix[l], g_post_mix[l], g_pre_ffn[l], g_post_ffn[l], w_in[l], b_f[l],
             w_proj_a[l], w_proj_b[l], w_out[l], w_up[l], conv_w[l], conv_b[l], w_down[l])
        buf0 = jnp.zeros((x_p.shape[0], CONV_W - 1, 2 * D_FF), x_p.dtype)
        x_p, (ka, va, kb, vb, lf, cv) = layer(
            x_p, functools.partial(band_attn_prompt, rel_table=rel_table[l]),
            forget_attn_prompt, buf0, *w)
        keep = min(A_BAND, x_p.shape[1])
        p_states.append((ka[:, -keep:], va[:, -keep:], kb, vb, lf, cv))
        x_s, st = layer(
            x_s,
            functools.partial(band_attn_sample, k_cache=cache_k_a[l], v_cache=cache_v_a[l],
                              rel_table=rel_table[l]),
            functools.partial(forget_attn_sample, k_cache=cache_k_b[l], v_cache=cache_v_b[l],
                              logf_cache=cache_logf_b[l]),
            state_conv_ffn[l], *w)
        s_states.append(st)
    ka_p, va_p, kb_p, vb_p, lf_p, cv_p = [jnp.stack(s) for s in zip(*p_states)]
    ka_s, va_s, kb_s, vb_s, lf_s, cv_s = [jnp.stack(s) for s in zip(*s_states)]
    return (x_p, x_s, ka_p, va_p, kb_p, vb_p, lf_p, cv_p, ka_s, va_s, kb_s, vb_s, lf_s, cv_s)
```

```cpp
#include <hip/hip_runtime.h>
#include <hip/hip_cooperative_groups.h>
#include <cstdio>
#include <cstdint>
namespace cg = cooperative_groups;
namespace pg8 {
#define PG8_LAS __attribute__((address_space(3)))
typedef unsigned short bf16_t;
typedef short bf16x8 __attribute__((ext_vector_type(8)));
typedef float f32x4 __attribute__((ext_vector_type(4)));
typedef unsigned u32x4 __attribute__((ext_vector_type(4)));
constexpr int BM = 256, BK = 64, HALF = 128, HTB = HALF * BK * 2  , STAGE_BYTES = 8 * HTB, NXCD = 8, WGM = 8;

__host__ __device__ __forceinline__ int lds_byte(int r, int c) { const int st = (r >> 4) * 2 + (c >> 5), rr = r & 15, cc = c & 31, ob = rr * 64 + cc * 2; return st * 1024 + (ob ^ (((ob >> 9) & 1) << 5)); }
__host__ __device__ __forceinline__ void stage_rc(int b, int& R, int& C) { const int st = b / 1024, sb = b % 1024, swz = sb ^ (((sb >> 9) & 1) << 5); R = (st >> 1) * 16 + swz / 64; C = (st & 1) * 32 + (swz % 64) / 2; }
__host__ __device__ __forceinline__ int perm32(int rho) { const int n = rho >> 4, i = rho & 15; return 8 * (i >> 2) + 4 * n + (i & 3); }

struct Unit { int pm, pn; };
struct Gemm { const bf16_t* A; const bf16_t* Bt; int M, N, K; };

struct StaticOrder {
    int nM, nN, nwg, G, c;
    __host__ __device__ void init(int M, int N, int G_, int c_) { nM = M / BM; nN = N / BM; nwg = nM * nN; G = G_; c = c_; }
    __host__ __device__ __forceinline__ bool next(int i, Unit& u) const {
        const long L = (long)i * G + c; if (L >= nwg) return false;
        int wgid = (int)L; { const int q = nwg / NXCD, r = nwg % NXCD, xcd = wgid % NXCD, off = wgid / NXCD; wgid = (xcd < r ? xcd * (q + 1) : r * (q + 1) + (xcd - r) * q) + off; }
        const int nig = WGM * nN, gid = wgid / nig, fm = gid * WGM, gsz = (nM - fm) < WGM ? (nM - fm) : WGM;
        u.pm = fm + ((wgid % nig) % gsz); u.pn = (wgid % nig) / gsz; return true;
    }
    __device__ __forceinline__ void a_ready(const Unit&) const {}
    __device__ __forceinline__ void done(const Unit&) const {}
};

__device__ __forceinline__ unsigned cvt_pk_bf16(float lo, float hi) { unsigned r; asm volatile("v_cvt_pk_bf16_f32 %0, %1, %2" : "=v"(r) : "v"(lo), "v"(hi)); return r; }
typedef float f32x2 __attribute__((ext_vector_type(2)));
template <class Epi, class Sched, bool ALIGN_EPI = false, bool SP2 = false>
__device__ __forceinline__ void gemm_phase(PG8_LAS unsigned char* lds, const Gemm g, const Sched& S, const Epi& E, const int wv) {
    const int wid = wv, lane = (int)__builtin_amdgcn_mbcnt_hi(~0u, __builtin_amdgcn_mbcnt_lo(~0u, 0u)), tid = wid * 64 + lane, wr = wid >> 2, wc = wid & 3, fr = lane & 15, fq = lane >> 4;
    const int K = g.K, nt = K / BK;
    unsigned voffA[2], voffB[2];
#pragma unroll
    for (int i = 0; i < 2; ++i) { int R, C; stage_rc(tid * 16 + i * 8192, R, C); const int Rb = Epi::PERM ? ((R & ~31) + perm32(R & 31)) : R;
        voffA[i] = (unsigned)(R * K + C) * 2u; voffB[i] = (unsigned)(Rb * K + C) * 2u; }
    const size_t kstep = (size_t)(BK * 2);
    const size_t hstep = (size_t)HALF * K * 2;
    const size_t tstep = 2 * hstep;
    const unsigned ldsw = (unsigned)wid * 1024u;
    const int aoff = lds_byte(wr * 64 + fr, fq * 8), boff = lds_byte(wc * 32 + fr, fq * 8);
#define PG8_SA(b, h) (((b) * 2 + (h)) * HTB)
#define PG8_SB(b, h) ((4 + (b) * 2 + (h)) * HTB)
#define PG8_STAGE(bufoff, gbase, voff) do { _Pragma("unroll") for (int _i = 0; _i < 2; ++_i) \
        __builtin_amdgcn_global_load_lds((const unsigned*)((const char*)(gbase) + (voff)[_i]), (PG8_LAS unsigned*)(lds + (bufoff) + ldsw + _i * 8192), 16, 0, 0); } while (0)
#define PG8_LDA(dst, b, h) do { _Pragma("unroll") for (int m = 0; m < 4; ++m) _Pragma("unroll") for (int k = 0; k < 2; ++k) dst[m][k] = *(const PG8_LAS bf16x8*)(lds + PG8_SA(b, h) + aoff + m * 2048 + k * 1024); } while (0)
#define PG8_LDB(dst, b, h) do { _Pragma("unroll") for (int n = 0; n < 2; ++n) _Pragma("unroll") for (int k = 0; k < 2; ++k) dst[n][k] = *(const PG8_LAS bf16x8*)(lds + PG8_SB(b, h) + boff + n * 2048 + k * 1024); } while (0)
#define PG8_MMA(ai, bj, At, Bt) do { __builtin_amdgcn_s_setprio(1); _Pragma("unroll") for (int m = 0; m < 4; ++m) _Pragma("unroll") for (int n = 0; n < 2; ++n) _Pragma("unroll") for (int k = 0; k < 2; ++k) \
        acc[ai][bj][m][n] = __builtin_amdgcn_mfma_f32_16x16x32_bf16(Bt[n][k], At[m][k], acc[ai][bj][m][n], 0, 0, 0); __builtin_amdgcn_s_setprio(0); } while (0)
#define PG8_WAIT_V(n) asm volatile("s_waitcnt vmcnt(" #n ")" ::: "memory")
#define PG8_WAIT_L(n) asm volatile("s_waitcnt lgkmcnt(" #n ")" ::: "memory")
#define PG8_BAR __builtin_amdgcn_s_barrier()
#define PG8_SCHED __builtin_amdgcn_sched_barrier(0)
    Unit cur, nxt; int ui = 0;
    if (!S.next(0, cur)) return;
    f32x4 acc[2][2][4][2];
#pragma unroll
    for (int a = 0; a < 2; ++a)
#pragma unroll
        for (int b = 0; b < 2; ++b)
#pragma unroll
            for (int m = 0; m < 4; ++m)
#pragma unroll
                for (int n = 0; n < 2; ++n) acc[a][b][m][n] = (f32x4){0.f, 0.f, 0.f, 0.f};
    bf16x8 At[4][2], B0[2][2], B1[2][2];
    const char* cA = (const char*)g.A + (size_t)cur.pm * tstep; const char* cB = (const char*)g.Bt + (size_t)cur.pn * tstep;
    S.a_ready(cur);
    if constexpr (SP2) {
        PG8_STAGE(PG8_SB(0, 0), cB, voffB); PG8_STAGE(PG8_SB(0, 1), cB + hstep, voffB); PG8_STAGE(PG8_SA(0, 0), cA, voffA); PG8_STAGE(PG8_SA(0, 1), cA + hstep, voffA);
        if (wr == 1) PG8_BAR;
        PG8_WAIT_V(2); PG8_BAR;
        PG8_STAGE(PG8_SB(1, 0), cB + kstep, voffB); PG8_STAGE(PG8_SA(1, 0), cA + kstep, voffA); PG8_STAGE(PG8_SB(1, 1), cB + hstep + kstep, voffB);
        PG8_WAIT_V(6); PG8_BAR;
    } else {
        PG8_STAGE(PG8_SB(0, 0), cB, voffB); PG8_STAGE(PG8_SA(0, 0), cA, voffA); PG8_STAGE(PG8_SB(0, 1), cB + hstep, voffB); PG8_STAGE(PG8_SA(0, 1), cA + hstep, voffA);
        if (wr == 1) PG8_BAR;
        PG8_WAIT_V(4); PG8_BAR;
        PG8_STAGE(PG8_SB(1, 0), cB + kstep, voffB); PG8_STAGE(PG8_SA(1, 0), cA + kstep, voffA); PG8_STAGE(PG8_SB(1, 1), cB + hstep + kstep, voffB);
        PG8_WAIT_V(6); PG8_BAR;
    }
    for (;;) {
        const bool has_next = S.next(ui + 1, nxt);
        const char* nA = has_next ? (const char*)g.A + (size_t)nxt.pm * tstep : cA; const char* nB = has_next ? (const char*)g.Bt + (size_t)nxt.pn * tstep : cB;
        for (int t = 0; t < nt; t += 2) {
            const bool last = (t == nt - 2);
            const char* a1 = cA + (size_t)(t + 1) * kstep;
            const char* a2 = last ? nA : cA + (size_t)(t + 2) * kstep; const char* b2 = last ? nB : cB + (size_t)(t + 2) * kstep;
            const char* a3 = a2 + kstep; const char* b3 = b2 + kstep;
            if (last && has_next) S.a_ready(nxt);
            if constexpr (SP2) {
            PG8_LDB(B0, 0, 0); PG8_LDB(B1, 0, 1); PG8_SCHED; PG8_LDA(At, 0, 0); PG8_STAGE(PG8_SA(1, 1), a1 + hstep, voffA);
            PG8_WAIT_V(8); PG8_WAIT_L(0); PG8_BAR; PG8_MMA(0, 0, At, B0); PG8_MMA(0, 1, At, B1); PG8_BAR; PG8_SCHED;
            PG8_LDA(At, 0, 1); PG8_STAGE(PG8_SB(0, 0), b2, voffB); PG8_STAGE(PG8_SB(0, 1), b2 + hstep, voffB); PG8_STAGE(PG8_SA(0, 0), a2, voffA);
            PG8_WAIT_V(8); PG8_WAIT_L(0); PG8_BAR; PG8_MMA(1, 0, At, B0); PG8_MMA(1, 1, At, B1); PG8_BAR; PG8_SCHED;
            PG8_LDB(B0, 1, 0); PG8_LDB(B1, 1, 1); PG8_SCHED; PG8_LDA(At, 1, 0); PG8_STAGE(PG8_SA(0, 1), a2 + hstep, voffA);
            PG8_WAIT_V(8); PG8_WAIT_L(0); PG8_BAR; PG8_MMA(0, 0, At, B0); PG8_MMA(0, 1, At, B1); PG8_BAR; PG8_SCHED;
            PG8_LDA(At, 1, 1); PG8_STAGE(PG8_SB(1, 0), b3, voffB); PG8_STAGE(PG8_SB(1, 1), b3 + hstep, voffB); PG8_STAGE(PG8_SA(1, 0), a3, voffA);
            PG8_WAIT_V(8); PG8_WAIT_L(0); PG8_BAR; PG8_MMA(1, 0, At, B0); PG8_MMA(1, 1, At, B1); PG8_BAR; PG8_SCHED;
            } else {
            PG8_LDB(B0, 0, 0); PG8_SCHED; PG8_LDA(At, 0, 0); PG8_STAGE(PG8_SA(1, 1), a1 + hstep, voffA);
            PG8_WAIT_L(8); PG8_BAR; PG8_WAIT_L(0); PG8_MMA(0, 0, At, B0); PG8_BAR; PG8_SCHED;
            PG8_LDB(B1, 0, 1); PG8_STAGE(PG8_SB(0, 0), b2, voffB);
            PG8_BAR; PG8_WAIT_L(0); PG8_MMA(0, 1, At, B1); PG8_BAR;
            PG8_LDA(At, 0, 1); PG8_STAGE(PG8_SA(0, 0), a2, voffA);
            PG8_BAR; PG8_WAIT_L(0); PG8_MMA(1, 0, At, B0); PG8_BAR; PG8_SCHED;
            PG8_STAGE(PG8_SB(0, 1), b2 + hstep, voffB);
            PG8_WAIT_V(6); PG8_BAR; PG8_MMA(1, 1, At, B1); PG8_BAR;
            PG8_LDB(B0, 1, 0); PG8_SCHED; PG8_LDA(At, 1, 0); PG8_STAGE(PG8_SA(0, 1), a2 + hstep, voffA);
            PG8_WAIT_L(8); PG8_BAR; PG8_WAIT_L(0); PG8_MMA(0, 0, At, B0); PG8_BAR; PG8_SCHED;
            PG8_LDB(B1, 1, 1); PG8_STAGE(PG8_SB(1, 0), b3, voffB);
            PG8_BAR; PG8_WAIT_L(0); PG8_MMA(0, 1, At, B1); PG8_BAR;
            PG8_LDA(At, 1, 1); PG8_STAGE(PG8_SA(1, 0), a3, voffA);
            PG8_BAR; PG8_WAIT_L(0); PG8_MMA(1, 0, At, B0); PG8_BAR; PG8_SCHED;
            PG8_STAGE(PG8_SB(1, 1), b3 + hstep, voffB);
            PG8_WAIT_V(6); PG8_BAR; PG8_MMA(1, 1, At, B1); PG8_BAR;
            }
        }
        if constexpr (ALIGN_EPI) { if (wr == 0) PG8_BAR; }
        if constexpr (!Epi::AFTER_DRAIN) { E(acc, cur, wr, wc, fr, fq); S.done(cur); }
        if (!has_next) break;
#pragma unroll
        for (int a = 0; a < 2; ++a)
#pragma unroll
            for (int b = 0; b < 2; ++b)
#pragma unroll
                for (int m = 0; m < 4; ++m)
#pragma unroll
                    for (int n = 0; n < 2; ++n) acc[a][b][m][n] = (f32x4){0.f, 0.f, 0.f, 0.f};
        cur = nxt; cA = nA; cB = nB; ++ui;
        if constexpr (ALIGN_EPI) { if (wr == 1) PG8_BAR; }
    }
    PG8_WAIT_V(0);
    if constexpr (!ALIGN_EPI) { if (wr == 0) PG8_BAR; }
    PG8_BAR;
    if constexpr (Epi::AFTER_DRAIN) { E.fused(acc, cur, wr, wc, fr, fq, lds, wid, lane); S.done(cur); }
#undef PG8_SA
#undef PG8_SB
#undef PG8_STAGE
#undef PG8_LDA
#undef PG8_LDB
#undef PG8_MMA
#undef PG8_WAIT_V
#undef PG8_WAIT_L
#undef PG8_BAR
#undef PG8_SCHED
}
}

#define LAS __attribute__((address_space(3)))
using pg8::bf16_t; using pg8::bf16x8; using pg8::f32x4; using pg8::u32x4; using pg8::Unit;
typedef float f32x16 __attribute__((ext_vector_type(16)));
typedef short s16x4 __attribute__((ext_vector_type(4)));
typedef unsigned u32x2 __attribute__((ext_vector_type(2)));

constexpr int DM = 1024, NBAT = 8, SEQ = 2048, DBAT = 16, DSEQ = 64, PAST = 2048, ALEN = 512;
constexpr int MP = NBAT * SEQ, MS = DBAT * DSEQ, MTOK = MP + MS;
constexpr int HW = 512;
constexpr int NIN = 5120;
constexpr int DFF = 2816, NUP = 2 * DFF;
constexpr float EPS = 1e-6f, LOG2E = 1.4426950408889634f, QSCALE = 0.125f * LOG2E;

constexpr size_t O_Y = 0;
constexpr size_t O_KA_P = (size_t)MTOK * DM;
constexpr size_t O_VA_P = O_KA_P + (size_t)NBAT * ALEN * HW;
constexpr size_t O_KB_P = O_VA_P + (size_t)NBAT * ALEN * HW;
constexpr size_t O_VB_P = O_KB_P + (size_t)NBAT * SEQ * HW;
constexpr size_t O_LF_P = O_VB_P + (size_t)NBAT * SEQ * HW;
constexpr size_t O_CV_P = O_LF_P + (size_t)NBAT * SEQ * 8;
constexpr size_t O_KA_S = O_CV_P + (size_t)NBAT * 2 * NUP;
constexpr size_t O_VA_S = O_KA_S + (size_t)MS * HW;
constexpr size_t O_KB_S = O_VA_S + (size_t)MS * HW;
constexpr size_t O_VB_S = O_KB_S + (size_t)MS * HW;
constexpr size_t O_LF_S = O_VB_S + (size_t)MS * HW;
constexpr size_t O_CV_S = O_LF_S + (size_t)MS * 8;
constexpr size_t O_END = O_CV_S + (size_t)DBAT * 2 * NUP;
static_assert(O_END == 41304064, "output size");

constexpr size_t MiB = 1u << 20;
constexpr size_t WS_CTL = 0, CTL_BYTES = 131072;
constexpr int CW_CNT1 = 8192, CW_CNT2 = 12288, CW_CNT3 = 16384, CW_TC1 = 20480, CW_TC2 = 21504, CW_TC3 = 22528;
constexpr size_t WS_WIN = 1 * MiB, WS_WUP = 11 * MiB, WS_WDN = 22 * MiB, WS_WOUT = 28 * MiB, WS_WPA = 30 * MiB, WS_WPB = 31 * MiB;
constexpr size_t WS_H = 32 * MiB;
constexpr size_t WS_OA = 32 * MiB, WS_OB = 236 * MiB;
constexpr size_t WS_QKV = 66 * MiB;
constexpr size_t QKV_STRIDE = (size_t)MTOK * HW;
constexpr size_t WS_GA = 168 * MiB, WS_GB = 202 * MiB;
constexpr size_t WS_T = 66 * MiB;
constexpr size_t WS_MG = 134 * MiB;
constexpr size_t WS_U = 66 * MiB;
constexpr size_t WS_A2 = 160 * MiB;
constexpr size_t WS_HEAD = 254 * MiB, WS_TAIL = 258 * MiB;
constexpr size_t WS_XB1 = 262 * MiB, WS_XB2 = WS_XB1 + 262144, WS_XB3 = WS_XB2 + 262144;
constexpr size_t WS_XT1 = WS_XB3 + 262144, WS_XT2 = WS_XT1 + 65536, WS_XT3 = WS_XT2 + 65536;
constexpr size_t WS_END = 264 * MiB;
static_assert(WS_A2 + (size_t)MTOK * DFF * 2 <= WS_END && WS_U + (size_t)MTOK * DFF * 2 <= WS_A2, "ws map");

constexpr int RING_BYTES = 131072, LDS_BYTES = 147456;

struct Args { const float* in[22]; float* out; unsigned char* ws; int ph_lo, ph_hi, coop, pad; };
enum { I_XP = 0, I_XS, I_CKA, I_CVA, I_CKB, I_CVB, I_CLF, I_CONV, I_G1, I_G2, I_G3, I_G4, I_WIN, I_BF, I_REL, I_WPA, I_WPB, I_WOUT, I_WUP, I_CW, I_CB, I_WDN };

__device__ __forceinline__ void lds_barrier() { asm volatile("s_waitcnt lgkmcnt(0)" ::: "memory"); __builtin_amdgcn_s_barrier(); asm volatile("" ::: "memory"); }
__device__ __forceinline__ int lane_id() { return (int)__builtin_amdgcn_mbcnt_hi(~0u, __builtin_amdgcn_mbcnt_lo(~0u, 0u)); }
__device__ __forceinline__ unsigned f2bf(float f) { unsigned u = __builtin_bit_cast(unsigned, f); return (u + 0x7fffu + ((u >> 16) & 1u)) >> 16; }
__device__ __forceinline__ unsigned pk2(float lo, float hi) { return pg8::cvt_pk_bf16(lo, hi); }
__device__ __forceinline__ float bflo(unsigned w) { return __uint_as_float(w << 16); }
__device__ __forceinline__ float bfhi(unsigned w) { return __uint_as_float(w & 0xffff0000u); }
__device__ __forceinline__ float wave_sum(float v) {
#pragma unroll
    for (int o = 1; o < 64; o <<= 1) v += __shfl_xor(v, o);
    return v;
}
__device__ __forceinline__ float sigmoidf_(float x) { return __builtin_amdgcn_rcpf(1.0f + __builtin_amdgcn_exp2f(-x * LOG2E)); }
__device__ __forceinline__ const float* xrow_ptr(const Args& a, int m) { return m < MP ? a.in[I_XP] + (size_t)m * DM : a.in[I_XS] + (size_t)(m - MP) * DM; }

#define EPI_MAIN_CALL \
    __device__ __forceinline__ void operator()(const f32x4 (&acc)[2][2][4][2], const Unit& u, int wr, int wc, int fr, int fq) const { \
        _Pragma("unroll") for (int ai = 0; ai < 2; ++ai) _Pragma("unroll") for (int m = 0; m < 4; ++m) { \
            const int row = u.pm * 256 + ai * 128 + wr * 64 + m * 16 + fr; \
            _Pragma("unroll") for (int bj = 0; bj < 2; ++bj) store8(row, u.pn * 256 + bj * 128 + wc * 32 + 8 * fq, acc[ai][bj][m][0], acc[ai][bj][m][1]); } }
struct EpiIn {
    static constexpr bool PERM = true, AFTER_DRAIN = false;
    unsigned char* ws; float* out;
    __device__ __forceinline__ void store8(int row, int col, f32x4 v0, f32x4 v1) const {
        const int pn = col >> 8, seg = pn >> 1;
        bf16_t* bdst; int pitch, cl; float sc = 1.f; const bool sig = pn >= 12;
        if (!sig) { bdst = (bf16_t*)(ws + WS_QKV) + (size_t)seg * QKV_STRIDE; pitch = HW; cl = col & 511; if (seg == 0 || seg == 3) sc = QSCALE; }
        else { bdst = (bf16_t*)(ws + (pn < 16 ? WS_GA : WS_GB)); pitch = DM; cl = (col - 3072) & 1023; }
        if (sig) {
            unsigned q[8];
#pragma unroll
            for (int e = 0; e < 4; ++e) { q[e] = (unsigned)(sigmoidf_(v0[e]) * 255.0f + 0.5f); q[4 + e] = (unsigned)(sigmoidf_(v1[e]) * 255.0f + 0.5f); }
            u32x2 w8; w8.x = q[0] | (q[1] << 8) | (q[2] << 16) | (q[3] << 24); w8.y = q[4] | (q[5] << 8) | (q[6] << 16) | (q[7] << 24);
            *(u32x2*)((unsigned char*)bdst + (size_t)row * DM + cl) = w8;
            return;
        }
        v0 = v0 * sc; v1 = v1 * sc;
        u32x4 w; w.x = pk2(v0[0], v0[1]); w.y = pk2(v0[2], v0[3]); w.z = pk2(v1[0], v1[1]); w.w = pk2(v1[2], v1[3]);
        *(u32x4*)(bdst + (size_t)row * pitch + cl) = w;
    }
    EPI_MAIN_CALL
};
struct EpiProjA {
    static constexpr bool PERM = true, AFTER_DRAIN = false;
    const unsigned char* G; bf16_t* T;
    __device__ __forceinline__ void store8(int row, int c, f32x4 v0, f32x4 v1) const {
        const u32x2 g = *(const u32x2*)(G + (size_t)row * DM + c); constexpr float S8 = 1.0f / 255.0f;
        v0[0] *= (float)(g.x & 255u) * S8; v0[1] *= (float)((g.x >> 8) & 255u) * S8; v0[2] *= (float)((g.x >> 16) & 255u) * S8; v0[3] *= (float)(g.x >> 24) * S8;
        v1[0] *= (float)(g.y & 255u) * S8; v1[1] *= (float)((g.y >> 8) & 255u) * S8; v1[2] *= (float)((g.y >> 16) & 255u) * S8; v1[3] *= (float)(g.y >> 24) * S8;
        u32x4 w; w.x = pk2(v0[0], v0[1]); w.y = pk2(v0[2], v0[3]); w.z = pk2(v1[0], v1[1]); w.w = pk2(v1[2], v1[3]);
        *(u32x4*)(T + (size_t)row * DM + c) = w;
    }
    EPI_MAIN_CALL
};
struct EpiProjB {
    static constexpr bool PERM = true, AFTER_DRAIN = false;
    const unsigned char* G; const bf16_t* T; bf16_t* MG;
    __device__ __forceinline__ void store8(int row, int c, f32x4 v0, f32x4 v1) const {
        const u32x2 g8 = *(const u32x2*)(G + (size_t)row * DM + c); constexpr float S8 = 1.0f / 255.0f;
        const float gf[8] = {(float)(g8.x & 255u) * S8, (float)((g8.x >> 8) & 255u) * S8, (float)((g8.x >> 16) & 255u) * S8, (float)(g8.x >> 24) * S8,
                             (float)(g8.y & 255u) * S8, (float)((g8.y >> 8) & 255u) * S8, (float)((g8.y >> 16) & 255u) * S8, (float)(g8.y >> 24) * S8};
        const u32x4 tw = *(const u32x4*)(T + (size_t)row * DM + c);
        const f32x4 t0 = {bflo(tw.x), bfhi(tw.x), bflo(tw.y), bfhi(tw.y)}, t1 = {bflo(tw.z), bfhi(tw.z), bflo(tw.w), bfhi(tw.w)};
        v0[0] = t0[0] + v0[0] * gf[0]; v0[1] = t0[1] + v0[1] * gf[1]; v0[2] = t0[2] + v0[2] * gf[2]; v0[3] = t0[3] + v0[3] * gf[3];
        v1[0] = t1[0] + v1[0] * gf[4]; v1[1] = t1[1] + v1[1] * gf[5]; v1[2] = t1[2] + v1[2] * gf[6]; v1[3] = t1[3] + v1[3] * gf[7];
        u32x4 w; w.x = pk2(v0[0], v0[1]); w.y = pk2(v0[2], v0[3]); w.z = pk2(v1[0], v1[1]); w.w = pk2(v1[2], v1[3]);
        *(u32x4*)(MG + (size_t)row * DM + c) = w;
    }
    EPI_MAIN_CALL
};
struct EpiF32 {
    static constexpr bool PERM = true, AFTER_DRAIN = false;
    bf16_t* T;
    __device__ __forceinline__ void store8(int row, int c, f32x4 v0, f32x4 v1) const {
        u32x4 w; w.x = pk2(v0[0], v0[1]); w.y = pk2(v0[2], v0[3]); w.z = pk2(v1[0], v1[1]); w.w = pk2(v1[2], v1[3]);
        *(u32x4*)(T + (size_t)row * DM + c) = w;
    }
    EPI_MAIN_CALL
};

__device__ __forceinline__ bf16x8 frag_perm(const u32x4 v, const int paddr) {
    u32x4 r; r.x = (unsigned)__builtin_amdgcn_ds_bpermute(paddr, (int)v.x); r.y = (unsigned)__builtin_amdgcn_ds_bpermute(paddr, (int)v.y);
    r.z = (unsigned)__builtin_amdgcn_ds_bpermute(paddr, (int)v.z); r.w = (unsigned)__builtin_amdgcn_ds_bpermute(paddr, (int)v.w);
    return __builtin_bit_cast(bf16x8, r);
}
template <class Epi>
__device__ __forceinline__ void small_gemm_range(LAS unsigned char* lds, const bf16_t* A, const bf16_t* Bt, const int K, const int ubeg, const int uend, const int ustride, const Epi& E, const int wv) {
    int lane_ = lane_id(); asm volatile("" : "+v"(lane_));
    const int lane = lane_, fr = lane & 15, fq = lane >> 4, tid = wv * 64 + lane;
    const int kw = K >> 3;
    LAS float* red = (LAS float*)lds;
    for (int u = ubeg; u < uend; u += ustride) {
        const int rc = u & 15, cc = u >> 4;
        const bf16_t* Ap = A + (size_t)(MP + rc * 64 + (lane >> 2)) * K + wv * kw + 8 * (lane & 3);
        const bf16_t* Bp = Bt + (size_t)(cc * 64 + (lane >> 2)) * K + wv * kw + 8 * (lane & 3);
        const int paddr = ((lane & 15) * 4 + (lane >> 4)) * 4;
        f32x4 acc[4][4];
#pragma unroll
        for (int m = 0; m < 4; ++m)
#pragma unroll
            for (int n = 0; n < 4; ++n) acc[m][n] = (f32x4){0.f, 0.f, 0.f, 0.f};
#pragma unroll 4
        for (int ks = 0; ks < kw; ks += 32) {
            u32x4 ar[4], br[4]; bf16x8 af[4], bfr[4];
#pragma unroll
            for (int m = 0; m < 4; ++m) { ar[m] = *(const u32x4*)(Ap + (size_t)(m * 16) * K + ks); br[m] = *(const u32x4*)(Bp + (size_t)(m * 16) * K + ks); }
#pragma unroll
            for (int m = 0; m < 4; ++m) { af[m] = frag_perm(ar[m], paddr); bfr[m] = frag_perm(br[m], paddr); }
#pragma unroll
            for (int m = 0; m < 4; ++m)
#pragma unroll
                for (int n = 0; n < 4; ++n) acc[m][n] = __builtin_amdgcn_mfma_f32_16x16x32_bf16(bfr[n], af[m], acc[m][n], 0, 0, 0);
        }
#pragma unroll
        for (int m = 0; m < 4; ++m)
#pragma unroll
            for (int n = 0; n < 4; ++n) *(LAS f32x4*)(red + (wv * 64 + 16 * m + fr) * 68 + 16 * n + 4 * fq) = acc[m][n];
        __syncthreads();
        const int r = tid >> 3, c8 = (tid & 7) * 8;
        f32x4 s0 = {0.f, 0.f, 0.f, 0.f}, s1 = {0.f, 0.f, 0.f, 0.f};
#pragma unroll
        for (int w = 0; w < 8; ++w) { s0 += *(const LAS f32x4*)(red + (w * 64 + r) * 68 + c8); s1 += *(const LAS f32x4*)(red + (w * 64 + r) * 68 + c8 + 4); }
        E.store8(MP + rc * 64 + r, cc * 64 + c8, s0, s1);
        __syncthreads();
    }
}
template <class Epi>
__device__ __forceinline__ void small_gemm(LAS unsigned char* lds, const bf16_t* A, const bf16_t* Bt, const int K, const int N, const Epi& E, const int wv) {
    small_gemm_range<Epi>(lds, A, Bt, K, (int)blockIdx.x, 16 * (N >> 6), (int)gridDim.x, E, wv);
}
struct TailStat { float* xs; unsigned* cnt; };
__device__ __forceinline__ float tail_row_stat(const TailStat& st, const float part8, const int rc, const int cc, const int r, const int tid) {
    float p = part8; p += __shfl_xor(p, 1); p += __shfl_xor(p, 2); p += __shfl_xor(p, 4);
    if ((tid & 7) == 0) __hip_atomic_store(st.xs + (size_t)(rc * 64 + r) * 16 + cc, p, __ATOMIC_RELAXED, __HIP_MEMORY_SCOPE_AGENT);
    asm volatile("s_waitcnt vmcnt(0)" ::: "memory"); __syncthreads();
    if (tid == 0) {
        __hip_atomic_fetch_add(st.cnt + 64 * rc, 1u, __ATOMIC_RELAXED, __HIP_MEMORY_SCOPE_AGENT);
        while (__hip_atomic_load(st.cnt + 64 * rc, __ATOMIC_RELAXED, __HIP_MEMORY_SCOPE_AGENT) < 16u) __builtin_amdgcn_s_sleep(1);
        __builtin_amdgcn_fence(__ATOMIC_ACQUIRE, "agent");
    }
    __syncthreads();
    float q = 0.f;
#pragma unroll
    for (int j = 0; j < 16; ++j) q += __hip_atomic_load(st.xs + (size_t)(rc * 64 + r) * 16 + j, __ATOMIC_RELAXED, __HIP_MEMORY_SCOPE_AGENT);
    return 1.0f / sqrtf(q * (1.0f / DM) + EPS);
}
template <int MODE>
__device__ __forceinline__ void small_gemm_norm(LAS unsigned char* lds, const bf16_t* A, const bf16_t* Bt, const int K, const float* xin, float* y, bf16_t* H, const float* ga, const float* gb,
                                                const TailStat st1, const TailStat st2, const int wv) {
    int lane_ = lane_id(); asm volatile("" : "+v"(lane_));
    const int lane = lane_, fr = lane & 15, fq = lane >> 4, tid = wv * 64 + lane;
    const int kw = K >> 3, u = blockIdx.x, rc = u & 15, cc = u >> 4;
    LAS float* red = (LAS float*)lds;
    const bf16_t* Ap = A + (size_t)(MP + rc * 64 + (lane >> 2)) * K + wv * kw + 8 * (lane & 3);
    const bf16_t* Bp = Bt + (size_t)(cc * 64 + (lane >> 2)) * K + wv * kw + 8 * (lane & 3);
    const int paddr = ((lane & 15) * 4 + (lane >> 4)) * 4;
    f32x4 acc[4][4];
#pragma unroll
    for (int m = 0; m < 4; ++m)
#pragma unroll
        for (int n = 0; n < 4; ++n) acc[m][n] = (f32x4){0.f, 0.f, 0.f, 0.f};
#pragma unroll 4
    for (int ks = 0; ks < kw; ks += 32) {
        u32x4 ar[4], br[4]; bf16x8 af[4], bfr[4];
#pragma unroll
        for (int m = 0; m < 4; ++m) { ar[m] = *(const u32x4*)(Ap + (size_t)(m * 16) * K + ks); br[m] = *(const u32x4*)(Bp + (size_t)(m * 16) * K + ks); }
#pragma unroll
        for (int m = 0; m < 4; ++m) { af[m] = frag_perm(ar[m], paddr); bfr[m] = frag_perm(br[m], paddr); }
#pragma unroll
        for (int m = 0; m < 4; ++m)
#pragma unroll
            for (int n = 0; n < 4; ++n) acc[m][n] = __builtin_amdgcn_mfma_f32_16x16x32_bf16(bfr[n], af[m], acc[m][n], 0, 0, 0);
    }
#pragma unroll
    for (int m = 0; m < 4; ++m)
#pragma unroll
        for (int n = 0; n < 4; ++n) *(LAS f32x4*)(red + (wv * 64 + 16 * m + fr) * 68 + 16 * n + 4 * fq) = acc[m][n];
    __syncthreads();
    const int r = tid >> 3, c8 = (tid & 7) * 8;
    f32x4 s0 = {0.f, 0.f, 0.f, 0.f}, s1 = {0.f, 0.f, 0.f, 0.f};
#pragma unroll
    for (int w = 0; w < 8; ++w) { s0 += *(const LAS f32x4*)(red + (w * 64 + r) * 68 + c8); s1 += *(const LAS f32x4*)(red + (w * 64 + r) * 68 + c8 + 4); }
    const int row = rc * 64 + r, col = cc * 64 + c8;
    const float rs1 = tail_row_stat(st1, (s0[0] * s0[0] + s0[1] * s0[1]) + (s0[2] * s0[2] + s0[3] * s0[3]) + (s1[0] * s1[0] + s1[1] * s1[1]) + (s1[2] * s1[2] + s1[3] * s1[3]), rc, cc, r, tid);
    const f32x4 ga0 = *(const f32x4*)(ga + col), ga1 = *(const f32x4*)(ga + col + 4);
    float* yp = y + (size_t)(MP + row) * DM + col;
    if (MODE == 1) {
        const f32x4 y0 = *(const f32x4*)yp, y1 = *(const f32x4*)(yp + 4);
        *(f32x4*)yp = y0 + s0 * rs1 * ga0; *(f32x4*)(yp + 4) = y1 + s1 * rs1 * ga1;
    } else {
        const float* xp = xin + (size_t)row * DM + col;
        const f32x4 x0 = *(const f32x4*)xp + s0 * rs1 * ga0, x1 = *(const f32x4*)(xp + 4) + s1 * rs1 * ga1;
        *(f32x4*)yp = x0; *(f32x4*)(yp + 4) = x1;
        const float rs2 = tail_row_stat(st2, (x0[0] * x0[0] + x0[1] * x0[1]) + (x0[2] * x0[2] + x0[3] * x0[3]) + (x1[0] * x1[0] + x1[1] * x1[1]) + (x1[2] * x1[2] + x1[3] * x1[3]), rc, cc, r, tid);
        const f32x4 gb0 = *(const f32x4*)(gb + col), gb1 = *(const f32x4*)(gb + col + 4);
        const f32x4 h0 = x0 * rs2 * gb0, h1 = x1 * rs2 * gb1;
        u32x4 w; w.x = pk2(h0[0], h0[1]); w.y = pk2(h0[2], h0[3]); w.z = pk2(h1[0], h1[1]); w.w = pk2(h1[2], h1[3]);
        *(u32x4*)(H + (size_t)(MP + row) * DM + col) = w;
    }
    __syncthreads();
}
template <class Epi>
__device__ __forceinline__ void small_gemm_a4(LAS unsigned char* lds, const bf16_t* A, const bf16_t* Bt, const int N, const Epi& E, const int wv) {
    constexpr int K = 1024, kw = 128;
    int lane_ = lane_id(); asm volatile("" : "+v"(lane_));
    const int lane = lane_, fr = lane & 15, fq = lane >> 4, tid = wv * 64 + lane;
    const int nunits = 16 * (N >> 6), G = gridDim.x;
    LAS float* red = (LAS float*)lds;
    const int lrow = lane >> 2, lch = 8 * (lane & 3), paddr = ((lane & 15) * 4 + (lane >> 4)) * 4;
    const int rc = blockIdx.x & 15;
    bf16x8 pa[4][4];
    {   const bf16_t* Ap = A + (size_t)(MP + rc * 64 + lrow) * K + wv * kw + lch;
        u32x4 ar[4][4];
#pragma unroll
        for (int ks = 0; ks < 4; ++ks)
#pragma unroll
            for (int m = 0; m < 4; ++m) ar[ks][m] = *(const u32x4*)(Ap + (size_t)(m * 16) * K + ks * 32);
#pragma unroll
        for (int ks = 0; ks < 4; ++ks)
#pragma unroll
            for (int m = 0; m < 4; ++m) pa[ks][m] = frag_perm(ar[ks][m], paddr); }
    u32x4 br[4][4];
    if ((int)blockIdx.x < nunits) { const bf16_t* Bp = Bt + (size_t)((blockIdx.x >> 4) * 64 + lrow) * K + wv * kw + lch;
#pragma unroll
        for (int ks = 0; ks < 4; ++ks)
#pragma unroll
            for (int n = 0; n < 4; ++n) br[ks][n] = *(const u32x4*)(Bp + (size_t)(n * 16) * K + ks * 32); }
    for (int u = blockIdx.x; u < nunits; u += G) {
        const int cc = u >> 4;
        f32x4 acc[4][4];
#pragma unroll
        for (int m = 0; m < 4; ++m)
#pragma unroll
            for (int n = 0; n < 4; ++n) acc[m][n] = (f32x4){0.f, 0.f, 0.f, 0.f};
#pragma unroll
        for (int ks = 0; ks < 4; ++ks) {
            bf16x8 pb[4];
#pragma unroll
            for (int n = 0; n < 4; ++n) pb[n] = frag_perm(br[ks][n], paddr);
#pragma unroll
            for (int m = 0; m < 4; ++m)
#pragma unroll
                for (int n = 0; n < 4; ++n) acc[m][n] = __builtin_amdgcn_mfma_f32_16x16x32_bf16(pb[n], pa[ks][m], acc[m][n], 0, 0, 0);
        }
        { const int un = u + G < nunits ? u + G : u;
          const bf16_t* Bp = Bt + (size_t)((un >> 4) * 64 + lrow) * K + wv * kw + lch;
#pragma unroll
          for (int ks = 0; ks < 4; ++ks)
#pragma unroll
              for (int n = 0; n < 4; ++n) br[ks][n] = *(const u32x4*)(Bp + (size_t)(n * 16) * K + ks * 32); }
#pragma unroll
        for (int m = 0; m < 4; ++m)
#pragma unroll
            for (int n = 0; n < 4; ++n) *(LAS f32x4*)(red + (wv * 64 + 16 * m + fr) * 68 + 16 * n + 4 * fq) = acc[m][n];
        lds_barrier();
        const int r = tid >> 3, c8 = (tid & 7) * 8;
        f32x4 s0 = {0.f, 0.f, 0.f, 0.f}, s1 = {0.f, 0.f, 0.f, 0.f};
#pragma unroll
        for (int w = 0; w < 8; ++w) { s0 += *(const LAS f32x4*)(red + (w * 64 + r) * 68 + c8); s1 += *(const LAS f32x4*)(red + (w * 64 + r) * 68 + c8 + 4); }
        E.store8(MP + rc * 64 + r, cc * 64 + c8, s0, s1);
        lds_barrier();
    }
}
template <class Epi>
__device__ __forceinline__ void small_gemm_k1024(LAS unsigned char* lds, const bf16_t* A, const bf16_t* Bt, const int N, const Epi& E, const int wv) {
    constexpr int K = 1024, kw = 128;
    const int lane = lane_id(), fr = lane & 15, fq = lane >> 4, tid = wv * 64 + lane;
    const int nunits = 16 * (N >> 6), G = gridDim.x;
    LAS float* red = (LAS float*)lds;
    int u = blockIdx.x;
    if (u >= nunits) return;
    u32x4 fa[4][4], fb[4][4];
    const int lrow = lane >> 2, lch = 8 * (lane & 3), paddr = ((lane & 15) * 4 + (lane >> 4)) * 4;
    {   const bf16_t* Ap = A + (size_t)(MP + (u & 15) * 64 + lrow) * K + wv * kw + lch; const bf16_t* Bp = Bt + (size_t)((u >> 4) * 64 + lrow) * K + wv * kw + lch;
#pragma unroll
        for (int ks = 0; ks < 4; ++ks)
#pragma unroll
            for (int m = 0; m < 4; ++m) { fa[ks][m] = *(const u32x4*)(Ap + (size_t)(m * 16) * K + ks * 32); fb[ks][m] = *(const u32x4*)(Bp + (size_t)(m * 16) * K + ks * 32); } }
    for (; u < nunits; u += G) {
        const int rc = u & 15, cc = u >> 4, nu = u + G; const bool has_next = nu < nunits;
        const bf16_t* Ap = A + (size_t)(MP + (nu & 15) * 64 + lrow) * K + wv * kw + lch; const bf16_t* Bp = Bt + (size_t)((nu >> 4) * 64 + lrow) * K + wv * kw + lch;
        f32x4 acc[4][4];
#pragma unroll
        for (int m = 0; m < 4; ++m)
#pragma unroll
            for (int n = 0; n < 4; ++n) acc[m][n] = (f32x4){0.f, 0.f, 0.f, 0.f};
#pragma unroll
        for (int ks = 0; ks < 4; ++ks) {
            bf16x8 pa[4], pb[4];
#pragma unroll
            for (int m = 0; m < 4; ++m) { pa[m] = frag_perm(fa[ks][m], paddr); pb[m] = frag_perm(fb[ks][m], paddr); }
            if (has_next) {
#pragma unroll
                for (int m = 0; m < 4; ++m) { fa[ks][m] = *(const u32x4*)(Ap + (size_t)(m * 16) * K + ks * 32); fb[ks][m] = *(const u32x4*)(Bp + (size_t)(m * 16) * K + ks * 32); }
            }
#pragma unroll
            for (int m = 0; m < 4; ++m)
#pragma unroll
                for (int n = 0; n < 4; ++n) acc[m][n] = __builtin_amdgcn_mfma_f32_16x16x32_bf16(pb[n], pa[m], acc[m][n], 0, 0, 0);
        }
#pragma unroll
        for (int m = 0; m < 4; ++m)
#pragma unroll
            for (int n = 0; n < 4; ++n) *(LAS f32x4*)(red + (wv * 64 + 16 * m + fr) * 68 + 16 * n + 4 * fq) = acc[m][n];
        __syncthreads();
        const int r = tid >> 3, c8 = (tid & 7) * 8;
        f32x4 s0 = {0.f, 0.f, 0.f, 0.f}, s1 = {0.f, 0.f, 0.f, 0.f};
#pragma unroll
        for (int w = 0; w < 8; ++w) { s0 += *(const LAS f32x4*)(red + (w * 64 + r) * 68 + c8); s1 += *(const LAS f32x4*)(red + (w * 64 + r) * 68 + c8 + 4); }
        E.store8(MP + rc * 64 + r, cc * 64 + c8, s0, s1);
        __syncthreads();
    }
}
template <int CTRL> __device__ __forceinline__ float dppf(float old, float src) {
    return __builtin_bit_cast(float, __builtin_amdgcn_update_dpp(__builtin_bit_cast(int, old), __builtin_bit_cast(int, src), CTRL, 0xf, 0xf, false));
}
__device__ __forceinline__ float gelu_tanh(float x) {
    const float u = 1.5957691216057308f * (x + 0.044715f * x * x * x);
    return x * __builtin_amdgcn_rcpf(1.0f + __builtin_amdgcn_exp2f(-u * LOG2E));
}
struct EpiUpFused {
    static constexpr bool PERM = true, AFTER_DRAIN = false;
    bf16_t* A2; float* out; const float* cw; const float* cb; const float* st; float* head; float* tail; LAS float* halo;
    __device__ __forceinline__ void operator()(const f32x4 (&acc)[2][2][4][2], const Unit& u, int wr, int wc, int fr, int fq) const {
        const int pm = u.pm, gt = u.pn; const bool samp = pm >= 64;
        const int colq = wc * 32 + 8 * fq, oc = gt * 128 + colq;
#pragma unroll
        for (int ai = 0; ai < 2; ++ai) {
            const int g = ai * 2 + wr;
            if (fr >= 14) {
                const int r = fr - 14;
                float* cdst = nullptr;
                if (samp) cdst = out + O_CV_S + ((size_t)((pm - 64) * 4 + g) * 2 + r) * NUP;
                else if (g == 3) cdst = ((pm & 7) == 7) ? out + O_CV_P + ((size_t)(pm >> 3) * 2 + r) * NUP : tail + ((size_t)pm * 2 + r) * NUP;
#pragma unroll
                for (int bj = 0; bj < 2; ++bj) {
                    const f32x4 v0 = acc[ai][bj][3][0], v1 = acc[ai][bj][3][1];
                    LAS float* hp = halo + ((g * 2 + r) * 2 + bj) * 128 + colq;
                    *(LAS f32x4*)hp = v0; *(LAS f32x4*)(hp + 4) = v1;
                    if (cdst) { *(f32x4*)(cdst + bj * DFF + oc) = v0; *(f32x4*)(cdst + bj * DFF + oc + 4) = v1; }
                }
            }
        }
        const bool defer = !samp && (pm & 7) != 0;
        if (defer && wr == 0 && fr < 2) {
            float* hd = head + ((size_t)pm * 2 + fr) * NUP;
#pragma unroll
            for (int bj = 0; bj < 2; ++bj) { *(f32x4*)(hd + bj * DFF + oc) = acc[0][bj][0][0]; *(f32x4*)(hd + bj * DFF + oc + 4) = acc[0][bj][0][1]; }
        }
        f32x4 wg[3], wq[3], bg, bq;
#pragma unroll
        for (int k = 0; k < 3; ++k) { wg[k] = *(const f32x4*)(cw + (size_t)k * NUP + oc); wq[k] = *(const f32x4*)(cw + (size_t)k * NUP + DFF + oc); }
        bg = *(const f32x4*)(cb + oc); bq = *(const f32x4*)(cb + DFF + oc);
        asm volatile("s_waitcnt lgkmcnt(0)" ::: "memory"); __builtin_amdgcn_s_barrier(); asm volatile("" ::: "memory");
        u32x2 keep[2][4];
#pragma unroll
        for (int n = 0; n < 2; ++n) {
            if (n == 1) {
#pragma unroll
                for (int k = 0; k < 3; ++k) { wg[k] = *(const f32x4*)(cw + (size_t)k * NUP + oc + 4); wq[k] = *(const f32x4*)(cw + (size_t)k * NUP + DFF + oc + 4); }
                bg = *(const f32x4*)(cb + oc + 4); bq = *(const f32x4*)(cb + DFF + oc + 4);
            }
#pragma unroll
            for (int ai = 0; ai < 2; ++ai) {
                const int g = ai * 2 + wr;
                f32x4 xm1[2];
                xm1[0] = (f32x4){0.f, 0.f, 0.f, 0.f}; xm1[1] = (f32x4){0.f, 0.f, 0.f, 0.f};
                if (fr >= 14) {
                    const int r = fr - 14;
                    if (samp) { const float* sp = st + ((size_t)((pm - 64) * 4 + g) * 2 + r) * NUP; xm1[0] = *(const f32x4*)(sp + oc + 4 * n); xm1[1] = *(const f32x4*)(sp + DFF + oc + 4 * n); }
                    else if (g > 0) { const LAS float* hp = halo + (((g - 1) * 2 + r) * 2) * 128 + colq + 4 * n; xm1[0] = *(const LAS f32x4*)hp; xm1[1] = *(const LAS f32x4*)(hp + 128); }
                }
#pragma unroll
                for (int m = 0; m < 4; ++m) {
                    const size_t row = (size_t)pm * 256 + g * 64 + m * 16 + fr;
                    float res[4];
#pragma unroll
                    for (int e = 0; e < 4; ++e) {
                        const float xg = acc[ai][0][m][n][e], xgp = (m == 0) ? xm1[0][e] : acc[ai][0][m > 0 ? m - 1 : 0][n][e];
                        const float xv = acc[ai][1][m][n][e], xvp = (m == 0) ? xm1[1][e] : acc[ai][1][m > 0 ? m - 1 : 0][n][e];
                        const float g1 = dppf<0x111>(dppf<0x121>(0.f, xgp), xg), g2 = dppf<0x112>(dppf<0x122>(0.f, xgp), xg);
                        const float v1 = dppf<0x111>(dppf<0x121>(0.f, xvp), xv), v2 = dppf<0x112>(dppf<0x122>(0.f, xvp), xv);
                        const float yg = bg[e] + wg[0][e] * g2 + wg[1][e] * g1 + wg[2][e] * xg;
                        const float yv = bq[e] + wq[0][e] * v2 + wq[1][e] * v1 + wq[2][e] * xv;
                        res[e] = gelu_tanh(yg) * yv;
                    }
                    u32x2 w; w.x = pk2(res[0], res[1]); w.y = pk2(res[2], res[3]);
                    if (n == 0) keep[ai][m] = w;
                    else if (!(defer && g == 0 && m == 0 && fr < 2)) { u32x4 ww; ww.x = keep[ai][m].x; ww.y = keep[ai][m].y; ww.z = w.x; ww.w = w.y; *(u32x4*)(A2 + row * DFF + oc) = ww; }
                    asm volatile("" ::: "memory");
                }
            }
        }
    }
};
__device__ __forceinline__ void ffn_fixup(const Args& a, const int pm, const int tid) {
    if (pm >= 64 || (pm & 7) == 0) return;
    const float* head = (const float*)(a.ws + WS_HEAD) + (size_t)pm * 2 * NUP; const float* tail = (const float*)(a.ws + WS_TAIL) + (size_t)(pm - 1) * 2 * NUP;
    const float* cw = a.in[I_CW]; const float* cb = a.in[I_CB]; bf16_t* A2 = (bf16_t*)(a.ws + WS_A2);
    for (int it = tid; it < 704; it += 512) {
        const int r = it >= 352 ? 1 : 0, oc = (it - r * 352) * 8;
        const float* x0 = r == 0 ? tail : tail + NUP; const float* x1 = r == 0 ? tail + NUP : head; const float* x2 = r == 0 ? head : head + NUP;
        float y[2][8];
#pragma unroll
        for (int hh = 0; hh < 2; ++hh) { const int c = hh * DFF + oc;
#pragma unroll
            for (int q = 0; q < 2; ++q) {
                const f32x4 bb = *(const f32x4*)(cb + c + 4 * q), w0 = *(const f32x4*)(cw + c + 4 * q), w1 = *(const f32x4*)(cw + NUP + c + 4 * q), w2 = *(const f32x4*)(cw + 2 * NUP + c + 4 * q);
                const f32x4 a0 = *(const f32x4*)(x0 + c + 4 * q), a1 = *(const f32x4*)(x1 + c + 4 * q), a2 = *(const f32x4*)(x2 + c + 4 * q);
#pragma unroll
                for (int e = 0; e < 4; ++e) y[hh][4 * q + e] = bb[e] + w0[e] * a0[e] + w1[e] * a1[e] + w2[e] * a2[e];
            } }
        float res[8];
#pragma unroll
        for (int e = 0; e < 8; ++e) res[e] = gelu_tanh(y[0][e]) * y[1][e];
        u32x4 w; w.x = pk2(res[0], res[1]); w.y = pk2(res[2], res[3]); w.z = pk2(res[4], res[5]); w.w = pk2(res[6], res[7]);
        *(u32x4*)(A2 + ((size_t)pm * 256 + r) * DFF + oc) = w;
    }
}

struct RowStat {
    float* xbuf; unsigned* cnt;
    __device__ __forceinline__ void run(const f32x4 (&v)[2][2][4][2], const Unit& u, int wr, int wc, int fr, int fq, LAS unsigned char* lds, int wid, int lane) const {
        LAS float* P = (LAS float*)lds; LAS float* S = (LAS float*)(lds + 4096);
#pragma unroll
        for (int ai = 0; ai < 2; ++ai)
#pragma unroll
            for (int m = 0; m < 4; ++m) { float s = 0.f;
#pragma unroll
                for (int bj = 0; bj < 2; ++bj)
#pragma unroll
                    for (int n = 0; n < 2; ++n) { const f32x4 x = v[ai][bj][m][n]; s += (x[0] * x[0] + x[1] * x[1]) + (x[2] * x[2] + x[3] * x[3]); }
                s += __shfl_xor(s, 16); s += __shfl_xor(s, 32);
                if (fq == 0) P[(ai * 128 + wr * 64 + m * 16 + fr) * 4 + wc] = s; }
        asm volatile("s_waitcnt lgkmcnt(0)" ::: "memory"); __builtin_amdgcn_s_barrier(); asm volatile("" ::: "memory");
        const int tid = wid * 64 + lane;
        if (tid < 256) { const f32x4 p = *(const LAS f32x4*)(P + tid * 4);
            __hip_atomic_store(xbuf + ((size_t)u.pm * 256 + tid) * 4 + u.pn, (p[0] + p[1]) + (p[2] + p[3]), __ATOMIC_RELAXED, __HIP_MEMORY_SCOPE_AGENT); }
        asm volatile("s_waitcnt vmcnt(0)" ::: "memory"); __builtin_amdgcn_s_barrier(); asm volatile("" ::: "memory");
        if (tid == 0) {
            __hip_atomic_fetch_add(cnt + 64 * u.pm, 1u, __ATOMIC_RELAXED, __HIP_MEMORY_SCOPE_AGENT);
            while (__hip_atomic_load(cnt + 64 * u.pm, __ATOMIC_RELAXED, __HIP_MEMORY_SCOPE_AGENT) < 4u) __builtin_amdgcn_s_sleep(1);
            __builtin_amdgcn_fence(__ATOMIC_ACQUIRE, "agent");
        }
        asm volatile("s_waitcnt vmcnt(0) lgkmcnt(0)" ::: "memory"); __builtin_amdgcn_s_barrier(); asm volatile("" ::: "memory");
        if (tid < 256) { const float* slot = xbuf + ((size_t)u.pm * 256 + tid) * 4; float q = 0.f;
#pragma unroll
            for (int t = 0; t < 4; ++t) q += __hip_atomic_load(slot + t, __ATOMIC_RELAXED, __HIP_MEMORY_SCOPE_AGENT);
            S[tid] = 1.0f / sqrtf(q * (1.0f / DM) + EPS); }
        asm volatile("s_waitcnt vmcnt(0) lgkmcnt(0)" ::: "memory"); __builtin_amdgcn_s_barrier(); asm volatile("" ::: "memory");
    }
};
struct EpiOutNorm {
    static constexpr bool PERM = true, AFTER_DRAIN = true;
    const float* x; float* y; bf16_t* H; const float* g2; const float* g3; RowStat st1, st2;
    __device__ __forceinline__ void fused(f32x4 (&acc)[2][2][4][2], const Unit& u, int wr, int wc, int fr, int fq, LAS unsigned char* lds, int wid, int lane) const {
        st1.run(acc, u, wr, wc, fr, fq, lds, wid, lane);
        const LAS float* S = (const LAS float*)(lds + 4096);
        const int c0 = u.pn * 256 + wc * 32 + 8 * fq;
#pragma unroll
        for (int ai = 0; ai < 2; ++ai)
#pragma unroll
            for (int m = 0; m < 4; ++m) { const int rl = ai * 128 + wr * 64 + m * 16 + fr; const size_t row = (size_t)u.pm * 256 + rl; const float rs = S[rl];
#pragma unroll
                for (int bj = 0; bj < 2; ++bj)
#pragma unroll
                    for (int n = 0; n < 2; ++n) { const int c = c0 + bj * 128 + 4 * n;
                        const f32x4 xv = *(const f32x4*)(x + row * DM + c), gg = *(const f32x4*)(g2 + c);
                        const f32x4 x1 = xv + acc[ai][bj][m][n] * rs * gg;
                        *(f32x4*)(y + row * DM + c) = x1; acc[ai][bj][m][n] = x1; }
                asm volatile("" : "+v"(acc[ai][0][m][0]), "+v"(acc[ai][0][m][1]), "+v"(acc[ai][1][m][0]), "+v"(acc[ai][1][m][1]));
                asm volatile("" ::: "memory"); }
        st2.run(acc, u, wr, wc, fr, fq, lds, wid, lane);
#pragma unroll
        for (int ai = 0; ai < 2; ++ai)
#pragma unroll
            for (int m = 0; m < 4; ++m) { const int rl = ai * 128 + wr * 64 + m * 16 + fr; const size_t row = (size_t)u.pm * 256 + rl; const float rs = S[rl];
#pragma unroll
                for (int bj = 0; bj < 2; ++bj) { const int c = c0 + bj * 128;
                    const f32x4 ga = *(const f32x4*)(g3 + c), gb = *(const f32x4*)(g3 + c + 4); const f32x4 v0 = acc[ai][bj][m][0] * rs * ga, v1 = acc[ai][bj][m][1] * rs * gb;
                    u32x4 w; w.x = pk2(v0[0], v0[1]); w.y = pk2(v0[2], v0[3]); w.z = pk2(v1[0], v1[1]); w.w = pk2(v1[2], v1[3]);
                    *(u32x4*)(H + row * DM + c) = w; } }
    }
};
struct EpiDownNorm {
    static constexpr bool PERM = true, AFTER_DRAIN = true;
    float* y; const float* g4; RowStat st;
    __device__ __forceinline__ void fused(f32x4 (&acc)[2][2][4][2], const Unit& u, int wr, int wc, int fr, int fq, LAS unsigned char* lds, int wid, int lane) const {
        st.run(acc, u, wr, wc, fr, fq, lds, wid, lane);
        const LAS float* S = (const LAS float*)(lds + 4096);
        const int c0 = u.pn * 256 + wc * 32 + 8 * fq;
#pragma unroll
        for (int ai = 0; ai < 2; ++ai)
#pragma unroll
            for (int m = 0; m < 4; ++m) { const int rl = ai * 128 + wr * 64 + m * 16 + fr; const size_t row = (size_t)u.pm * 256 + rl; const float rs = S[rl];
#pragma unroll
                for (int bj = 0; bj < 2; ++bj)
#pragma unroll
                    for (int n = 0; n < 2; ++n) { const int c = c0 + bj * 128 + 4 * n;
                        const f32x4 xv = *(const f32x4*)(y + row * DM + c), gg = *(const f32x4*)(g4 + c);
                        *(f32x4*)(y + row * DM + c) = xv + acc[ai][bj][m][n] * rs * gg; }
                asm volatile("" ::: "memory"); }
    }
};

__device__ __forceinline__ void p0_transpose_item(const float* W, int N, int K, bf16_t* WT, int k0, int src_n0, int dst_n0, LAS float* scr, int lane) {
    float tv[32];
#pragma unroll
    for (int i = 0; i < 32; ++i) tv[i] = W[(size_t)(k0 + 2 * i + (lane >> 5)) * N + src_n0 + (lane & 31)];
#pragma unroll
    for (int i = 0; i < 32; ++i) scr[(2 * i + (lane >> 5)) * 33 + (lane & 31)] = tv[i];
    asm volatile("s_waitcnt lgkmcnt(0)" ::: "memory");
    const int c = lane & 7;
#pragma unroll
    for (int j = 0; j < 4; ++j) { const int n = (lane >> 3) + 8 * j; const LAS float* s = scr + (8 * c) * 33 + n;
        u32x4 o; o.x = pk2(s[0 * 33], s[1 * 33]); o.y = pk2(s[2 * 33], s[3 * 33]); o.z = pk2(s[4 * 33], s[5 * 33]); o.w = pk2(s[6 * 33], s[7 * 33]);
        *(u32x4*)(WT + (size_t)(dst_n0 + n) * K + k0 + 8 * c) = o; }
    asm volatile("s_waitcnt lgkmcnt(0)" ::: "memory");
}

constexpr int TI_IN = 16 * 160, TI_PA = 8 * 32, TI_PB = 8 * 32, TI_OUT = 16 * 32, TI_UP = 16 * 176, TI_DN = 44 * 32;
constexpr int TI_ALL = TI_IN + TI_PA + TI_PB + TI_OUT + TI_UP + TI_DN;
__device__ __forceinline__ void transpose_item(const Args& a, const int it, LAS float* scr, const int lane) {
    unsigned char* ws = a.ws; int r = it;
    if (r < TI_IN) { const int kb = r / 160, nb = r % 160, d0 = nb * 32; p0_transpose_item(a.in[I_WIN], 5128, DM, (bf16_t*)(ws + WS_WIN), kb * 64, d0 + (d0 >= 3072 ? 8 : 0), d0, scr, lane); return; } r -= TI_IN;
    if (r < TI_PA) { const int kb = r / 32, nb = r % 32; p0_transpose_item(a.in[I_WPA], DM, HW, (bf16_t*)(ws + WS_WPA), kb * 64, nb * 32, nb * 32, scr, lane); return; } r -= TI_PA;
    if (r < TI_PB) { const int kb = r / 32, nb = r % 32; p0_transpose_item(a.in[I_WPB], DM, HW, (bf16_t*)(ws + WS_WPB), kb * 64, nb * 32, nb * 32, scr, lane); return; } r -= TI_PB;
    if (r < TI_OUT) { const int kb = r / 32, nb = r % 32; p0_transpose_item(a.in[I_WOUT], DM, DM, (bf16_t*)(ws + WS_WOUT), kb * 64, nb * 32, nb * 32, scr, lane); return; } r -= TI_OUT;
    if (r < TI_UP) { const int kb = r / 176, nb = r % 176, d0 = nb * 32, tile = d0 >> 8, w = d0 & 255; const int s0 = (w < 128) ? tile * 128 + w : DFF + tile * 128 + (w - 128);
        p0_transpose_item(a.in[I_WUP], NUP, DM, (bf16_t*)(ws + WS_WUP), kb * 64, s0, d0, scr, lane); return; } r -= TI_UP;
    { const int kb = r / 32, nb = r % 32; p0_transpose_item(a.in[I_WDN], DM, DFF, (bf16_t*)(ws + WS_WDN), kb * 64, nb * 32, nb * 32, scr, lane); }
}
__device__ __forceinline__ void phase_prologue(const Args& a, LAS unsigned char* lds, const int wv) {
    const int lane = lane_id(), wave = wv, tid = wv * 64 + lane;
    const int G = gridDim.x, gw = blockIdx.x * 8 + wave, NGW = G * 8;
    unsigned char* ws = a.ws;
    LAS float* scr = (LAS float*)(lds + wave * 8448);
    LAS float* wfg = (LAS float*)(lds + 69632);
    {
        const float* win = a.in[I_WIN]; const float* g1 = a.in[I_G1];
        for (int k = tid; k < DM; k += 512) {
            const f32x4 w0 = *(const f32x4*)(win + (size_t)k * 5128 + 3072), w1 = *(const f32x4*)(win + (size_t)k * 5128 + 3076); const float g = g1[k];
            wfg[0 * DM + k] = w0[0] * g; wfg[1 * DM + k] = w0[1] * g; wfg[2 * DM + k] = w0[2] * g; wfg[3 * DM + k] = w0[3] * g;
            wfg[4 * DM + k] = w1[0] * g; wfg[5 * DM + k] = w1[1] * g; wfg[6 * DM + k] = w1[2] * g; wfg[7 * DM + k] = w1[3] * g;
        }
    }
    __syncthreads();
    for (int it = gw; it < TI_IN; it += NGW) transpose_item(a, it, scr, lane);
    const float* g1 = a.in[I_G1]; const float* bfp = a.in[I_BF];
    f32x4 gv[4];
#pragma unroll
    for (int j = 0; j < 4; ++j) gv[j] = *(const f32x4*)(g1 + 4 * lane + 256 * j);
    bf16_t* H = (bf16_t*)(ws + WS_H);
    constexpr int RB = 4;
    for (int mb = (NGW - 1 - gw) * RB; mb < MTOK; mb += NGW * RB) {
        f32x4 v[RB][4]; float ss[RB], z[RB][8];
#pragma unroll
        for (int i = 0; i < RB; ++i) { const float* xr = xrow_ptr(a, mb + i);
#pragma unroll
            for (int j = 0; j < 4; ++j) v[i][j] = *(const f32x4*)(xr + 4 * lane + 256 * j); }
#pragma unroll
        for (int i = 0; i < RB; ++i) { ss[i] = 0.f;
#pragma unroll
            for (int j = 0; j < 4; ++j) ss[i] += (v[i][j][0] * v[i][j][0] + v[i][j][1] * v[i][j][1]) + (v[i][j][2] * v[i][j][2] + v[i][j][3] * v[i][j][3]); }
#pragma unroll
        for (int q = 0; q < 8; ++q) {
            f32x4 w[4];
#pragma unroll
            for (int j = 0; j < 4; ++j) w[j] = *(const LAS f32x4*)(wfg + q * DM + 4 * lane + 256 * j);
#pragma unroll
            for (int i = 0; i < RB; ++i) { float s = 0.f;
#pragma unroll
                for (int j = 0; j < 4; ++j) s += (v[i][j][0] * w[j][0] + v[i][j][1] * w[j][1]) + (v[i][j][2] * w[j][2] + v[i][j][3] * w[j][3]);
                z[i][q] = s; }
        }
#pragma unroll
        for (int i = 0; i < RB; ++i) {
            const int m = mb + i;
            const float sst = wave_sum(ss[i]);
#pragma unroll
            for (int q = 0; q < 8; ++q) z[i][q] = wave_sum(z[i][q]);
            const float rs = 1.0f / sqrtf(sst * (1.0f / DM) + EPS);
#pragma unroll
            for (int j = 0; j < 4; ++j) {
                u32x2 o; o.x = pk2(v[i][j][0] * rs * gv[j][0], v[i][j][1] * rs * gv[j][1]); o.y = pk2(v[i][j][2] * rs * gv[j][2], v[i][j][3] * rs * gv[j][3]);
                *(u32x2*)(H + (size_t)m * DM + 4 * lane + 256 * j) = o;
            }
            float zz = z[i][0];
#pragma unroll
            for (int q = 1; q < 8; ++q) zz = (lane == q) ? z[i][q] : zz;
            if (lane < 8) {
                const float t = zz * rs + bfp[lane];
                const float lf = fminf(t, 0.f) - log1pf(expf(-fabsf(t)));
                float* dst = m < MP ? a.out + O_LF_P + (size_t)m * 8 : a.out + O_LF_S + (size_t)(m - MP) * 8;
                dst[lane] = lf;
            }
        }
    }
}

__device__ __forceinline__ void phase_rows1(const Args& a, const int wv) {
    const int lane = lane_id(), wave = wv; const int gw = blockIdx.x * 8 + wave, NGW = gridDim.x * 8;
    const bf16_t* T = (const bf16_t*)(a.ws + WS_T); bf16_t* H = (bf16_t*)(a.ws + WS_H);
    f32x4 g2[4], g3[4];
#pragma unroll
    for (int j = 0; j < 4; ++j) { g2[j] = *(const f32x4*)(a.in[I_G2] + 4 * lane + 256 * j); g3[j] = *(const f32x4*)(a.in[I_G3] + 4 * lane + 256 * j); }
    constexpr int RB = 2;
    for (int mb = MP + gw * RB; mb < MTOK; mb += NGW * RB) {
        f32x4 t[RB][4], x[RB][4];
#pragma unroll
        for (int i = 0; i < RB; ++i) { const float* xr = xrow_ptr(a, mb + i); const bf16_t* tr = T + (size_t)(mb + i) * DM;
#pragma unroll
            for (int j = 0; j < 4; ++j) { const u32x2 tw = *(const u32x2*)(tr + 4 * lane + 256 * j); t[i][j] = (f32x4){bflo(tw.x), bfhi(tw.x), bflo(tw.y), bfhi(tw.y)}; x[i][j] = *(const f32x4*)(xr + 4 * lane + 256 * j); } }
#pragma unroll
        for (int i = 0; i < RB; ++i) {
            const int m = mb + i; float ss = 0.f;
#pragma unroll
            for (int j = 0; j < 4; ++j) ss += (t[i][j][0] * t[i][j][0] + t[i][j][1] * t[i][j][1]) + (t[i][j][2] * t[i][j][2] + t[i][j][3] * t[i][j][3]);
            const float rs = 1.0f / sqrtf(wave_sum(ss) * (1.0f / DM) + EPS);
            float s2 = 0.f;
#pragma unroll
            for (int j = 0; j < 4; ++j) { x[i][j] = x[i][j] + t[i][j] * rs * g2[j]; s2 += (x[i][j][0] * x[i][j][0] + x[i][j][1] * x[i][j][1]) + (x[i][j][2] * x[i][j][2] + x[i][j][3] * x[i][j][3]);
                *(f32x4*)(a.out + O_Y + (size_t)m * DM + 4 * lane + 256 * j) = x[i][j]; }
            const float r2 = 1.0f / sqrtf(wave_sum(s2) * (1.0f / DM) + EPS);
#pragma unroll
            for (int j = 0; j < 4; ++j) { u32x2 o; o.x = pk2(x[i][j][0] * r2 * g3[j][0], x[i][j][1] * r2 * g3[j][1]); o.y = pk2(x[i][j][2] * r2 * g3[j][2], x[i][j][3] * r2 * g3[j][3]);
                *(u32x2*)(H + (size_t)m * DM + 4 * lane + 256 * j) = o; }
        }
    }
}
__device__ __forceinline__ void phase_rows2(const Args& a, const int wv) {
    const int lane = lane_id(), wave = wv; const int gw = blockIdx.x * 8 + wave, NGW = gridDim.x * 8;
    const bf16_t* T = (const bf16_t*)(a.ws + WS_T);
    f32x4 g4[4];
#pragma unroll
    for (int j = 0; j < 4; ++j) g4[j] = *(const f32x4*)(a.in[I_G4] + 4 * lane + 256 * j);
    constexpr int RB = 2;
    for (int mb = MP + gw * RB; mb < MTOK; mb += NGW * RB) {
        f32x4 t[RB][4], x[RB][4];
#pragma unroll
        for (int i = 0; i < RB; ++i) { const bf16_t* tr = T + (size_t)(mb + i) * DM; const float* yr = a.out + O_Y + (size_t)(mb + i) * DM;
#pragma unroll
            for (int j = 0; j < 4; ++j) { const u32x2 tw = *(const u32x2*)(tr + 4 * lane + 256 * j); t[i][j] = (f32x4){bflo(tw.x), bfhi(tw.x), bflo(tw.y), bfhi(tw.y)}; x[i][j] = *(const f32x4*)(yr + 4 * lane + 256 * j); } }
#pragma unroll
        for (int i = 0; i < RB; ++i) {
            float* yr = a.out + O_Y + (size_t)(mb + i) * DM; float ss = 0.f;
#pragma unroll
            for (int j = 0; j < 4; ++j) ss += (t[i][j][0] * t[i][j][0] + t[i][j][1] * t[i][j][1]) + (t[i][j][2] * t[i][j][2] + t[i][j][3] * t[i][j][3]);
            const float rs = 1.0f / sqrtf(wave_sum(ss) * (1.0f / DM) + EPS);
#pragma unroll
            for (int j = 0; j < 4; ++j) *(f32x4*)(yr + 4 * lane + 256 * j) = x[i][j] + t[i][j] * rs * g4[j];
        }
    }
}


constexpr int AL_K = 0, AL_KB = 64 * 144, AL_V = 2 * AL_KB, AL_VB = 8192, AL_WS = AL_V + 2 * AL_VB, AL_CS = AL_WS + 8 * 256, AL_TAB = AL_CS + 2112 * 4, AL_MISC = AL_TAB + 260 * 4;
constexpr int N_ATT_UNITS = 1280, N_TR_UNITS = (TI_ALL - TI_IN + 7) / 8;
__device__ __forceinline__ int crow(int r, int hi) { return (r & 3) + 8 * (r >> 2) + 4 * hi; }
__device__ __forceinline__ float halfswap_max(float m) { auto rr = __builtin_amdgcn_permlane32_swap(__float_as_uint(m), __float_as_uint(m), false, false); return fmaxf(__uint_as_float(rr[0]), __uint_as_float(rr[1])); }
__device__ __forceinline__ float halfswap_sum(float m) { auto rr = __builtin_amdgcn_permlane32_swap(__float_as_uint(m), __float_as_uint(m), false, false); return __uint_as_float(rr[0]) + __uint_as_float(rr[1]); }

__device__ __forceinline__ void pv_step(f32x16* o, f32x16& lacc, unsigned vb, bf16x8 pa0, bf16x8 pa1, bf16x8 pa2, bf16x8 pa3) {
#pragma unroll
    for (int d0 = 0; d0 < 2; ++d0) { s16x4 lo[4], hh[4];
#pragma unroll
        for (int ks = 0; ks < 4; ++ks) {
            asm volatile("ds_read_b64_tr_b16 %0,%1 offset:%c2" : "=&v"(lo[ks]) : "v"(vb), "i"(d0 * 4096 + ks * 1024) : "memory");
            asm volatile("ds_read_b64_tr_b16 %0,%1 offset:%c2" : "=&v"(hh[ks]) : "v"(vb), "i"(d0 * 4096 + ks * 1024 + 512) : "memory"); }
        if (d0 == 0) {
            __builtin_amdgcn_sched_barrier(0);
            const u32x4 one4 = {0x3F803F80u, 0x3F803F80u, 0x3F803F80u, 0x3F803F80u}; const bf16x8 ones = __builtin_bit_cast(bf16x8, one4);
            lacc = __builtin_amdgcn_mfma_f32_32x32x16_bf16(pa0, ones, lacc, 0, 0, 0); lacc = __builtin_amdgcn_mfma_f32_32x32x16_bf16(pa1, ones, lacc, 0, 0, 0);
            lacc = __builtin_amdgcn_mfma_f32_32x32x16_bf16(pa2, ones, lacc, 0, 0, 0); lacc = __builtin_amdgcn_mfma_f32_32x32x16_bf16(pa3, ones, lacc, 0, 0, 0);
            __builtin_amdgcn_sched_barrier(0);
        }
        asm volatile("s_waitcnt lgkmcnt(0)" ::: "memory"); __builtin_amdgcn_sched_barrier(0);
#define PK_(k) (bf16x8){lo[k][0], lo[k][1], lo[k][2], lo[k][3], hh[k][0], hh[k][1], hh[k][2], hh[k][3]}
        o[d0] = __builtin_amdgcn_mfma_f32_32x32x16_bf16(pa0, PK_(0), o[d0], 0, 0, 0);
        o[d0] = __builtin_amdgcn_mfma_f32_32x32x16_bf16(pa1, PK_(1), o[d0], 0, 0, 0);
        o[d0] = __builtin_amdgcn_mfma_f32_32x32x16_bf16(pa2, PK_(2), o[d0], 0, 0, 0);
        o[d0] = __builtin_amdgcn_mfma_f32_32x32x16_bf16(pa3, PK_(3), o[d0], 0, 0, 0);
#undef PK_
    }
}

template <int KIND>
__device__ __forceinline__ void attn_unit(const Args& a, LAS unsigned char* lds, int b, int h, int blk, int samp, const int wv, unsigned* qctr, LAS unsigned* qnext) {
    int lane_ = lane_id(); asm volatile("" : "+v"(lane_));
    const int lane = lane_, r32 = lane & 31, hi = lane >> 5, wid = wv, tid = wv * 64 + lane;
    const bf16_t* QKV = (const bf16_t*)(a.ws + WS_QKV);
    const bf16_t* Qb = QKV + (size_t)(KIND == 0 ? 0 : 3) * QKV_STRIDE; const bf16_t* Kb = Qb + QKV_STRIDE; const bf16_t* Vb = Kb + QKV_STRIDE;
    bf16_t* Ob = (bf16_t*)(a.ws + (KIND == 0 ? WS_OA : WS_OB));
    const float* Kc = a.in[KIND == 0 ? I_CKA : I_CKB]; const float* Vc = a.in[KIND == 0 ? I_CVA : I_CVB];
    constexpr int CT = (KIND == 0) ? 8 : 32;
    int t_lo, t_hi, w_lo, w_hi, qrow, cch = 0, qpos = 0;
    if (KIND == 0) {
        if (!samp) { const int c0 = 4 * blk; cch = c0 + (wid >> 1); t_lo = c0 - 8 < 0 ? 0 : c0 - 8; t_hi = c0 + 3; w_lo = cch - 8 < 0 ? 0 : cch - 8; w_hi = cch; qrow = b * SEQ + 64 * cch + 32 * (wid & 1); qpos = 32 * (wid & 1) + r32; }
        else { cch = 8; t_lo = 0; t_hi = 8; w_lo = 0; w_hi = wid < 2 ? 8 : -1; qrow = MP + b * DSEQ + 32 * (wid & 1); qpos = 32 * (wid & 1) + r32; }
    } else {
        if (!samp) { t_lo = 0; t_hi = 4 * blk + 3; w_lo = 0; w_hi = 4 * blk + (wid >> 1); qrow = b * SEQ + 256 * blk + 32 * wid; qpos = 256 * blk + 32 * wid + r32; }
        else { t_lo = 0; t_hi = 32; w_lo = 0; w_hi = wid < 2 ? 32 : -1; qrow = MP + b * DSEQ + 32 * (wid & 1); qpos = PAST + 32 * (wid & 1) + r32; }
    }
    const bool active = w_hi >= w_lo;
    LAS float* wsf = (LAS float*)(lds + AL_WS) + wid * 64;
    LAS float* cs = (LAS float*)(lds + AL_CS);
    LAS float* tab = (LAS float*)(lds + AL_TAB);
    LAS float* misc = (LAS float*)(lds + AL_MISC);
    lds_barrier();
    bf16x8 qr[4];
#pragma unroll
    for (int dk = 0; dk < 4; ++dk) qr[dk] = active ? *(const bf16x8*)(Qb + (size_t)(qrow + r32) * HW + h * 64 + dk * 16 + hi * 8) : (bf16x8){0, 0, 0, 0, 0, 0, 0, 0};
    const int srow = tid >> 3, sch = tid & 7;
    const unsigned kst = AL_K + srow * 144 + sch * 16, vst = AL_V + (sch >> 2) * 4096 + srow * 64 + (sch & 3) * 16;
    struct Stage { u32x4 k, v; f32x4 kf0, kf1, vf0, vf1; bool f; };
    Stage sA, sB; sA.f = false; sB.f = false;
    auto issue = [&](int tq, Stage& s) {
        const int t = tq > t_hi ? t_hi : tq;
        if (samp && t < CT) { const unsigned off = ((unsigned)(b * (64 * CT) + 64 * t + srow) * 8u + h) * 64u + sch * 8;
            s.kf0 = *(const f32x4*)(Kc + off); s.kf1 = *(const f32x4*)(Kc + off + 4); s.vf0 = *(const f32x4*)(Vc + off); s.vf1 = *(const f32x4*)(Vc + off + 4); s.f = true; }
        else { const unsigned row = samp ? (unsigned)(MP + b * DSEQ + srow) : (unsigned)(b * SEQ + 64 * t + srow); const unsigned off = row * HW + h * 64 + sch * 8;
            s.k = *(const u32x4*)(Kb + off); s.v = *(const u32x4*)(Vb + off); s.f = false; }
    };
    auto commit = [&](int buf, int t, Stage& s) {
        u32x4 kreg = s.k, vreg = s.v;
        if (s.f) { kreg.x = pk2(s.kf0[0], s.kf0[1]); kreg.y = pk2(s.kf0[2], s.kf0[3]); kreg.z = pk2(s.kf1[0], s.kf1[1]); kreg.w = pk2(s.kf1[2], s.kf1[3]);
                   vreg.x = pk2(s.vf0[0], s.vf0[1]); vreg.y = pk2(s.vf0[2], s.vf0[3]); vreg.z = pk2(s.vf1[0], s.vf1[1]); vreg.w = pk2(s.vf1[2], s.vf1[3]); }
        *(LAS u32x4*)(lds + kst + buf * AL_KB) = kreg; *(LAS u32x4*)(lds + vst + buf * AL_VB) = vreg;
        float* kd = nullptr; float* vd = nullptr;
        if (samp) { if (t == CT) { const unsigned o = (unsigned)(b * DSEQ + srow) * HW + h * 64 + sch * 8; kd = a.out + (KIND == 0 ? O_KA_S : O_KB_S) + o; vd = a.out + (KIND == 0 ? O_VA_S : O_VB_S) + o; } }
        else if (KIND == 1) { if (t >= 4 * blk) { const unsigned o = (unsigned)(b * SEQ + 64 * t + srow) * HW + h * 64 + sch * 8; kd = a.out + O_KB_P + o; vd = a.out + O_VB_P + o; } }
        else { if (t >= 4 * blk && t >= 24) { const unsigned o = (unsigned)(b * ALEN + 64 * (t - 24) + srow) * HW + h * 64 + sch * 8; kd = a.out + O_KA_P + o; vd = a.out + O_VA_P + o; } }
        if (kd) {
            *(f32x4*)kd = (f32x4){bflo(kreg.x), bfhi(kreg.x), bflo(kreg.y), bfhi(kreg.y)}; *(f32x4*)(kd + 4) = (f32x4){bflo(kreg.z), bfhi(kreg.z), bflo(kreg.w), bfhi(kreg.w)};
            *(f32x4*)vd = (f32x4){bflo(vreg.x), bfhi(vreg.x), bflo(vreg.y), bfhi(vreg.y)}; *(f32x4*)(vd + 4) = (f32x4){bflo(vreg.z), bfhi(vreg.z), bflo(vreg.w), bfhi(vreg.w)};
        }
    };
    issue(t_lo, sA); issue(t_lo + 1, sB);
    if (KIND == 0) {
        for (int i = tid; i < 257; i += 512) tab[i] = a.in[I_REL][h * 257 + i] * LOG2E;
    } else {
        const int n0 = samp ? PAST : 256 * (blk + 1);
        const float* src = samp ? a.in[I_CLF] + (size_t)b * PAST * 8 + h : a.out + O_LF_P + (size_t)b * SEQ * 8 + h;
        float v[4];
#pragma unroll
        for (int j = 0; j < 4; ++j) { const int idx = 4 * tid + j; v[j] = idx < n0 ? src[(size_t)idx * 8] : 0.f; }
        v[1] += v[0]; v[2] += v[1]; v[3] += v[2];
        float inc = v[3];
#pragma unroll
        for (int o = 1; o < 64; o <<= 1) { const float t = __shfl_up(inc, o); if (lane >= o) inc += t; }
        if (lane == 63) misc[wid] = inc;
        __syncthreads();
        float off = inc - v[3];
#pragma unroll
        for (int w = 0; w < 8; ++w) if (w < wid) off += misc[w];
        if (4 * tid < n0) { f32x4 o4 = {(off + v[0]) * LOG2E, (off + v[1]) * LOG2E, (off + v[2]) * LOG2E, (off + v[3]) * LOG2E}; *(LAS f32x4*)(cs + 4 * tid) = o4; }
        if (samp) {
            __syncthreads();
            if (wid == 0) {
                float x = a.out[O_LF_S + (size_t)(b * DSEQ + lane) * 8 + h];
#pragma unroll
                for (int o = 1; o < 64; o <<= 1) { const float t = __shfl_up(x, o); if (lane >= o) x += t; }
                cs[PAST + lane] = cs[PAST - 1] + x * LOG2E;
            }
        }
    }
    commit(0, t_lo, sA);
    __syncthreads();
    f32x16 o[2];
#pragma unroll
    for (int r = 0; r < 16; ++r) { o[0][r] = 0.f; o[1][r] = 0.f; }
    float mhat = (KIND == 1 && active) ? -cs[qpos] : 0.f;
    f32x16 lacc;
#pragma unroll
    for (int r = 0; r < 16; ++r) lacc[r] = 0.f;
    const unsigned lds0 = (unsigned)(uintptr_t)lds;
    const unsigned vb0 = lds0 + AL_V + ((lane >> 4) & 1) * 32 + (lane & 3) * 8 + (4 * hi + ((lane & 15) >> 2)) * 64;
    auto tile = [&](const int t, const int buf) {
        if (active && t >= w_lo && t <= w_hi) {
            const LAS unsigned char* Kt = lds + AL_K + buf * AL_KB + r32 * 144 + hi * 16;
            f32x16 p0, p1; const float nmh = -mhat;
            if (KIND == 0) {
                const int delta = cch - t;
                if (delta >= 3) { const float bb = tab[256] + nmh;
#pragma unroll
                    for (int r = 0; r < 16; ++r) { p0[r] = bb; p1[r] = bb; } }
                else { int base = 64 * delta + qpos - 4 * hi + 128; asm volatile("" : "+v"(base));
#pragma unroll
                    for (int r = 0; r < 16; ++r) { const int kv = (r & 3) + 8 * (r >> 2); int i0 = base - kv, i1 = base - kv - 32;
                        i0 = i0 < 0 ? 0 : (i0 > 256 ? 256 : i0); i1 = i1 < 0 ? 0 : (i1 > 256 ? 256 : i1); p0[r] = tab[i0] + nmh; p1[r] = tab[i1] + nmh; } }
            } else {
                const LAS float* ct = cs + 64 * t + 4 * hi;
#pragma unroll
                for (int g = 0; g < 4; ++g) { const f32x4 c0 = *(const LAS f32x4*)(ct + 8 * g), c1 = *(const LAS f32x4*)(ct + 32 + 8 * g);
#pragma unroll
                    for (int e = 0; e < 4; ++e) { p0[4 * g + e] = nmh - c0[e]; p1[4 * g + e] = nmh - c1[e]; } }
            }
#pragma unroll
            for (int dk = 0; dk < 4; ++dk) {
                const bf16x8 a0 = *(const LAS bf16x8*)(Kt + dk * 32), a1 = *(const LAS bf16x8*)(Kt + 32 * 144 + dk * 32);
                p0 = __builtin_amdgcn_mfma_f32_32x32x16_bf16(a0, qr[dk], p0, 0, 0, 0);
                p1 = __builtin_amdgcn_mfma_f32_32x32x16_bf16(a1, qr[dk], p1, 0, 0, 0);
            }
            if (KIND == 1) {
                if (t == w_hi) { int kb = 64 * t + 4 * hi - qpos; asm volatile("" : "+v"(kb));
#pragma unroll
                    for (int r = 0; r < 16; ++r) { const int kv = kb + (r & 3) + 8 * (r >> 2); if (kv > 0) p0[r] = -INFINITY; if (kv + 32 > 0) p1[r] = -INFINITY; } }
            }
            float mxa = fmaxf(p0[0], p1[0]), mxb = fmaxf(p0[1], p1[1]), mxc = fmaxf(p0[2], p1[2]), mxd = fmaxf(p0[3], p1[3]);
#pragma unroll
            for (int r = 4; r < 16; r += 4) { mxa = fmaxf(mxa, fmaxf(p0[r], p1[r])); mxb = fmaxf(mxb, fmaxf(p0[r + 1], p1[r + 1])); mxc = fmaxf(mxc, fmaxf(p0[r + 2], p1[r + 2])); mxd = fmaxf(mxd, fmaxf(p0[r + 3], p1[r + 3])); }
            float mx = halfswap_max(fmaxf(fmaxf(mxa, mxb), fmaxf(mxc, mxd)));
            if (__any(mx > 8.0f)) {
                const float dl = fmaxf(mx, 0.f); const float al = __builtin_amdgcn_exp2f(-dl); mhat += dl;
#pragma unroll
                for (int r = 0; r < 16; ++r) { p0[r] -= dl; p1[r] -= dl; }
                if (hi == 0) wsf[r32] = al;
#pragma unroll
                for (int g = 0; g < 4; ++g) { const f32x4 f = *(const LAS f32x4*)(wsf + 8 * g + 4 * hi);
#pragma unroll
                    for (int e = 0; e < 4; ++e) { o[0][4 * g + e] *= f[e]; o[1][4 * g + e] *= f[e]; lacc[4 * g + e] *= f[e]; } }
            }
#pragma unroll
            for (int r = 0; r < 16; ++r) { p0[r] = __builtin_amdgcn_exp2f(p0[r]); p1[r] = __builtin_amdgcn_exp2f(p1[r]); }
            u32x4 w0, w1, w2, w3;
            w0.x = pk2(p0[0], p0[1]); w0.y = pk2(p0[2], p0[3]); w0.z = pk2(p0[4], p0[5]); w0.w = pk2(p0[6], p0[7]);
            w1.x = pk2(p0[8], p0[9]); w1.y = pk2(p0[10], p0[11]); w1.z = pk2(p0[12], p0[13]); w1.w = pk2(p0[14], p0[15]);
            w2.x = pk2(p1[0], p1[1]); w2.y = pk2(p1[2], p1[3]); w2.z = pk2(p1[4], p1[5]); w2.w = pk2(p1[6], p1[7]);
            w3.x = pk2(p1[8], p1[9]); w3.y = pk2(p1[10], p1[11]); w3.z = pk2(p1[12], p1[13]); w3.w = pk2(p1[14], p1[15]);
            pv_step(o, lacc, vb0 + buf * AL_VB, __builtin_bit_cast(bf16x8, w0), __builtin_bit_cast(bf16x8, w1), __builtin_bit_cast(bf16x8, w2), __builtin_bit_cast(bf16x8, w3));
        }
    };
    for (int t = t_lo;;) {
        issue(t + 2, sA);
        tile(t, 0);
        if (t < t_hi) commit(1, t + 1, sB);
        lds_barrier();
        if (++t > t_hi) break;
        issue(t + 2, sB);
        tile(t, 1);
        if (t < t_hi) commit(0, t + 1, sA);
        lds_barrier();
        if (++t > t_hi) break;
    }
    unsigned nxt = 0u;
    if (tid == 0) nxt = atomicAdd(qctr, 1u);
    if (active) {
        float rl[16];
#pragma unroll
        for (int r = 0; r < 16; ++r) rl[r] = __builtin_amdgcn_rcpf(lacc[r]);
        LAS bf16_t* stg = (LAS bf16_t*)(lds + AL_K + wid * 4096);
#pragma unroll
        for (int r = 0; r < 16; ++r) { const int orow = crow(r, hi); stg[orow * 64 + r32] = (bf16_t)f2bf(o[0][r] * rl[r]); stg[orow * 64 + 32 + r32] = (bf16_t)f2bf(o[1][r] * rl[r]); }
#pragma unroll
        for (int i = 0; i < 4; ++i) { const int row = i * 8 + (lane >> 3), ch = lane & 7; const u32x4 v = *(const LAS u32x4*)(stg + row * 64 + ch * 8);
            *(u32x4*)(Ob + (size_t)(qrow + row) * HW + h * 64 + ch * 8) = v; }
    }
    if (tid == 0) *qnext = nxt;
}

__device__ __forceinline__ void phase_attention(const Args& a, LAS unsigned char* lds, const int wv) {
    const int tid = wv * 64 + lane_id();
    unsigned* ctr = (unsigned*)(a.ws + WS_CTL);
    LAS unsigned* sidx = (LAS unsigned*)(lds + AL_MISC + 64);
    __syncthreads();
    if (tid == 0) *sidx = atomicAdd(ctr, 1u);
    for (;;) {
        lds_barrier();
        const int i = (int)*sidx;
        if (i >= N_ATT_UNITS + N_TR_UNITS) break;
        if (i >= N_ATT_UNITS) {
            const int it = TI_IN + (i - N_ATT_UNITS) * 8 + wv;
            __syncthreads();
            int l2 = lane_id(); asm volatile("" : "+v"(l2));
            if (it < TI_ALL) transpose_item(a, it, (LAS float*)(lds + wv * 8448), l2);
            __syncthreads();
            if (tid == 0) *sidx = atomicAdd(ctr, 1u);
            continue;
        }
        if (i < 128) attn_unit<1>(a, lds, i >> 3, i & 7, 0, 1, wv, ctr, sidx);
        else if (i < 448) { const int j = i - 128; attn_unit<1>(a, lds, (j & 63) >> 3, j & 7, 7 - (j >> 6), 0, wv, ctr, sidx); }
        else if (i < 832) { const int j = i - 448; attn_unit<0>(a, lds, (j & 63) >> 3, j & 7, 7 - (j >> 6), 0, wv, ctr, sidx); }
        else if (i < 896) { const int j = i - 832; attn_unit<1>(a, lds, j >> 3, j & 7, 2, 0, wv, ctr, sidx); }
        else if (i < 1024) { const int j = i - 896; attn_unit<0>(a, lds, j >> 3, j & 7, 0, 1, wv, ctr, sidx); }
        else if (i < 1088) { const int j = i - 1024; attn_unit<0>(a, lds, j >> 3, j & 7, 1, 0, wv, ctr, sidx); }
        else if (i < 1152) { const int j = i - 1088; attn_unit<1>(a, lds, j >> 3, j & 7, 1, 0, wv, ctr, sidx); }
        else if (i < 1216) { const int j = i - 1152; attn_unit<1>(a, lds, j >> 3, j & 7, 0, 0, wv, ctr, sidx); }
        else { const int j = i - 1216; attn_unit<0>(a, lds, j >> 3, j & 7, 0, 0, wv, ctr, sidx); }
    }
}

#define XB_TMO      128
#define XB_XCNT(j)  (256  + 64 * (j))
#define XB_XSUB(j)  (1280 + 64 * (j))
#define XB_XGEN(j)  (2304 + 64 * (j))
#define XB_TOP      3328
#define XB_TOPGEN   3392
#define XCD_BAR_WORDS 3456
#define XB_SPIN_CAP (1u << 18)

__device__ __forceinline__ unsigned xb_ld(unsigned* p)              { return __hip_atomic_load(p, __ATOMIC_RELAXED, __HIP_MEMORY_SCOPE_AGENT); }
__device__ __forceinline__ unsigned xb_add(unsigned* p, unsigned v) { return __hip_atomic_fetch_add(p, v, __ATOMIC_RELAXED, __HIP_MEMORY_SCOPE_AGENT); }
__device__ __forceinline__ unsigned xb_xcc_id() { return (unsigned)__builtin_amdgcn_s_getreg((3 << 11) | 20) & 0xFu; }
#define XB_SPIN(cond, bar) do { unsigned _sp = 0; while (cond) { __builtin_amdgcn_s_sleep(1); \
    if ((++_sp & 255u) == 0u) { if (xb_ld(&(bar)[XB_TMO])) break; if (_sp > XB_SPIN_CAP) { atomicAdd(&(bar)[XB_TMO], 1u); break; } } } } while (0)

struct XcdBarrier {
    unsigned* bar; unsigned x; bool leader;
    volatile LAS unsigned* st;
};

__device__ __forceinline__ XcdBarrier xcd_barrier_post(unsigned* bar, volatile LAS unsigned* st, const bool leader) {
    XcdBarrier b; b.bar = bar; b.x = xb_xcc_id(); b.st = st; b.leader = leader;
    if (leader) (void)xb_add(&bar[XB_XCNT(b.x)], 1u);
    return b;
}
__device__ __forceinline__ void xcd_barrier_complete(unsigned* bar, unsigned x, unsigned& nloc, unsigned& nx) {
    const unsigned G = gridDim.x * gridDim.y * gridDim.z;
    unsigned sum, cnt, mine, sp = 0u;
    for (;;) {
        sum = 0u; cnt = 0u; mine = 0u;
#pragma unroll
        for (unsigned j = 0; j < 16; ++j) { const unsigned c = xb_ld(&bar[XB_XCNT(j)]); sum += c; cnt += (c > 0u) ? 1u : 0u; mine = (j == x) ? c : mine; }
        if (sum == G) break;
        __builtin_amdgcn_s_sleep(1);
        if ((++sp & 255u) == 0u) { if (xb_ld(&bar[XB_TMO])) break; if (sp > XB_SPIN_CAP) { atomicAdd(&bar[XB_TMO], 1u); break; } }
    }
    nloc = mine > 0u ? mine : 1u; nx = cnt > 0u ? cnt : 1u;
}

__device__ __forceinline__ void xcd_barrier(const XcdBarrier& b, const bool leader_now) {
    asm volatile("s_waitcnt vmcnt(0)" ::: "memory");
    __syncthreads();
    if (leader_now) {
        unsigned* bar = b.bar;
        __builtin_amdgcn_s_waitcnt(0);
        unsigned nloc = b.st[0], nx = b.st[1];
        if (nloc == 0u) { xcd_barrier_complete(bar, b.x, nloc, nx); b.st[0] = nloc; b.st[1] = nx; }
        const unsigned old = xb_add(&bar[XB_XSUB(b.x)], 1u);
        const unsigned gen = old / nloc;
        if (old + 1u == (gen + 1u) * nloc) {
            __builtin_amdgcn_fence(__ATOMIC_RELEASE, "agent");
            asm volatile("s_waitcnt vmcnt(0)" ::: "memory");
            const unsigned og = xb_add(&bar[XB_TOP], 1u);
            const unsigned tg = og / nx;
            if (og + 1u == (tg + 1u) * nx) xb_add(&bar[XB_TOPGEN], 1u);
            else XB_SPIN(xb_ld(&bar[XB_TOPGEN]) == tg, bar);
            __builtin_amdgcn_fence(__ATOMIC_ACQUIRE, "agent");
            xb_add(&bar[XB_XGEN(b.x)], 1u);
            asm volatile("s_waitcnt vmcnt(0)" ::: "memory");
        } else {
            XB_SPIN(xb_ld(&bar[XB_XGEN(b.x)]) == gen, bar);
            __builtin_amdgcn_fence(__ATOMIC_ACQUIRE, "agent");
            asm volatile("s_waitcnt vmcnt(0)" ::: "memory");
        }
    }
    __syncthreads();
}

constexpr int N_PHASES = 7;
__device__ __forceinline__ void grid_bar(unsigned* bar, unsigned& epoch, const int wv, const unsigned nblocks) {
    __syncthreads();
    epoch += 1;
    if (wv == 0 && lane_id() == 0) {
        __builtin_amdgcn_fence(__ATOMIC_RELEASE, "agent");
        asm volatile("s_waitcnt vmcnt(0)" ::: "memory");
        __hip_atomic_fetch_add(bar, 1u, __ATOMIC_RELAXED, __HIP_MEMORY_SCOPE_AGENT);
        const unsigned target = epoch * nblocks;
        while (__hip_atomic_load(bar, __ATOMIC_RELAXED, __HIP_MEMORY_SCOPE_AGENT) < target) __builtin_amdgcn_s_sleep(2);
        __builtin_amdgcn_fence(__ATOMIC_ACQUIRE, "agent");
        asm volatile("s_waitcnt vmcnt(0)" ::: "memory");
    }
    __syncthreads();
}
__global__ void __launch_bounds__(512, 2) mega_fwd(Args a) {
    extern __shared__ __attribute__((aligned(16))) unsigned char lds_raw[];
    LAS unsigned char* lds = (LAS unsigned char*)lds_raw;
    unsigned char* ws = a.ws;
    const int lo = a.ph_lo, hi = a.ph_hi, G = gridDim.x, c = (int)blockIdx.x;
    const int wv = __builtin_amdgcn_readfirstlane((int)threadIdx.x >> 6);
    volatile LAS unsigned* bst = (volatile LAS unsigned*)(lds + RING_BYTES + 12288);
    if (threadIdx.x < 2) bst[threadIdx.x] = 0u;
    __syncthreads();
    XcdBarrier xbar; xbar.bar = (unsigned*)(ws + WS_CTL) + 1024; xbar.x = 0; xbar.st = bst; xbar.leader = false;
    if (a.coop == 2) cg::this_grid().sync();
    if (a.coop) xbar = xcd_barrier_post((unsigned*)(ws + WS_CTL) + 1024, bst, wv == 0 && lane_id() == 0);
#define IN(k) (lo <= (k) && (k) < hi)
#define SEAM(k) do { if (IN(k) && IN((k) + 1)) { if (a.coop) { xcd_barrier(xbar, wv == 0 && lane_id() == 0); } } } while (0)
    if (IN(0)) phase_prologue(a, lds, wv);
    SEAM(0);
    if (IN(1)) {
        pg8::Gemm g{(const bf16_t*)(ws + WS_H), (const bf16_t*)(ws + WS_WIN), MP, NIN, DM}; pg8::StaticOrder S; S.init(MP, NIN, G, c);
        EpiIn E{ws, a.out};
        pg8::gemm_phase<EpiIn, pg8::StaticOrder, true, true>(lds, g, S, E, wv);
        small_gemm_a4<EpiIn>(lds, g.A, g.Bt, NIN, E, wv);
    }
    SEAM(1);
    if (IN(2)) phase_attention(a, lds, wv);
    SEAM(2);
    if (IN(3)) {
        { pg8::Gemm g{(const bf16_t*)(ws + WS_OA), (const bf16_t*)(ws + WS_WPA), MP, DM, HW}; pg8::StaticOrder S; S.init(MP, DM, G, c);
          EpiProjA E{(const unsigned char*)(ws + WS_GA), (bf16_t*)(ws + WS_T)};
          pg8::gemm_phase<EpiProjA, pg8::StaticOrder, true, true>(lds, g, S, E, wv);
          small_gemm<EpiProjA>(lds, g.A, g.Bt, HW, DM, E, wv); }
        { pg8::Gemm g{(const bf16_t*)(ws + WS_OB), (const bf16_t*)(ws + WS_WPB), MP, DM, HW}; pg8::StaticOrder S; S.init(MP, DM, G, c);
          EpiProjB E{(const unsigned char*)(ws + WS_GB), (const bf16_t*)(ws + WS_T), (bf16_t*)(ws + WS_MG)};
          pg8::gemm_phase<EpiProjB, pg8::StaticOrder, true, true>(lds, g, S, E, wv);
          small_gemm<EpiProjB>(lds, g.A, g.Bt, HW, DM, E, wv); }
    }
    SEAM(3);
    if (IN(4)) {
        pg8::Gemm g{(const bf16_t*)(ws + WS_MG), (const bf16_t*)(ws + WS_WOUT), MP, DM, DM}; pg8::StaticOrder S; S.init(MP, DM, G, c);
        EpiOutNorm EN{a.in[I_XP], a.out + O_Y, (bf16_t*)(ws + WS_H), a.in[I_G2], a.in[I_G3], RowStat{(float*)(ws + WS_XB1), (unsigned*)(ws + WS_CTL) + CW_CNT1}, RowStat{(float*)(ws + WS_XB2), (unsigned*)(ws + WS_CTL) + CW_CNT2}};
        pg8::gemm_phase<EpiOutNorm, pg8::StaticOrder, false, true>(lds, g, S, EN, wv);
        __syncthreads();
        small_gemm_norm<0>(lds, g.A, g.Bt, DM, a.in[I_XS], a.out + O_Y, (bf16_t*)(ws + WS_H), a.in[I_G2], a.in[I_G3],
                           TailStat{(float*)(ws + WS_XT1), (unsigned*)(ws + WS_CTL) + CW_TC1}, TailStat{(float*)(ws + WS_XT2), (unsigned*)(ws + WS_CTL) + CW_TC2}, wv);
    }
    SEAM(4);
    if (IN(5)) {
        pg8::Gemm g{(const bf16_t*)(ws + WS_H), (const bf16_t*)(ws + WS_WUP), MTOK, NUP, DM}; pg8::StaticOrder S; S.init(MTOK, NUP, G, c);
        EpiUpFused E{(bf16_t*)(ws + WS_A2), a.out, a.in[I_CW], a.in[I_CB], a.in[I_CONV], (float*)(ws + WS_HEAD), (float*)(ws + WS_TAIL), (LAS float*)(lds + RING_BYTES)};
        pg8::gemm_phase<EpiUpFused, pg8::StaticOrder, true, true>(lds, g, S, E, wv);
    }
    SEAM(5);
    if (IN(6)) {
        pg8::Gemm g{(const bf16_t*)(ws + WS_A2), (const bf16_t*)(ws + WS_WDN), MP, DM, DFF}; pg8::StaticOrder S; S.init(MP, DM, G, c);
        { Unit fu; for (int i = 0; S.next(i, fu); ++i) ffn_fixup(a, fu.pm, wv * 64 + lane_id()); }
        __syncthreads();
        EpiDownNorm EN{a.out + O_Y, a.in[I_G4], RowStat{(float*)(ws + WS_XB3), (unsigned*)(ws + WS_CTL) + CW_CNT3}};
        pg8::gemm_phase<EpiDownNorm, pg8::StaticOrder, false, true>(lds, g, S, EN, wv);
        __syncthreads();
        small_gemm_norm<1>(lds, g.A, g.Bt, DFF, nullptr, a.out + O_Y, nullptr, a.in[I_G4], nullptr,
                           TailStat{(float*)(ws + WS_XT3), (unsigned*)(ws + WS_CTL) + CW_TC3}, TailStat{nullptr, nullptr}, wv);
    }
#undef IN
#undef SEAM
}

#ifndef MK_N_LAUNCHES
#define MK_N_LAUNCHES 1
#endif
extern "C" void kernel_launch(void* const* d_in, const int* in_sizes, int n_in, void* d_out, int out_size, void* d_ws, size_t ws_size, hipStream_t stream) {
    static int grid = 0;
    if (grid == 0) {
        if (n_in != 22 || (size_t)out_size != O_END || ws_size < WS_END) { fprintf(stderr, "kernel_launch: unexpected sizes n_in %d out %d ws %zu\n", n_in, out_size, ws_size); grid = -1; return; }
        int dev = 0, cus = 0, per_cu = 0;
        hipGetDevice(&dev);
        hipDeviceGetAttribute(&cus, hipDeviceAttributeMultiprocessorCount, dev);
        hipFuncSetAttribute((const void*)mega_fwd, hipFuncAttributeMaxDynamicSharedMemorySize, LDS_BYTES);
        hipOccupancyMaxActiveBlocksPerMultiprocessor(&per_cu, (const void*)mega_fwd, 512, LDS_BYTES);
        if (per_cu < 1) { fprintf(stderr, "kernel_launch: occupancy query says %d blocks/CU\n", per_cu); per_cu = 1; }
        (void)hipGetLastError();
        grid = cus;
        if (grid != 256) { fprintf(stderr, "kernel_launch: built for 256 CUs (one 256x256 unit per workgroup in the fused-norm GEMMs), device has %d\n", grid); grid = -1; return; }
    }
    if (grid < 0) return;
    hipMemsetAsync((char*)d_ws + WS_CTL, 0, CTL_BYTES, stream);
    Args a{};
    for (int i = 0; i < 22; ++i) a.in[i] = (const float*)d_in[i];
    a.out = (float*)d_out; a.ws = (unsigned char*)d_ws;
#if MK_N_LAUNCHES == 1
    a.ph_lo = 0; a.ph_hi = N_PHASES; a.coop = 1; a.pad = 0;
    void* args[] = {&a};
    hipError_t e = hipLaunchCooperativeKernel((const void*)mega_fwd, dim3(grid), dim3(512), args, LDS_BYTES, stream);
    if (e != hipSuccess) fprintf(stderr, "cooperative launch failed: %s (grid %d)\n", hipGetErrorString(e), grid);
#else
    for (int p = 0; p < N_PHASES; ++p) {
        a.ph_lo = p; a.ph_hi = p + 1; a.coop = 0; a.pad = 0;
        hipLaunchKernelGGL(mega_fwd, dim3(grid), dim3(512), LDS_BYTES, stream, a);
    }
#endif
}
```

```cpp
#include <hip/hip_runtime.h>
#include <hip/hip_cooperative_groups.h>
#include <cstdio>
#include <cstdint>
namespace cg = cooperative_groups;
namespace pg8 {
#define PG8_LAS __attribute__((address_space(3)))
typedef unsigned short bf16_t;
typedef short bf16x8 __attribute__((ext_vector_type(8)));
typedef float f32x4 __attribute__((ext_vector_type(4)));
typedef unsigned u32x4 __attribute__((ext_vector_type(4)));
constexpr int BM = 256, BK = 64, HALF = 128, HTB = HALF * BK * 2  , STAGE_BYTES = 8 * HTB, NXCD = 8, WGM = 8;

__host__ __device__ __forceinline__ int lds_byte(int r, int c) { const int st = (r >> 4) * 2 + (c >> 5), rr = r & 15, cc = c & 31, ob = rr * 64 + cc * 2; return st * 1024 + (ob ^ (((ob >> 9) & 1) << 5)); }
__host__ __device__ __forceinline__ void stage_rc(int b, int& R, int& C) { const int st = b / 1024, sb = b % 1024, swz = sb ^ (((sb >> 9) & 1) << 5); R = (st >> 1) * 16 + swz / 64; C = (st & 1) * 32 + (swz % 64) / 2; }
__host__ __device__ __forceinline__ int perm32(int rho) { const int n = rho >> 4, i = rho & 15; return 8 * (i >> 2) + 4 * n + (i & 3); }

struct Unit { int pm, pn; };
struct Gemm { const bf16_t* A; const bf16_t* Bt; int M, N, K; };

struct StaticOrder {
    int nM, nN, nwg, G, c;
    __host__ __device__ void init(int M, int N, int G_, int c_) { nM = M / BM; nN = N / BM; nwg = nM * nN; G = G_; c = c_; }
    __host__ __device__ __forceinline__ bool next(int i, Unit& u) const {
        const long L = (long)i * G + c; if (L >= nwg) return false;
        int wgid = (int)L; { const int q = nwg / NXCD, r = nwg % NXCD, xcd = wgid % NXCD, off = wgid / NXCD; wgid = (xcd < r ? xcd * (q + 1) : r * (q + 1) + (xcd - r) * q) + off; }
        const int nig = WGM * nN, gid = wgid / nig, fm = gid * WGM, gsz = (nM - fm) < WGM ? (nM - fm) : WGM;
        u.pm = fm + ((wgid % nig) % gsz); u.pn = (wgid % nig) / gsz; return true;
    }
    __device__ __forceinline__ void a_ready(const Unit&) const {}
    __device__ __forceinline__ void done(const Unit&) const {}
};

__device__ __forceinline__ unsigned cvt_pk_bf16(float lo, float hi) { unsigned r; asm volatile("v_cvt_pk_bf16_f32 %0, %1, %2" : "=v"(r) : "v"(lo), "v"(hi)); return r; }
typedef float f32x2 __attribute__((ext_vector_type(2)));
template <class Epi, class Sched, bool ALIGN_EPI = false, bool SP2 = false>
__device__ __forceinline__ void gemm_phase(PG8_LAS unsigned char* lds, const Gemm g, const Sched& S, const Epi& E, const int wv) {
    const int wid = wv, lane = (int)__builtin_amdgcn_mbcnt_hi(~0u, __builtin_amdgcn_mbcnt_lo(~0u, 0u)), tid = wid * 64 + lane, wr = wid >> 2, wc = wid & 3, fr = lane & 15, fq = lane >> 4;
    const int K = g.K, nt = K / BK;
    unsigned voffA[2], voffB[2];
#pragma unroll
    for (int i = 0; i < 2; ++i) { int R, C; stage_rc(tid * 16 + i * 8192, R, C); const int Rb = Epi::PERM ? ((R & ~31) + perm32(R & 31)) : R;
        voffA[i] = (unsigned)(R * K + C) * 2u; voffB[i] = (unsigned)(Rb * K + C) * 2u; }
    const size_t kstep = (size_t)(BK * 2);
    const size_t hstep = (size_t)HALF * K * 2;
    const size_t tstep = 2 * hstep;
    const unsigned ldsw = (unsigned)wid * 1024u;
    const int aoff = lds_byte(wr * 64 + fr, fq * 8), boff = lds_byte(wc * 32 + fr, fq * 8);
#define PG8_SA(b, h) (((b) * 2 + (h)) * HTB)
#define PG8_SB(b, h) ((4 + (b) * 2 + (h)) * HTB)
#define PG8_STAGE(bufoff, gbase, voff) do { _Pragma("unroll") for (int _i = 0; _i < 2; ++_i) \
        __builtin_amdgcn_global_load_lds((const unsigned*)((const char*)(gbase) + (voff)[_i]), (PG8_LAS unsigned*)(lds + (bufoff) + ldsw + _i * 8192), 16, 0, 0); } while (0)
#define PG8_LDA(dst, b, h) do { _Pragma("unroll") for (int m = 0; m < 4; ++m) _Pragma("unroll") for (int k = 0; k < 2; ++k) dst[m][k] = *(const PG8_LAS bf16x8*)(lds + PG8_SA(b, h) + aoff + m * 2048 + k * 1024); } while (0)
#define PG8_LDB(dst, b, h) do { _Pragma("unroll") for (int n = 0; n < 2; ++n) _Pragma("unroll") for (int k = 0; k < 2; ++k) dst[n][k] = *(const PG8_LAS bf16x8*)(lds + PG8_SB(b, h) + boff + n * 2048 + k * 1024); } while (0)
#define PG8_MMA(ai, bj, At, Bt) do { __builtin_amdgcn_s_setprio(1); _Pragma("unroll") for (int m = 0; m < 4; ++m) _Pragma("unroll") for (int n = 0; n < 2; ++n) _Pragma("unroll") for (int k = 0; k < 2; ++k) \
        acc[ai][bj][m][n] = __builtin_amdgcn_mfma_f32_16x16x32_bf16(Bt[n][k], At[m][k], acc[ai][bj][m][n], 0, 0, 0); __builtin_amdgcn_s_setprio(0); } while (0)
#define PG8_WAIT_V(n) asm volatile("s_waitcnt vmcnt(" #n ")" ::: "memory")
#define PG8_WAIT_L(n) asm volatile("s_waitcnt lgkmcnt(" #n ")" ::: "memory")
#define PG8_BAR __builtin_amdgcn_s_barrier()
#define PG8_SCHED __builtin_amdgcn_sched_barrier(0)
    Unit cur, nxt; int ui = 0;
    if (!S.next(0, cur)) return;
    f32x4 acc[2][2][4][2];
#pragma unroll
    for (int a = 0; a < 2; ++a)
#pragma unroll
        for (int b = 0; b < 2; ++b)
#pragma unroll
            for (int m = 0; m < 4; ++m)
#pragma unroll
                for (int n = 0; n < 2; ++n) acc[a][b][m][n] = (f32x4){0.f, 0.f, 0.f, 0.f};
    bf16x8 At[4][2], B0[2][2], B1[2][2];
    const char* cA = (const char*)g.A + (size_t)cur.pm * tstep; const char* cB = (const char*)g.Bt + (size_t)cur.pn * tstep;
    S.a_ready(cur);
    if constexpr (SP2) {
        PG8_STAGE(PG8_SB(0, 0), cB, voffB); PG8_STAGE(PG8_SB(0, 1), cB + hstep, voffB); PG8_STAGE(PG8_SA(0, 0), cA, voffA); PG8_STAGE(PG8_SA(0, 1), cA + hstep, voffA);
        if (wr == 1) PG8_BAR;
        PG8_WAIT_V(2); PG8_BAR;
        PG8_STAGE(PG8_SB(1, 0), cB + kstep, voffB); PG8_STAGE(PG8_SA(1, 0), cA + kstep, voffA); PG8_STAGE(PG8_SB(1, 1), cB + hstep + kstep, voffB);
        PG8_WAIT_V(6); PG8_BAR;
    } else {
        PG8_STAGE(PG8_SB(0, 0), cB, voffB); PG8_STAGE(PG8_SA(0, 0), cA, voffA); PG8_STAGE(PG8_SB(0, 1), cB + hstep, voffB); PG8_STAGE(PG8_SA(0, 1), cA + hstep, voffA);
        if (wr == 1) PG8_BAR;
        PG8_WAIT_V(4); PG8_BAR;
        PG8_STAGE(PG8_SB(1, 0), cB + kstep, voffB); PG8_STAGE(PG8_SA(1, 0), cA + kstep, voffA); PG8_STAGE(PG8_SB(1, 1), cB + hstep + kstep, voffB);
        PG8_WAIT_V(6); PG8_BAR;
    }
    for (;;) {
        const bool has_next = S.next(ui + 1, nxt);
        const char* nA = has_next ? (const char*)g.A + (size_t)nxt.pm * tstep : cA; const char* nB = has_next ? (const char*)g.Bt + (size_t)nxt.pn * tstep : cB;
        for (int t = 0; t < nt; t += 2) {
            const bool last = (t == nt - 2);
            const char* a1 = cA + (size_t)(t + 1) * kstep;
            const char* a2 = last ? nA : cA + (size_t)(t + 2) * kstep; const char* b2 = last ? nB : cB + (size_t)(t + 2) * kstep;
            const char* a3 = a2 + kstep; const char* b3 = b2 + kstep;
            if (last && has_next) S.a_ready(nxt);
            if constexpr (SP2) {
            PG8_LDB(B0, 0, 0); PG8_LDB(B1, 0, 1); PG8_SCHED; PG8_LDA(At, 0, 0); PG8_STAGE(PG8_SA(1, 1), a1 + hstep, voffA);
            PG8_WAIT_V(8); PG8_WAIT_L(0); PG8_BAR; PG8_MMA(0, 0, At, B0); PG8_MMA(0, 1, At, B1); PG8_BAR; PG8_SCHED;
            PG8_LDA(At, 0, 1); PG8_STAGE(PG8_SB(0, 0), b2, voffB); PG8_STAGE(PG8_SB(0, 1), b2 + hstep, voffB); PG8_STAGE(PG8_SA(0, 0), a2, voffA);
            PG8_WAIT_V(8); PG8_WAIT_L(0); PG8_BAR; PG8_MMA(1, 0, At, B0); PG8_MMA(1, 1, At, B1); PG8_BAR; PG8_SCHED;
            PG8_LDB(B0, 1, 0); PG8_LDB(B1, 1, 1); PG8_SCHED; PG8_LDA(At, 1, 0); PG8_STAGE(PG8_SA(0, 1), a2 + hstep, voffA);
            PG8_WAIT_V(8); PG8_WAIT_L(0); PG8_BAR; PG8_MMA(0, 0, At, B0); PG8_MMA(0, 1, At, B1); PG8_BAR; PG8_SCHED;
            PG8_LDA(At, 1, 1); PG8_STAGE(PG8_SB(1, 0), b3, voffB); PG8_STAGE(PG8_SB(1, 1), b3 + hstep, voffB); PG8_STAGE(PG8_SA(1, 0), a3, voffA);
            PG8_WAIT_V(8); PG8_WAIT_L(0); PG8_BAR; PG8_MMA(1, 0, At, B0); PG8_MMA(1, 1, At, B1); PG8_BAR; PG8_SCHED;
            } else {
            PG8_LDB(B0, 0, 0); PG8_SCHED; PG8_LDA(At, 0, 0); PG8_STAGE(PG8_SA(1, 1), a1 + hstep, voffA);
            PG8_WAIT_L(8); PG8_BAR; PG8_WAIT_L(0); PG8_MMA(0, 0, At, B0); PG8_BAR; PG8_SCHED;
            PG8_LDB(B1, 0, 1); PG8_STAGE(PG8_SB(0, 0), b2, voffB);
            PG8_BAR; PG8_WAIT_L(0); PG8_MMA(0, 1, At, B1); PG8_BAR;
            PG8_LDA(At, 0, 1); PG8_STAGE(PG8_SA(0, 0), a2, voffA);
            PG8_BAR; PG8_WAIT_L(0); PG8_MMA(1, 0, At, B0); PG8_BAR; PG8_SCHED;
            PG8_STAGE(PG8_SB(0, 1), b2 + hstep, voffB);
            PG8_WAIT_V(6); PG8_BAR; PG8_MMA(1, 1, At, B1); PG8_BAR;
            PG8_LDB(B0, 1, 0); PG8_SCHED; PG8_LDA(At, 1, 0); PG8_STAGE(PG8_SA(0, 1), a2 + hstep, voffA);
            PG8_WAIT_L(8); PG8_BAR; PG8_WAIT_L(0); PG8_MMA(0, 0, At, B0); PG8_BAR; PG8_SCHED;
            PG8_LDB(B1, 1, 1); PG8_STAGE(PG8_SB(1, 0), b3, voffB);
            PG8_BAR; PG8_WAIT_L(0); PG8_MMA(0, 1, At, B1); PG8_BAR;
            PG8_LDA(At, 1, 1); PG8_STAGE(PG8_SA(1, 0), a3, voffA);
            PG8_BAR; PG8_WAIT_L(0); PG8_MMA(1, 0, At, B0); PG8_BAR; PG8_SCHED;
            PG8_STAGE(PG8_SB(1, 1), b3 + hstep, voffB);
            PG8_WAIT_V(6); PG8_BAR; PG8_MMA(1, 1, At, B1); PG8_BAR;
            }
        }
        if constexpr (ALIGN_EPI) { if (wr == 0) PG8_BAR; }
        if constexpr (!Epi::AFTER_DRAIN) { E(acc, cur, wr, wc, fr, fq); S.done(cur); }
        if (!has_next) break;
#pragma unroll
        for (int a = 0; a < 2; ++a)
#pragma unroll
            for (int b = 0; b < 2; ++b)
#pragma unroll
                for (int m = 0; m < 4; ++m)
#pragma unroll
                    for (int n = 0; n < 2; ++n) acc[a][b][m][n] = (f32x4){0.f, 0.f, 0.f, 0.f};
        cur = nxt; cA = nA; cB = nB; ++ui;
        if constexpr (ALIGN_EPI) { if (wr == 1) PG8_BAR; }
    }
    PG8_WAIT_V(0);
    if constexpr (!ALIGN_EPI) { if (wr == 0) PG8_BAR; }
    PG8_BAR;
    if constexpr (Epi::AFTER_DRAIN) { E.fused(acc, cur, wr, wc, fr, fq, lds, wid, lane); S.done(cur); }
#undef PG8_SA
#undef PG8_SB
#undef PG8_STAGE
#undef PG8_LDA
#undef PG8_LDB
#undef PG8_MMA
#undef PG8_WAIT_V
#undef PG8_WAIT_L
#undef PG8_BAR
#undef PG8_SCHED
}
}

#define LAS __attribute__((address_space(3)))
using pg8::bf16_t; using pg8::bf16x8; using pg8::f32x4; using pg8::u32x4; using pg8::Unit;
typedef float f32x16 __attribute__((ext_vector_type(16)));
typedef short s16x4 __attribute__((ext_vector_type(4)));
typedef unsigned u32x2 __attribute__((ext_vector_type(2)));

constexpr int DM = 1024, NBAT = 8, SEQ = 2048, DBAT = 16, DSEQ = 64, PAST = 2048, ALEN = 512;
constexpr int MP = NBAT * SEQ, MS = DBAT * DSEQ, MTOK = MP + MS;
constexpr int HW = 512;
constexpr int NIN = 5120;
constexpr int DFF = 2816, NUP = 2 * DFF;
constexpr float EPS = 1e-6f, LOG2E = 1.4426950408889634f, QSCALE = 0.125f * LOG2E;

constexpr size_t O_Y = 0;
constexpr size_t O_KA_P = (size_t)MTOK * DM;
constexpr size_t O_VA_P = O_KA_P + (size_t)NBAT * ALEN * HW;
constexpr size_t O_KB_P = O_VA_P + (size_t)NBAT * ALEN * HW;
constexpr size_t O_VB_P = O_KB_P + (size_t)NBAT * SEQ * HW;
constexpr size_t O_LF_P = O_VB_P + (size_t)NBAT * SEQ * HW;
constexpr size_t O_CV_P = O_LF_P + (size_t)NBAT * SEQ * 8;
constexpr size_t O_KA_S = O_CV_P + (size_t)NBAT * 2 * NUP;
constexpr size_t O_VA_S = O_KA_S + (size_t)MS * HW;
constexpr size_t O_KB_S = O_VA_S + (size_t)MS * HW;
constexpr size_t O_VB_S = O_KB_S + (size_t)MS * HW;
constexpr size_t O_LF_S = O_VB_S + (size_t)MS * HW;
constexpr size_t O_CV_S = O_LF_S + (size_t)MS * 8;
constexpr size_t O_END = O_CV_S + (size_t)DBAT * 2 * NUP;
static_assert(O_END == 41304064, "output size");

constexpr size_t MiB = 1u << 20;
constexpr size_t WS_CTL = 0, CTL_BYTES = 131072;
constexpr int CW_CNT1 = 8192, CW_CNT2 = 12288, CW_CNT3 = 16384, CW_TC1 = 20480, CW_TC2 = 21504, CW_TC3 = 22528;
constexpr size_t WS_WIN = 1 * MiB, WS_WUP = 11 * MiB, WS_WDN = 22 * MiB, WS_WOUT = 28 * MiB, WS_WPA = 30 * MiB, WS_WPB = 31 * MiB;
constexpr size_t WS_H = 32 * MiB;
constexpr size_t WS_OA = 32 * MiB, WS_OB = 236 * MiB;
constexpr size_t WS_QKV = 66 * MiB;
constexpr size_t QKV_STRIDE = (size_t)MTOK * HW;
constexpr size_t WS_GA = 168 * MiB, WS_GB = 202 * MiB;
constexpr size_t WS_T = 66 * MiB;
constexpr size_t WS_X1 = 100 * MiB;
constexpr size_t WS_MG = 134 * MiB;
constexpr size_t WS_U = 66 * MiB;
constexpr size_t WS_A2 = 160 * MiB;
constexpr size_t WS_HEAD = 254 * MiB, WS_TAIL = 258 * MiB;
constexpr size_t WS_XB1 = 262 * MiB, WS_XB2 = WS_XB1 + 262144, WS_XB3 = WS_XB2 + 262144;
constexpr size_t WS_XT1 = WS_XB3 + 262144, WS_XT2 = WS_XT1 + 65536, WS_XT3 = WS_XT2 + 65536;
constexpr size_t WS_END = 264 * MiB;
static_assert(WS_A2 + (size_t)MTOK * DFF * 2 <= WS_END && WS_U + (size_t)MTOK * DFF * 2 <= WS_A2, "ws map");

constexpr int RING_BYTES = 131072, LDS_BYTES = 147456;

struct Args { const float* in[22]; float* out; unsigned char* ws; int ph_lo, ph_hi, coop, pad; };
enum { I_XP = 0, I_XS, I_CKA, I_CVA, I_CKB, I_CVB, I_CLF, I_CONV, I_G1, I_G2, I_G3, I_G4, I_WIN, I_BF, I_REL, I_WPA, I_WPB, I_WOUT, I_WUP, I_CW, I_CB, I_WDN };

__device__ __forceinline__ void lds_barrier() { asm volatile("s_waitcnt lgkmcnt(0)" ::: "memory"); __builtin_amdgcn_s_barrier(); asm volatile("" ::: "memory"); }
__device__ __forceinline__ int lane_id() { return (int)__builtin_amdgcn_mbcnt_hi(~0u, __builtin_amdgcn_mbcnt_lo(~0u, 0u)); }
__device__ __forceinline__ unsigned f2bf(float f) { unsigned u = __builtin_bit_cast(unsigned, f); return (u + 0x7fffu + ((u >> 16) & 1u)) >> 16; }
__device__ __forceinline__ unsigned pk2(float lo, float hi) { return pg8::cvt_pk_bf16(lo, hi); }
__device__ __forceinline__ float bflo(unsigned w) { return __uint_as_float(w << 16); }
__device__ __forceinline__ float bfhi(unsigned w) { return __uint_as_float(w & 0xffff0000u); }
__device__ __forceinline__ float wave_sum(float v) {
#pragma unroll
    for (int o = 1; o < 64; o <<= 1) v += __shfl_xor(v, o);
    return v;
}
__device__ __forceinline__ float sigmoidf_(float x) { return __builtin_amdgcn_rcpf(1.0f + __builtin_amdgcn_exp2f(-x * LOG2E)); }
__device__ __forceinline__ const float* xrow_ptr(const Args& a, int m) { return m < MP ? a.in[I_XP] + (size_t)m * DM : a.in[I_XS] + (size_t)(m - MP) * DM; }

#define EPI_MAIN_CALL \
    __device__ __forceinline__ void operator()(const f32x4 (&acc)[2][2][4][2], const Unit& u, int wr, int wc, int fr, int fq) const { \
        _Pragma("unroll") for (int ai = 0; ai < 2; ++ai) _Pragma("unroll") for (int m = 0; m < 4; ++m) { \
            const int row = u.pm * 256 + ai * 128 + wr * 64 + m * 16 + fr; \
            _Pragma("unroll") for (int bj = 0; bj < 2; ++bj) store8(row, u.pn * 256 + bj * 128 + wc * 32 + 8 * fq, acc[ai][bj][m][0], acc[ai][bj][m][1]); } }
struct EpiIn {
    static constexpr bool PERM = true, AFTER_DRAIN = false;
    unsigned char* ws; float* out;
    __device__ __forceinline__ void store8(int row, int col, f32x4 v0, f32x4 v1) const {
        const int pn = col >> 8, seg = pn >> 1;
        bf16_t* bdst; int pitch, cl; float sc = 1.f; const bool sig = pn >= 12;
        if (!sig) { bdst = (bf16_t*)(ws + WS_QKV) + (size_t)seg * QKV_STRIDE; pitch = HW; cl = col & 511; if (seg == 0 || seg == 3) sc = QSCALE; }
        else { bdst = (bf16_t*)(ws + (pn < 16 ? WS_GA : WS_GB)); pitch = DM; cl = (col - 3072) & 1023; }
        if (sig) {
#pragma unroll
            for (int e = 0; e < 4; ++e) { v0[e] = sigmoidf_(v0[e]); v1[e] = sigmoidf_(v1[e]); }
        } else { v0 = v0 * sc; v1 = v1 * sc; }
        u32x4 w; w.x = pk2(v0[0], v0[1]); w.y = pk2(v0[2], v0[3]); w.z = pk2(v1[0], v1[1]); w.w = pk2(v1[2], v1[3]);
        *(u32x4*)(bdst + (size_t)row * pitch + cl) = w;
    }
    EPI_MAIN_CALL
};
struct EpiProjA {
    static constexpr bool PERM = true, AFTER_DRAIN = false;
    const bf16_t* G; bf16_t* T;
    __device__ __forceinline__ void store8(int row, int c, f32x4 v0, f32x4 v1) const {
        const u32x4 g = *(const u32x4*)(G + (size_t)row * DM + c);
        v0[0] *= bflo(g.x); v0[1] *= bfhi(g.x); v0[2] *= bflo(g.y); v0[3] *= bfhi(g.y);
        v1[0] *= bflo(g.z); v1[1] *= bfhi(g.z); v1[2] *= bflo(g.w); v1[3] *= bfhi(g.w);
        u32x4 w; w.x = pk2(v0[0], v0[1]); w.y = pk2(v0[2], v0[3]); w.z = pk2(v1[0], v1[1]); w.w = pk2(v1[2], v1[3]);
        *(u32x4*)(T + (size_t)row * DM + c) = w;
    }
    EPI_MAIN_CALL
};
struct EpiProjB {
    static constexpr bool PERM = true, AFTER_DRAIN = false;
    const bf16_t* G; const bf16_t* T; bf16_t* MG;
    __device__ __forceinline__ void store8(int row, int c, f32x4 v0, f32x4 v1) const {
        const u32x4 g = *(const u32x4*)(G + (size_t)row * DM + c);
        const u32x4 tw = *(const u32x4*)(T + (size_t)row * DM + c);
        const f32x4 t0 = {bflo(tw.x), bfhi(tw.x), bflo(tw.y), bfhi(tw.y)}, t1 = {bflo(tw.z), bfhi(tw.z), bflo(tw.w), bfhi(tw.w)};
        v0[0] = t0[0] + v0[0] * bflo(g.x); v0[1] = t0[1] + v0[1] * bfhi(g.x); v0[2] = t0[2] + v0[2] * bflo(g.y); v0[3] = t0[3] + v0[3] * bfhi(g.y);
        v1[0] = t1[0] + v1[0] * bflo(g.z); v1[1] = t1[1] + v1[1] * bfhi(g.z); v1[2] = t1[2] + v1[2] * bflo(g.w); v1[3] = t1[3] + v1[3] * bfhi(g.w);
        u32x4 w; w.x = pk2(v0[0], v0[1]); w.y = pk2(v0[2], v0[3]); w.z = pk2(v1[0], v1[1]); w.w = pk2(v1[2], v1[3]);
        *(u32x4*)(MG + (size_t)row * DM + c) = w;
    }
    EPI_MAIN_CALL
};
struct EpiF32 {
    static constexpr bool PERM = true, AFTER_DRAIN = false;
    bf16_t* T;
    __device__ __forceinline__ void store8(int row, int c, f32x4 v0, f32x4 v1) const {
        u32x4 w; w.x = pk2(v0[0], v0[1]); w.y = pk2(v0[2], v0[3]); w.z = pk2(v1[0], v1[1]); w.w = pk2(v1[2], v1[3]);
        *(u32x4*)(T + (size_t)row * DM + c) = w;
    }
    EPI_MAIN_CALL
};

__device__ __forceinline__ bf16x8 frag_perm(const u32x4 v, const int paddr) {
    u32x4 r; r.x = (unsigned)__builtin_amdgcn_ds_bpermute(paddr, (int)v.x); r.y = (unsigned)__builtin_amdgcn_ds_bpermute(paddr, (int)v.y);
    r.z = (unsigned)__builtin_amdgcn_ds_bpermute(paddr, (int)v.z); r.w = (unsigned)__builtin_amdgcn_ds_bpermute(paddr, (int)v.w);
    return __builtin_bit_cast(bf16x8, r);
}
template <class Epi>
__device__ __forceinline__ void small_gemm_range(LAS unsigned char* lds, const bf16_t* A, const bf16_t* Bt, const int K, const int ubeg, const int uend, const int ustride, const Epi& E, const int wv) {
    int lane_ = lane_id(); asm volatile("" : "+v"(lane_));
    const int lane = lane_, fr = lane & 15, fq = lane >> 4, tid = wv * 64 + lane;
    const int kw = K >> 3;
    LAS float* red = (LAS float*)lds;
    for (int u = ubeg; u < uend; u += ustride) {
        const int rc = u & 15, cc = u >> 4;
        const bf16_t* Ap = A + (size_t)(MP + rc * 64 + (lane >> 2)) * K + wv * kw + 8 * (lane & 3);
        const bf16_t* Bp = Bt + (size_t)(cc * 64 + (lane >> 2)) * K + wv * kw + 8 * (lane & 3);
        const int paddr = ((lane & 15) * 4 + (lane >> 4)) * 4;
        f32x4 acc[4][4];
#pragma unroll
        for (int m = 0; m < 4; ++m)
#pragma unroll
            for (int n = 0; n < 4; ++n) acc[m][n] = (f32x4){0.f, 0.f, 0.f, 0.f};
#pragma unroll 4
        for (int ks = 0; ks < kw; ks += 32) {
            u32x4 ar[4], br[4]; bf16x8 af[4], bfr[4];
#pragma unroll
            for (int m = 0; m < 4; ++m) { ar[m] = *(const u32x4*)(Ap + (size_t)(m * 16) * K + ks); br[m] = *(const u32x4*)(Bp + (size_t)(m * 16) * K + ks); }
#pragma unroll
            for (int m = 0; m < 4; ++m) { af[m] = frag_perm(ar[m], paddr); bfr[m] = frag_perm(br[m], paddr); }
#pragma unroll
            for (int m = 0; m < 4; ++m)
#pragma unroll
                for (int n = 0; n < 4; ++n) acc[m][n] = __builtin_amdgcn_mfma_f32_16x16x32_bf16(bfr[n], af[m], acc[m][n], 0, 0, 0);
        }
#pragma unroll
        for (int m = 0; m < 4; ++m)
#pragma unroll
            for (int n = 0; n < 4; ++n) *(LAS f32x4*)(red + (wv * 64 + 16 * m + fr) * 68 + 16 * n + 4 * fq) = acc[m][n];
        __syncthreads();
        const int r = tid >> 3, c8 = (tid & 7) * 8;
        f32x4 s0 = {0.f, 0.f, 0.f, 0.f}, s1 = {0.f, 0.f, 0.f, 0.f};
#pragma unroll
        for (int w = 0; w < 8; ++w) { s0 += *(const LAS f32x4*)(red + (w * 64 + r) * 68 + c8); s1 += *(const LAS f32x4*)(red + (w * 64 + r) * 68 + c8 + 4); }
        E.store8(MP + rc * 64 + r, cc * 64 + c8, s0, s1);
        __syncthreads();
    }
}
template <class Epi>
__device__ __forceinline__ void small_gemm(LAS unsigned char* lds, const bf16_t* A, const bf16_t* Bt, const int K, const int N, const Epi& E, const int wv) {
    small_gemm_range<Epi>(lds, A, Bt, K, (int)blockIdx.x, 16 * (N >> 6), (int)gridDim.x, E, wv);
}
struct TailStat { float* xs; unsigned* cnt; };
__device__ __forceinline__ float tail_row_stat(const TailStat& st, const float part8, const int rc, const int cc, const int r, const int tid) {
    float p = part8; p += __shfl_xor(p, 1); p += __shfl_xor(p, 2); p += __shfl_xor(p, 4);
    if ((tid & 7) == 0) __hip_atomic_store(st.xs + (size_t)(rc * 64 + r) * 16 + cc, p, __ATOMIC_RELAXED, __HIP_MEMORY_SCOPE_AGENT);
    asm volatile("s_waitcnt vmcnt(0)" ::: "memory"); __syncthreads();
    if (tid == 0) {
        __hip_atomic_fetch_add(st.cnt + 64 * rc, 1u, __ATOMIC_RELAXED, __HIP_MEMORY_SCOPE_AGENT);
        while (__hip_atomic_load(st.cnt + 64 * rc, __ATOMIC_RELAXED, __HIP_MEMORY_SCOPE_AGENT) < 16u) __builtin_amdgcn_s_sleep(1);
        __builtin_amdgcn_fence(__ATOMIC_ACQUIRE, "agent");
    }
    __syncthreads();
    float q = 0.f;
#pragma unroll
    for (int j = 0; j < 16; ++j) q += __hip_atomic_load(st.xs + (size_t)(rc * 64 + r) * 16 + j, __ATOMIC_RELAXED, __HIP_MEMORY_SCOPE_AGENT);
    return 1.0f / sqrtf(q * (1.0f / DM) + EPS);
}
template <int MODE>
__device__ __forceinline__ void small_gemm_norm(LAS unsigned char* lds, const bf16_t* A, const bf16_t* Bt, const int K, const float* xin, float* y, bf16_t* X1, bf16_t* H, const float* ga, const float* gb,
                                                const TailStat st1, const TailStat st2, const int wv) {
    int lane_ = lane_id(); asm volatile("" : "+v"(lane_));
    const int lane = lane_, fr = lane & 15, fq = lane >> 4, tid = wv * 64 + lane;
    const int kw = K >> 3, u = blockIdx.x, rc = u & 15, cc = u >> 4;
    LAS float* red = (LAS float*)lds;
    const bf16_t* Ap = A + (size_t)(MP + rc * 64 + (lane >> 2)) * K + wv * kw + 8 * (lane & 3);
    const bf16_t* Bp = Bt + (size_t)(cc * 64 + (lane >> 2)) * K + wv * kw + 8 * (lane & 3);
    const int paddr = ((lane & 15) * 4 + (lane >> 4)) * 4;
    f32x4 acc[4][4];
#pragma unroll
    for (int m = 0; m < 4; ++m)
#pragma unroll
        for (int n = 0; n < 4; ++n) acc[m][n] = (f32x4){0.f, 0.f, 0.f, 0.f};
#pragma unroll 4
    for (int ks = 0; ks < kw; ks += 32) {
        u32x4 ar[4], br[4]; bf16x8 af[4], bfr[4];
#pragma unroll
        for (int m = 0; m < 4; ++m) { ar[m] = *(const u32x4*)(Ap + (size_t)(m * 16) * K + ks); br[m] = *(const u32x4*)(Bp + (size_t)(m * 16) * K + ks); }
#pragma unroll
        for (int m = 0; m < 4; ++m) { af[m] = frag_perm(ar[m], paddr); bfr[m] = frag_perm(br[m], paddr); }
#pragma unroll
        for (int m = 0; m < 4; ++m)
#pragma unroll
            for (int n = 0; n < 4; ++n) acc[m][n] = __builtin_amdgcn_mfma_f32_16x16x32_bf16(bfr[n], af[m], acc[m][n], 0, 0, 0);
    }
#pragma unroll
    for (int m = 0; m < 4; ++m)
#pragma unroll
        for (int n = 0; n < 4; ++n) *(LAS f32x4*)(red + (wv * 64 + 16 * m + fr) * 68 + 16 * n + 4 * fq) = acc[m][n];
    __syncthreads();
    const int r = tid >> 3, c8 = (tid & 7) * 8;
    f32x4 s0 = {0.f, 0.f, 0.f, 0.f}, s1 = {0.f, 0.f, 0.f, 0.f};
#pragma unroll
    for (int w = 0; w < 8; ++w) { s0 += *(const LAS f32x4*)(red + (w * 64 + r) * 68 + c8); s1 += *(const LAS f32x4*)(red + (w * 64 + r) * 68 + c8 + 4); }
    const int row = rc * 64 + r, col = cc * 64 + c8;
    const float rs1 = tail_row_stat(st1, (s0[0] * s0[0] + s0[1] * s0[1]) + (s0[2] * s0[2] + s0[3] * s0[3]) + (s1[0] * s1[0] + s1[1] * s1[1]) + (s1[2] * s1[2] + s1[3] * s1[3]), rc, cc, r, tid);
    const f32x4 ga0 = *(const f32x4*)(ga + col), ga1 = *(const f32x4*)(ga + col + 4);
    float* yp = y + (size_t)(MP + row) * DM + col;
    if (MODE == 1) {
        const u32x4 xw = *(const u32x4*)(X1 + (size_t)(MP + row) * DM + col);
        const f32x4 y0 = {bflo(xw.x), bfhi(xw.x), bflo(xw.y), bfhi(xw.y)}, y1 = {bflo(xw.z), bfhi(xw.z), bflo(xw.w), bfhi(xw.w)};
        *(f32x4*)yp = y0 + s0 * rs1 * ga0; *(f32x4*)(yp + 4) = y1 + s1 * rs1 * ga1;
    } else {
        const float* xp = xin + (size_t)row * DM + col;
        const f32x4 x0 = *(const f32x4*)xp + s0 * rs1 * ga0, x1 = *(const f32x4*)(xp + 4) + s1 * rs1 * ga1;
        { u32x4 xw; xw.x = pk2(x0[0], x0[1]); xw.y = pk2(x0[2], x0[3]); xw.z = pk2(x1[0], x1[1]); xw.w = pk2(x1[2], x1[3]); *(u32x4*)(X1 + (size_t)(MP + row) * DM + col) = xw; }
        const float rs2 = tail_row_stat(st2, (x0[0] * x0[0] + x0[1] * x0[1]) + (x0[2] * x0[2] + x0[3] * x0[3]) + (x1[0] * x1[0] + x1[1] * x1[1]) + (x1[2] * x1[2] + x1[3] * x1[3]), rc, cc, r, tid);
        const f32x4 gb0 = *(const f32x4*)(gb + col), gb1 = *(const f32x4*)(gb + col + 4);
        const f32x4 h0 = x0 * rs2 * gb0, h1 = x1 * rs2 * gb1;
        u32x4 w; w.x = pk2(h0[0], h0[1]); w.y = pk2(h0[2], h0[3]); w.z = pk2(h1[0], h1[1]); w.w = pk2(h1[2], h1[3]);
        *(u32x4*)(H + (size_t)(MP + row) * DM + col) = w;
    }
    __syncthreads();
}
template <class Epi>
__device__ __forceinline__ void small_gemm_a4(LAS unsigned char* lds, const bf16_t* A, const bf16_t* Bt, const int N, const Epi& E, const int wv) {
    constexpr int K = 1024, kw = 128;
    int lane_ = lane_id(); asm volatile("" : "+v"(lane_));
    const int lane = lane_, fr = lane & 15, fq = lane >> 4, tid = wv * 64 + lane;
    const int nunits = 16 * (N >> 6), G = gridDim.x;
    LAS float* red = (LAS float*)lds;
    const int lrow = lane >> 2, lch = 8 * (lane & 3), paddr = ((lane & 15) * 4 + (lane >> 4)) * 4;
    const int rc = blockIdx.x & 15;
    bf16x8 pa[4][4];
    {   const bf16_t* Ap = A + (size_t)(MP + rc * 64 + lrow) * K + wv * kw + lch;
        u32x4 ar[4][4];
#pragma unroll
        for (int ks = 0; ks < 4; ++ks)
#pragma unroll
            for (int m = 0; m < 4; ++m) ar[ks][m] = *(const u32x4*)(Ap + (size_t)(m * 16) * K + ks * 32);
#pragma unroll
        for (int ks = 0; ks < 4; ++ks)
#pragma unroll
            for (int m = 0; m < 4; ++m) pa[ks][m] = frag_perm(ar[ks][m], paddr); }
    u32x4 br[4][4];
    if ((int)blockIdx.x < nunits) { const bf16_t* Bp = Bt + (size_t)((blockIdx.x >> 4) * 64 + lrow) * K + wv * kw + lch;
#pragma unroll
        for (int ks = 0; ks < 4; ++ks)
#pragma unroll
            for (int n = 0; n < 4; ++n) br[ks][n] = *(const u32x4*)(Bp + (size_t)(n * 16) * K + ks * 32); }
    for (int u = blockIdx.x; u < nunits; u += G) {
        const int cc = u >> 4;
        f32x4 acc[4][4];
#pragma unroll
        for (int m = 0; m < 4; ++m)
#pragma unroll
            for (int n = 0; n < 4; ++n) acc[m][n] = (f32x4){0.f, 0.f, 0.f, 0.f};
#pragma unroll
        for (int ks = 0; ks < 4; ++ks) {
            bf16x8 pb[4];
#pragma unroll
            for (int n = 0; n < 4; ++n) pb[n] = frag_perm(br[ks][n], paddr);
#pragma unroll
            for (int m = 0; m < 4; ++m)
#pragma unroll
                for (int n = 0; n < 4; ++n) acc[m][n] = __builtin_amdgcn_mfma_f32_16x16x32_bf16(pb[n], pa[ks][m], acc[m][n], 0, 0, 0);
        }
        { const int un = u + G < nunits ? u + G : u;
          const bf16_t* Bp = Bt + (size_t)((un >> 4) * 64 + lrow) * K + wv * kw + lch;
#pragma unroll
          for (int ks = 0; ks < 4; ++ks)
#pragma unroll
              for (int n = 0; n < 4; ++n) br[ks][n] = *(const u32x4*)(Bp + (size_t)(n * 16) * K + ks * 32); }
#pragma unroll
        for (int m = 0; m < 4; ++m)
#pragma unroll
            for (int n = 0; n < 4; ++n) *(LAS f32x4*)(red + (wv * 64 + 16 * m + fr) * 68 + 16 * n + 4 * fq) = acc[m][n];
        lds_barrier();
        const int r = tid >> 3, c8 = (tid & 7) * 8;
        f32x4 s0 = {0.f, 0.f, 0.f, 0.f}, s1 = {0.f, 0.f, 0.f, 0.f};
#pragma unroll
        for (int w = 0; w < 8; ++w) { s0 += *(const LAS f32x4*)(red + (w * 64 + r) * 68 + c8); s1 += *(const LAS f32x4*)(red + (w * 64 + r) * 68 + c8 + 4); }
        E.store8(MP + rc * 64 + r, cc * 64 + c8, s0, s1);
        lds_barrier();
    }
}
template <class Epi>
__device__ __forceinline__ void small_gemm_k1024(LAS unsigned char* lds, const bf16_t* A, const bf16_t* Bt, const int N, const Epi& E, const int wv) {
    constexpr int K = 1024, kw = 128;
    const int lane = lane_id(), fr = lane & 15, fq = lane >> 4, tid = wv * 64 + lane;
    const int nunits = 16 * (N >> 6), G = gridDim.x;
    LAS float* red = (LAS float*)lds;
    int u = blockIdx.x;
    if (u >= nunits) return;
    u32x4 fa[4][4], fb[4][4];
    const int lrow = lane >> 2, lch = 8 * (lane & 3), paddr = ((lane & 15) * 4 + (lane >> 4)) * 4;
    {   const bf16_t* Ap = A + (size_t)(MP + (u & 15) * 64 + lrow) * K + wv * kw + lch; const bf16_t* Bp = Bt + (size_t)((u >> 4) * 64 + lrow) * K + wv * kw + lch;
#pragma unroll
        for (int ks = 0; ks < 4; ++ks)
#pragma unroll
            for (int m = 0; m < 4; ++m) { fa[ks][m] = *(const u32x4*)(Ap + (size_t)(m * 16) * K + ks * 32); fb[ks][m] = *(const u32x4*)(Bp + (size_t)(m * 16) * K + ks * 32); } }
    for (; u < nunits; u += G) {
        const int rc = u & 15, cc = u >> 4, nu = u + G; const bool has_next = nu < nunits;
        const bf16_t* Ap = A + (size_t)(MP + (nu & 15) * 64 + lrow) * K + wv * kw + lch; const bf16_t* Bp = Bt + (size_t)((nu >> 4) * 64 + lrow) * K + wv * kw + lch;
        f32x4 acc[4][4];
#pragma unroll
        for (int m = 0; m < 4; ++m)
#pragma unroll
            for (int n = 0; n < 4; ++n) acc[m][n] = (f32x4){0.f, 0.f, 0.f, 0.f};
#pragma unroll
        for (int ks = 0; ks < 4; ++ks) {
            bf16x8 pa[4], pb[4];
#pragma unroll
            for (int m = 0; m < 4; ++m) { pa[m] = frag_perm(fa[ks][m], paddr); pb[m] = frag_perm(fb[ks][m], paddr); }
            if (has_next) {
#pragma unroll
                for (int m = 0; m < 4; ++m) { fa[ks][m] = *(const u32x4*)(Ap + (size_t)(m * 16) * K + ks * 32); fb[ks][m] = *(const u32x4*)(Bp + (size_t)(m * 16) * K + ks * 32); }
            }
#pragma unroll
            for (int m = 0; m < 4; ++m)
#pragma unroll
                for (int n = 0; n < 4; ++n) acc[m][n] = __builtin_amdgcn_mfma_f32_16x16x32_bf16(pb[n], pa[m], acc[m][n], 0, 0, 0);
        }
#pragma unroll
        for (int m = 0; m < 4; ++m)
#pragma unroll
            for (int n = 0; n < 4; ++n) *(LAS f32x4*)(red + (wv * 64 + 16 * m + fr) * 68 + 16 * n + 4 * fq) = acc[m][n];
        __syncthreads();
        const int r = tid >> 3, c8 = (tid & 7) * 8;
        f32x4 s0 = {0.f, 0.f, 0.f, 0.f}, s1 = {0.f, 0.f, 0.f, 0.f};
#pragma unroll
        for (int w = 0; w < 8; ++w) { s0 += *(const LAS f32x4*)(red + (w * 64 + r) * 68 + c8); s1 += *(const LAS f32x4*)(red + (w * 64 + r) * 68 + c8 + 4); }
        E.store8(MP + rc * 64 + r, cc * 64 + c8, s0, s1);
        __syncthreads();
    }
}
template <int CTRL> __device__ __forceinline__ float dppf(float old, float src) {
    return __builtin_bit_cast(float, __builtin_amdgcn_update_dpp(__builtin_bit_cast(int, old), __builtin_bit_cast(int, src), CTRL, 0xf, 0xf, false));
}
__device__ __forceinline__ float gelu_tanh(float x) {
    const float u = 1.5957691216057308f * (x + 0.044715f * x * x * x);
    return x * __builtin_amdgcn_rcpf(1.0f + __builtin_amdgcn_exp2f(-u * LOG2E));
}
struct EpiUpFused {
    static constexpr bool PERM = true, AFTER_DRAIN = false;
    bf16_t* A2; float* out; const float* cw; const float* cb; const float* st; float* head; float* tail; LAS float* halo;
    __device__ __forceinline__ void operator()(const f32x4 (&acc)[2][2][4][2], const Unit& u, int wr, int wc, int fr, int fq) const {
        const int pm = u.pm, gt = u.pn; const bool samp = pm >= 64;
        const int colq = wc * 32 + 8 * fq, oc = gt * 128 + colq;
#pragma unroll
        for (int ai = 0; ai < 2; ++ai) {
            const int g = ai * 2 + wr;
            if (fr >= 14) {
                const int r = fr - 14;
                float* cdst = nullptr;
                if (samp) cdst = out + O_CV_S + ((size_t)((pm - 64) * 4 + g) * 2 + r) * NUP;
                else if (g == 3) cdst = ((pm & 7) == 7) ? out + O_CV_P + ((size_t)(pm >> 3) * 2 + r) * NUP : tail + ((size_t)pm * 2 + r) * NUP;
#pragma unroll
                for (int bj = 0; bj < 2; ++bj) {
                    const f32x4 v0 = acc[ai][bj][3][0], v1 = acc[ai][bj][3][1];
                    LAS float* hp = halo + ((g * 2 + r) * 2 + bj) * 128 + colq;
                    *(LAS f32x4*)hp = v0; *(LAS f32x4*)(hp + 4) = v1;
                    if (cdst) { *(f32x4*)(cdst + bj * DFF + oc) = v0; *(f32x4*)(cdst + bj * DFF + oc + 4) = v1; }
                }
            }
        }
        const bool defer = !samp && (pm & 7) != 0;
        if (defer && wr == 0 && fr < 2) {
            float* hd = head + ((size_t)pm * 2 + fr) * NUP;
#pragma unroll
            for (int bj = 0; bj < 2; ++bj) { *(f32x4*)(hd + bj * DFF + oc) = acc[0][bj][0][0]; *(f32x4*)(hd + bj * DFF + oc + 4) = acc[0][bj][0][1]; }
        }
        f32x4 wg[3], wq[3], bg, bq;
#pragma unroll
        for (int k = 0; k < 3; ++k) { wg[k] = *(const f32x4*)(cw + (size_t)k * NUP + oc); wq[k] = *(const f32x4*)(cw + (size_t)k * NUP + DFF + oc); }
        bg = *(const f32x4*)(cb + oc); bq = *(const f32x4*)(cb + DFF + oc);
        asm volatile("s_waitcnt lgkmcnt(0)" ::: "memory"); __builtin_amdgcn_s_barrier(); asm volatile("" ::: "memory");
        u32x2 keep[2][4];
#pragma unroll
        for (int n = 0; n < 2; ++n) {
            if (n == 1) {
#pragma unroll
                for (int k = 0; k < 3; ++k) { wg[k] = *(const f32x4*)(cw + (size_t)k * NUP + oc + 4); wq[k] = *(const f32x4*)(cw + (size_t)k * NUP + DFF + oc + 4); }
                bg = *(const f32x4*)(cb + oc + 4); bq = *(const f32x4*)(cb + DFF + oc + 4);
            }
#pragma unroll
            for (int ai = 0; ai < 2; ++ai) {
                const int g = ai * 2 + wr;
                f32x4 xm1[2];
                xm1[0] = (f32x4){0.f, 0.f, 0.f, 0.f}; xm1[1] = (f32x4){0.f, 0.f, 0.f, 0.f};
                if (fr >= 14) {
                    const int r = fr - 14;
                    if (samp) { const float* sp = st + ((size_t)((pm - 64) * 4 + g) * 2 + r) * NUP; xm1[0] = *(const f32x4*)(sp + oc + 4 * n); xm1[1] = *(const f32x4*)(sp + DFF + oc + 4 * n); }
                    else if (g > 0) { const LAS float* hp = halo + (((g - 1) * 2 + r) * 2) * 128 + colq + 4 * n; xm1[0] = *(const LAS f32x4*)hp; xm1[1] = *(const LAS f32x4*)(hp + 128); }
                }
#pragma unroll
                for (int m = 0; m < 4; ++m) {
                    const size_t row = (size_t)pm * 256 + g * 64 + m * 16 + fr;
                    float res[4];
#pragma unroll
                    for (int e = 0; e < 4; ++e) {
                        const float xg = acc[ai][0][m][n][e], xgp = (m == 0) ? xm1[0][e] : acc[ai][0][m > 0 ? m - 1 : 0][n][e];
                        const float xv = acc[ai][1][m][n][e], xvp = (m == 0) ? xm1[1][e] : acc[ai][1][m > 0 ? m - 1 : 0][n][e];
                        const float g1 = dppf<0x111>(dppf<0x121>(0.f, xgp), xg), g2 = dppf<0x112>(dppf<0x122>(0.f, xgp), xg);
                        const float v1 = dppf<0x111>(dppf<0x121>(0.f, xvp), xv), v2 = dppf<0x112>(dppf<0x122>(0.f, xvp), xv);
                        const float yg = bg[e] + wg[0][e] * g2 + wg[1][e] * g1 + wg[2][e] * xg;
                        const float yv = bq[e] + wq[0][e] * v2 + wq[1][e] * v1 + wq[2][e] * xv;
                        res[e] = gelu_tanh(yg) * yv;
                    }
                    u32x2 w; w.x = pk2(res[0], res[1]); w.y = pk2(res[2], res[3]);
                    if (n == 0) keep[ai][m] = w;
                    else if (!(defer && g == 0 && m == 0 && fr < 2)) { u32x4 ww; ww.x = keep[ai][m].x; ww.y = keep[ai][m].y; ww.z = w.x; ww.w = w.y; *(u32x4*)(A2 + row * DFF + oc) = ww; }
                    asm volatile("" ::: "memory");
                }
            }
        }
    }
};
__device__ __forceinline__ void ffn_fixup(const Args& a, const int pm, const int tid) {
    if (pm >= 64 || (pm & 7) == 0) return;
    const float* head = (const float*)(a.ws + WS_HEAD) + (size_t)pm * 2 * NUP; const float* tail = (const float*)(a.ws + WS_TAIL) + (size_t)(pm - 1) * 2 * NUP;
    const float* cw = a.in[I_CW]; const float* cb = a.in[I_CB]; bf16_t* A2 = (bf16_t*)(a.ws + WS_A2);
    for (int it = tid; it < 704; it += 512) {
        const int r = it >= 352 ? 1 : 0, oc = (it - r * 352) * 8;
        const float* x0 = r == 0 ? tail : tail + NUP; const float* x1 = r == 0 ? tail + NUP : head; const float* x2 = r == 0 ? head : head + NUP;
        float y[2][8];
#pragma unroll
        for (int hh = 0; hh < 2; ++hh) { const int c = hh * DFF + oc;
#pragma unroll
            for (int q = 0; q < 2; ++q) {
                const f32x4 bb = *(const f32x4*)(cb + c + 4 * q), w0 = *(const f32x4*)(cw + c + 4 * q), w1 = *(const f32x4*)(cw + NUP + c + 4 * q), w2 = *(const f32x4*)(cw + 2 * NUP + c + 4 * q);
                const f32x4 a0 = *(const f32x4*)(x0 + c + 4 * q), a1 = *(const f32x4*)(x1 + c + 4 * q), a2 = *(const f32x4*)(x2 + c + 4 * q);
#pragma unroll
                for (int e = 0; e < 4; ++e) y[hh][4 * q + e] = bb[e] + w0[e] * a0[e] + w1[e] * a1[e] + w2[e] * a2[e];
            } }
        float res[8];
#pragma unroll
        for (int e = 0; e < 8; ++e) res[e] = gelu_tanh(y[0][e]) * y[1][e];
        u32x4 w; w.x = pk2(res[0], res[1]); w.y = pk2(res[2], res[3]); w.z = pk2(res[4], res[5]); w.w = pk2(res[6], res[7]);
        *(u32x4*)(A2 + ((size_t)pm * 256 + r) * DFF + oc) = w;
    }
}

struct RowStat {
    float* xbuf; unsigned* cnt;
    __device__ __forceinline__ void run(const f32x4 (&v)[2][2][4][2], const Unit& u, int wr, int wc, int fr, int fq, LAS unsigned char* lds, int wid, int lane) const {
        LAS float* P = (LAS float*)lds; LAS float* S = (LAS float*)(lds + 4096);
#pragma unroll
        for (int ai = 0; ai < 2; ++ai)
#pragma unroll
            for (int m = 0; m < 4; ++m) { float s = 0.f;
#pragma unroll
                for (int bj = 0; bj < 2; ++bj)
#pragma unroll
                    for (int n = 0; n < 2; ++n) { const f32x4 x = v[ai][bj][m][n]; s += (x[0] * x[0] + x[1] * x[1]) + (x[2] * x[2] + x[3] * x[3]); }
                s += __shfl_xor(s, 16); s += __shfl_xor(s, 32);
                if (fq == 0) P[(ai * 128 + wr * 64 + m * 16 + fr) * 4 + wc] = s; }
        asm volatile("s_waitcnt lgkmcnt(0)" ::: "memory"); __builtin_amdgcn_s_barrier(); asm volatile("" ::: "memory");
        const int tid = wid * 64 + lane;
        if (tid < 256) { const f32x4 p = *(const LAS f32x4*)(P + tid * 4);
            __hip_atomic_store(xbuf + ((size_t)u.pm * 256 + tid) * 4 + u.pn, (p[0] + p[1]) + (p[2] + p[3]), __ATOMIC_RELAXED, __HIP_MEMORY_SCOPE_AGENT); }
        asm volatile("s_waitcnt vmcnt(0)" ::: "memory"); __builtin_amdgcn_s_barrier(); asm volatile("" ::: "memory");
        if (tid == 0) {
            __hip_atomic_fetch_add(cnt + 64 * u.pm, 1u, __ATOMIC_RELAXED, __HIP_MEMORY_SCOPE_AGENT);
            while (__hip_atomic_load(cnt + 64 * u.pm, __ATOMIC_RELAXED, __HIP_MEMORY_SCOPE_AGENT) < 4u) __builtin_amdgcn_s_sleep(1);
            __builtin_amdgcn_fence(__ATOMIC_ACQUIRE, "agent");
        }
        asm volatile("s_waitcnt vmcnt(0) lgkmcnt(0)" ::: "memory"); __builtin_amdgcn_s_barrier(); asm volatile("" ::: "memory");
        if (tid < 256) { const float* slot = xbuf + ((size_t)u.pm * 256 + tid) * 4; float q = 0.f;
#pragma unroll
            for (int t = 0; t < 4; ++t) q += __hip_atomic_load(slot + t, __ATOMIC_RELAXED, __HIP_MEMORY_SCOPE_AGENT);
            S[tid] = 1.0f / sqrtf(q * (1.0f / DM) + EPS); }
        asm volatile("s_waitcnt vmcnt(0) lgkmcnt(0)" ::: "memory"); __builtin_amdgcn_s_barrier(); asm volatile("" ::: "memory");
    }
};
struct EpiOutNorm {
    static constexpr bool PERM = true, AFTER_DRAIN = true;
    const float* x; bf16_t* X1; bf16_t* H; const float* g2; const float* g3; RowStat st1, st2;
    __device__ __forceinline__ void fused(f32x4 (&acc)[2][2][4][2], const Unit& u, int wr, int wc, int fr, int fq, LAS unsigned char* lds, int wid, int lane) const {
        st1.run(acc, u, wr, wc, fr, fq, lds, wid, lane);
        const LAS float* S = (const LAS float*)(lds + 4096);
        const int c0 = u.pn * 256 + wc * 32 + 8 * fq;
#pragma unroll
        for (int ai = 0; ai < 2; ++ai)
#pragma unroll
            for (int m = 0; m < 4; ++m) { const int rl = ai * 128 + wr * 64 + m * 16 + fr; const size_t row = (size_t)u.pm * 256 + rl; const float rs = S[rl];
#pragma unroll
                for (int bj = 0; bj < 2; ++bj)
#pragma unroll
                    for (int n = 0; n < 2; ++n) { const int c = c0 + bj * 128 + 4 * n;
                        const f32x4 xv = *(const f32x4*)(x + row * DM + c), gg = *(const f32x4*)(g2 + c);
                        const f32x4 x1 = xv + acc[ai][bj][m][n] * rs * gg;
                        u32x2 xw; xw.x = pk2(x1[0], x1[1]); xw.y = pk2(x1[2], x1[3]); *(u32x2*)(X1 + row * DM + c) = xw; acc[ai][bj][m][n] = x1; }
                asm volatile("" : "+v"(acc[ai][0][m][0]), "+v"(acc[ai][0][m][1]), "+v"(acc[ai][1][m][0]), "+v"(acc[ai][1][m][1]));
                asm volatile("" ::: "memory"); }
        st2.run(acc, u, wr, wc, fr, fq, lds, wid, lane);
#pragma unroll
        for (int ai = 0; ai < 2; ++ai)
#pragma unroll
            for (int m = 0; m < 4; ++m) { const int rl = ai * 128 + wr * 64 + m * 16 + fr; const size_t row = (size_t)u.pm * 256 + rl; const float rs = S[rl];
#pragma unroll
                for (int bj = 0; bj < 2; ++bj) { const int c = c0 + bj * 128;
                    const f32x4 ga = *(const f32x4*)(g3 + c), gb = *(const f32x4*)(g3 + c + 4); const f32x4 v0 = acc[ai][bj][m][0] * rs * ga, v1 = acc[ai][bj][m][1] * rs * gb;
                    u32x4 w; w.x = pk2(v0[0], v0[1]); w.y = pk2(v0[2], v0[3]); w.z = pk2(v1[0], v1[1]); w.w = pk2(v1[2], v1[3]);
                    *(u32x4*)(H + row * DM + c) = w; } }
    }
};
struct EpiDownNorm {
    static constexpr bool PERM = true, AFTER_DRAIN = true;
    const bf16_t* X1; float* y; const float* g4; RowStat st;
    __device__ __forceinline__ void fused(f32x4 (&acc)[2][2][4][2], const Unit& u, int wr, int wc, int fr, int fq, LAS unsigned char* lds, int wid, int lane) const {
        st.run(acc, u, wr, wc, fr, fq, lds, wid, lane);
        const LAS float* S = (const LAS float*)(lds + 4096);
        const int c0 = u.pn * 256 + wc * 32 + 8 * fq;
#pragma unroll
        for (int ai = 0; ai < 2; ++ai)
#pragma unroll
            for (int m = 0; m < 4; ++m) { const int rl = ai * 128 + wr * 64 + m * 16 + fr; const size_t row = (size_t)u.pm * 256 + rl; const float rs = S[rl];
#pragma unroll
                for (int bj = 0; bj < 2; ++bj)
#pragma unroll
                    for (int n = 0; n < 2; ++n) { const int c = c0 + bj * 128 + 4 * n;
                        const u32x2 xw = *(const u32x2*)(X1 + row * DM + c); const f32x4 xv = {bflo(xw.x), bfhi(xw.x), bflo(xw.y), bfhi(xw.y)}, gg = *(const f32x4*)(g4 + c);
                        *(f32x4*)(y + row * DM + c) = xv + acc[ai][bj][m][n] * rs * gg; }
                asm volatile("" ::: "memory"); }
    }
};

__device__ __forceinline__ void p0_transpose_item(const float* W, int N, int K, bf16_t* WT, int k0, int src_n0, int dst_n0, LAS float* scr, int lane) {
    float tv[32];
#pragma unroll
    for (int i = 0; i < 32; ++i) tv[i] = W[(size_t)(k0 + 2 * i + (lane >> 5)) * N + src_n0 + (lane & 31)];
#pragma unroll
    for (int i = 0; i < 32; ++i) scr[(2 * i + (lane >> 5)) * 33 + (lane & 31)] = tv[i];
    asm volatile("s_waitcnt lgkmcnt(0)" ::: "memory");
    const int c = lane & 7;
#pragma unroll
    for (int j = 0; j < 4; ++j) { const int n = (lane >> 3) + 8 * j; const LAS float* s = scr + (8 * c) * 33 + n;
        u32x4 o; o.x = pk2(s[0 * 33], s[1 * 33]); o.y = pk2(s[2 * 33], s[3 * 33]); o.z = pk2(s[4 * 33], s[5 * 33]); o.w = pk2(s[6 * 33], s[7 * 33]);
        *(u32x4*)(WT + (size_t)(dst_n0 + n) * K + k0 + 8 * c) = o; }
    asm volatile("s_waitcnt lgkmcnt(0)" ::: "memory");
}

constexpr int TI_IN = 16 * 160, TI_PA = 8 * 32, TI_PB = 8 * 32, TI_OUT = 16 * 32, TI_UP = 16 * 176, TI_DN = 44 * 32;
constexpr int TI_ALL = TI_IN + TI_PA + TI_PB + TI_OUT + TI_UP + TI_DN;
__device__ __forceinline__ void transpose_item(const Args& a, const int it, LAS float* scr, const int lane) {
    unsigned char* ws = a.ws; int r = it;
    if (r < TI_IN) { const int kb = r / 160, nb = r % 160, d0 = nb * 32; p0_transpose_item(a.in[I_WIN], 5128, DM, (bf16_t*)(ws + WS_WIN), kb * 64, d0 + (d0 >= 3072 ? 8 : 0), d0, scr, lane); return; } r -= TI_IN;
    if (r < TI_PA) { const int kb = r / 32, nb = r % 32; p0_transpose_item(a.in[I_WPA], DM, HW, (bf16_t*)(ws + WS_WPA), kb * 64, nb * 32, nb * 32, scr, lane); return; } r -= TI_PA;
    if (r < TI_PB) { const int kb = r / 32, nb = r % 32; p0_transpose_item(a.in[I_WPB], DM, HW, (bf16_t*)(ws + WS_WPB), kb * 64, nb * 32, nb * 32, scr, lane); return; } r -= TI_PB;
    if (r < TI_OUT) { const int kb = r / 32, nb = r % 32; p0_transpose_item(a.in[I_WOUT], DM, DM, (bf16_t*)(ws + WS_WOUT), kb * 64, nb * 32, nb * 32, scr, lane); return; } r -= TI_OUT;
    if (r < TI_UP) { const int kb = r / 176, nb = r % 176, d0 = nb * 32, tile = d0 >> 8, w = d0 & 255; const int s0 = (w < 128) ? tile * 128 + w : DFF + tile * 128 + (w - 128);
        p0_transpose_item(a.in[I_WUP], NUP, DM, (bf16_t*)(ws + WS_WUP), kb * 64, s0, d0, scr, lane); return; } r -= TI_UP;
    { const int kb = r / 32, nb = r % 32; p0_transpose_item(a.in[I_WDN], DM, DFF, (bf16_t*)(ws + WS_WDN), kb * 64, nb * 32, nb * 32, scr, lane); }
}
__device__ __forceinline__ void phase_prologue(const Args& a, LAS unsigned char* lds, const int wv) {
    const int lane = lane_id(), wave = wv, tid = wv * 64 + lane;
    const int G = gridDim.x, gw = blockIdx.x * 8 + wave, NGW = G * 8;
    unsigned char* ws = a.ws;
    LAS float* scr = (LAS float*)(lds + wave * 8448);
    LAS float* wfg = (LAS float*)(lds + 69632);
    {
        const float* win = a.in[I_WIN]; const float* g1 = a.in[I_G1];
        for (int k = tid; k < DM; k += 512) {
            const f32x4 w0 = *(const f32x4*)(win + (size_t)k * 5128 + 3072), w1 = *(const f32x4*)(win + (size_t)k * 5128 + 3076); const float g = g1[k];
            wfg[0 * DM + k] = w0[0] * g; wfg[1 * DM + k] = w0[1] * g; wfg[2 * DM + k] = w0[2] * g; wfg[3 * DM + k] = w0[3] * g;
            wfg[4 * DM + k] = w1[0] * g; wfg[5 * DM + k] = w1[1] * g; wfg[6 * DM + k] = w1[2] * g; wfg[7 * DM + k] = w1[3] * g;
        }
    }
    __syncthreads();
    for (int it = gw; it < TI_IN; it += NGW) transpose_item(a, it, scr, lane);
    const float* g1 = a.in[I_G1]; const float* bfp = a.in[I_BF];
    f32x4 gv[4];
#pragma unroll
    for (int j = 0; j < 4; ++j) gv[j] = *(const f32x4*)(g1 + 4 * lane + 256 * j);
    bf16_t* H = (bf16_t*)(ws + WS_H);
    constexpr int RB = 4;
    for (int mb = (NGW - 1 - gw) * RB; mb < MTOK; mb += NGW * RB) {
        f32x4 v[RB][4]; float ss[RB], z[RB][8];
#pragma unroll
        for (int i = 0; i < RB; ++i) { const float* xr = xrow_ptr(a, mb + i);
#pragma unroll
            for (int j = 0; j < 4; ++j) v[i][j] = *(const f32x4*)(xr + 4 * lane + 256 * j); }
#pragma unroll
        for (int i = 0; i < RB; ++i) { ss[i] = 0.f;
#pragma unroll
            for (int j = 0; j < 4; ++j) ss[i] += (v[i][j][0] * v[i][j][0] + v[i][j][1] * v[i][j][1]) + (v[i][j][2] * v[i][j][2] + v[i][j][3] * v[i][j][3]); }
#pragma unroll
        for (int q = 0; q < 8; ++q) {
            f32x4 w[4];
#pragma unroll
            for (int j = 0; j < 4; ++j) w[j] = *(const LAS f32x4*)(wfg + q * DM + 4 * lane + 256 * j);
#pragma unroll
            for (int i = 0; i < RB; ++i) { float s = 0.f;
#pragma unroll
                for (int j = 0; j < 4; ++j) s += (v[i][j][0] * w[j][0] + v[i][j][1] * w[j][1]) + (v[i][j][2] * w[j][2] + v[i][j][3] * w[j][3]);
                z[i][q] = s; }
        }
#pragma unroll
        for (int i = 0; i < RB; ++i) {
            const int m = mb + i;
            const float sst = wave_sum(ss[i]);
#pragma unroll
            for (int q = 0; q < 8; ++q) z[i][q] = wave_sum(z[i][q]);
            const float rs = 1.0f / sqrtf(sst * (1.0f / DM) + EPS);
#pragma unroll
            for (int j = 0; j < 4; ++j) {
                u32x2 o; o.x = pk2(v[i][j][0] * rs * gv[j][0], v[i][j][1] * rs * gv[j][1]); o.y = pk2(v[i][j][2] * rs * gv[j][2], v[i][j][3] * rs * gv[j][3]);
                *(u32x2*)(H + (size_t)m * DM + 4 * lane + 256 * j) = o;
            }
            float zz = z[i][0];
#pragma unroll
            for (int q = 1; q < 8; ++q) zz = (lane == q) ? z[i][q] : zz;
            if (lane < 8) {
                const float t = zz * rs + bfp[lane];
                const float lf = fminf(t, 0.f) - log1pf(expf(-fabsf(t)));
                float* dst = m < MP ? a.out + O_LF_P + (size_t)m * 8 : a.out + O_LF_S + (size_t)(m - MP) * 8;
                dst[lane] = lf;
            }
        }
    }
}

__device__ __forceinline__ void phase_rows1(const Args& a, const int wv) {
    const int lane = lane_id(), wave = wv; const int gw = blockIdx.x * 8 + wave, NGW = gridDim.x * 8;
    const bf16_t* T = (const bf16_t*)(a.ws + WS_T); bf16_t* H = (bf16_t*)(a.ws + WS_H);
    f32x4 g2[4], g3[4];
#pragma unroll
    for (int j = 0; j < 4; ++j) { g2[j] = *(const f32x4*)(a.in[I_G2] + 4 * lane + 256 * j); g3[j] = *(const f32x4*)(a.in[I_G3] + 4 * lane + 256 * j); }
    constexpr int RB = 2;
    for (int mb = MP + gw * RB; mb < MTOK; mb += NGW * RB) {
        f32x4 t[RB][4], x[RB][4];
#pragma unroll
        for (int i = 0; i < RB; ++i) { const float* xr = xrow_ptr(a, mb + i); const bf16_t* tr = T + (size_t)(mb + i) * DM;
#pragma unroll
            for (int j = 0; j < 4; ++j) { const u32x2 tw = *(const u32x2*)(tr + 4 * lane + 256 * j); t[i][j] = (f32x4){bflo(tw.x), bfhi(tw.x), bflo(tw.y), bfhi(tw.y)}; x[i][j] = *(const f32x4*)(xr + 4 * lane + 256 * j); } }
#pragma unroll
        for (int i = 0; i < RB; ++i) {
            const int m = mb + i; float ss = 0.f;
#pragma unroll
            for (int j = 0; j < 4; ++j) ss += (t[i][j][0] * t[i][j][0] + t[i][j][1] * t[i][j][1]) + (t[i][j][2] * t[i][j][2] + t[i][j][3] * t[i][j][3]);
            const float rs = 1.0f / sqrtf(wave_sum(ss) * (1.0f / DM) + EPS);
            float s2 = 0.f;
#pragma unroll
            for (int j = 0; j < 4; ++j) { x[i][j] = x[i][j] + t[i][j] * rs * g2[j]; s2 += (x[i][j][0] * x[i][j][0] + x[i][j][1] * x[i][j][1]) + (x[i][j][2] * x[i][j][2] + x[i][j][3] * x[i][j][3]);
                *(f32x4*)(a.out + O_Y + (size_t)m * DM + 4 * lane + 256 * j) = x[i][j]; }
            const float r2 = 1.0f / sqrtf(wave_sum(s2) * (1.0f / DM) + EPS);
#pragma unroll
            for (int j = 0; j < 4; ++j) { u32x2 o; o.x = pk2(x[i][j][0] * r2 * g3[j][0], x[i][j][1] * r2 * g3[j][1]); o.y = pk2(x[i][j][2] * r2 * g3[j][2], x[i][j][3] * r2 * g3[j][3]);
                *(u32x2*)(H + (size_t)m * DM + 4 * lane + 256 * j) = o; }
        }
    }
}
__device__ __forceinline__ void phase_rows2(const Args& a, const int wv) {
    const int lane = lane_id(), wave = wv; const int gw = blockIdx.x * 8 + wave, NGW = gridDim.x * 8;
    const bf16_t* T = (const bf16_t*)(a.ws + WS_T);
    f32x4 g4[4];
#pragma unroll
    for (int j = 0; j < 4; ++j) g4[j] = *(const f32x4*)(a.in[I_G4] + 4 * lane + 256 * j);
    constexpr int RB = 2;
    for (int mb = MP + gw * RB; mb < MTOK; mb += NGW * RB) {
        f32x4 t[RB][4], x[RB][4];
#pragma unroll
        for (int i = 0; i < RB; ++i) { const bf16_t* tr = T + (size_t)(mb + i) * DM; const float* yr = a.out + O_Y + (size_t)(mb + i) * DM;
#pragma unroll
            for (int j = 0; j < 4; ++j) { const u32x2 tw = *(const u32x2*)(tr + 4 * lane + 256 * j); t[i][j] = (f32x4){bflo(tw.x), bfhi(tw.x), bflo(tw.y), bfhi(tw.y)}; x[i][j] = *(const f32x4*)(yr + 4 * lane + 256 * j); } }
#pragma unroll
        for (int i = 0; i < RB; ++i) {
            float* yr = a.out + O_Y + (size_t)(mb + i) * DM; float ss = 0.f;
#pragma unroll
            for (int j = 0; j < 4; ++j) ss += (t[i][j][0] * t[i][j][0] + t[i][j][1] * t[i][j][1]) + (t[i][j][2] * t[i][j][2] + t[i][j][3] * t[i][j][3]);
            const float rs = 1.0f / sqrtf(wave_sum(ss) * (1.0f / DM) + EPS);
#pragma unroll
            for (int j = 0; j < 4; ++j) *(f32x4*)(yr + 4 * lane + 256 * j) = x[i][j] + t[i][j] * rs * g4[j];
        }
    }
}


constexpr int AL_K = 0, AL_KB = 64 * 144, AL_V = 2 * AL_KB, AL_VB = 8192, AL_WS = AL_V + 2 * AL_VB, AL_CS = AL_WS + 8 * 256, AL_TAB = AL_CS + 2112 * 4, AL_MISC = AL_TAB + 260 * 4;
constexpr int N_ATT_UNITS = 1280, N_TR_UNITS = (TI_ALL - TI_IN + 7) / 8;
__device__ __forceinline__ int crow(int r, int hi) { return (r & 3) + 8 * (r >> 2) + 4 * hi; }
__device__ __forceinline__ float halfswap_max(float m) { auto rr = __builtin_amdgcn_permlane32_swap(__float_as_uint(m), __float_as_uint(m), false, false); return fmaxf(__uint_as_float(rr[0]), __uint_as_float(rr[1])); }
__device__ __forceinline__ float halfswap_sum(float m) { auto rr = __builtin_amdgcn_permlane32_swap(__float_as_uint(m), __float_as_uint(m), false, false); return __uint_as_float(rr[0]) + __uint_as_float(rr[1]); }

__device__ __forceinline__ void pv_step(f32x16* o, f32x16& lacc, unsigned vb, bf16x8 pa0, bf16x8 pa1, bf16x8 pa2, bf16x8 pa3) {
#pragma unroll
    for (int d0 = 0; d0 < 2; ++d0) { s16x4 lo[4], hh[4];
#pragma unroll
        for (int ks = 0; ks < 4; ++ks) {
            asm volatile("ds_read_b64_tr_b16 %0,%1 offset:%c2" : "=&v"(lo[ks]) : "v"(vb), "i"(d0 * 4096 + ks * 1024) : "memory");
            asm volatile("ds_read_b64_tr_b16 %0,%1 offset:%c2" : "=&v"(hh[ks]) : "v"(vb), "i"(d0 * 4096 + ks * 1024 + 512) : "memory"); }
        if (d0 == 0) {
            __builtin_amdgcn_sched_barrier(0);
            const u32x4 one4 = {0x3F803F80u, 0x3F803F80u, 0x3F803F80u, 0x3F803F80u}; const bf16x8 ones = __builtin_bit_cast(bf16x8, one4);
            lacc = __builtin_amdgcn_mfma_f32_32x32x16_bf16(pa0, ones, lacc, 0, 0, 0); lacc = __builtin_amdgcn_mfma_f32_32x32x16_bf16(pa1, ones, lacc, 0, 0, 0);
            lacc = __builtin_amdgcn_mfma_f32_32x32x16_bf16(pa2, ones, lacc, 0, 0, 0); lacc = __builtin_amdgcn_mfma_f32_32x32x16_bf16(pa3, ones, lacc, 0, 0, 0);
            __builtin_amdgcn_sched_barrier(0);
        }
        asm volatile("s_waitcnt lgkmcnt(0)" ::: "memory"); __builtin_amdgcn_sched_barrier(0);
#define PK_(k) (bf16x8){lo[k][0], lo[k][1], lo[k][2], lo[k][3], hh[k][0], hh[k][1], hh[k][2], hh[k][3]}
        o[d0] = __builtin_amdgcn_mfma_f32_32x32x16_bf16(pa0, PK_(0), o[d0], 0, 0, 0);
        o[d0] = __builtin_amdgcn_mfma_f32_32x32x16_bf16(pa1, PK_(1), o[d0], 0, 0, 0);
        o[d0] = __builtin_amdgcn_mfma_f32_32x32x16_bf16(pa2, PK_(2), o[d0], 0, 0, 0);
        o[d0] = __builtin_amdgcn_mfma_f32_32x32x16_bf16(pa3, PK_(3), o[d0], 0, 0, 0);
#undef PK_
    }
}

template <int KIND>
__device__ __forceinline__ void attn_unit(const Args& a, LAS unsigned char* lds, int b, int h, int blk, int samp, const int wv, unsigned* qctr, LAS unsigned* qnext) {
    int lane_ = lane_id(); asm volatile("" : "+v"(lane_));
    const int lane = lane_, r32 = lane & 31, hi = lane >> 5, wid = wv, tid = wv * 64 + lane;
    const bf16_t* QKV = (const bf16_t*)(a.ws + WS_QKV);
    const bf16_t* Qb = QKV + (size_t)(KIND == 0 ? 0 : 3) * QKV_STRIDE; const bf16_t* Kb = Qb + QKV_STRIDE; const bf16_t* Vb = Kb + QKV_STRIDE;
    bf16_t* Ob = (bf16_t*)(a.ws + (KIND == 0 ? WS_OA : WS_OB));
    const float* Kc = a.in[KIND == 0 ? I_CKA : I_CKB]; const float* Vc = a.in[KIND == 0 ? I_CVA : I_CVB];
    constexpr int CT = (KIND == 0) ? 8 : 32;
    int t_lo, t_hi, w_lo, w_hi, qrow, cch = 0, qpos = 0;
    if (KIND == 0) {
        if (!samp) { const int c0 = 4 * blk; cch = c0 + (wid >> 1); t_lo = c0 - 8 < 0 ? 0 : c0 - 8; t_hi = c0 + 3; w_lo = cch - 8 < 0 ? 0 : cch - 8; w_hi = cch; qrow = b * SEQ + 64 * cch + 32 * (wid & 1); qpos = 32 * (wid & 1) + r32; }
        else { cch = 8; t_lo = 0; t_hi = 8; w_lo = 0; w_hi = wid < 2 ? 8 : -1; qrow = MP + b * DSEQ + 32 * (wid & 1); qpos = 32 * (wid & 1) + r32; }
    } else {
        if (!samp) { t_lo = 0; t_hi = 4 * blk + 3; w_lo = 0; w_hi = 4 * blk + (wid >> 1); qrow = b * SEQ + 256 * blk + 32 * wid; qpos = 256 * blk + 32 * wid + r32; }
        else { t_lo = 0; t_hi = 32; w_lo = 0; w_hi = wid < 2 ? 32 : -1; qrow = MP + b * DSEQ + 32 * (wid & 1); qpos = PAST + 32 * (wid & 1) + r32; }
    }
    const bool active = w_hi >= w_lo;
    LAS float* wsf = (LAS float*)(lds + AL_WS) + wid * 64;
    LAS float* cs = (LAS float*)(lds + AL_CS);
    LAS float* tab = (LAS float*)(lds + AL_TAB);
    LAS float* misc = (LAS float*)(lds + AL_MISC);
    lds_barrier();
    bf16x8 qr[4];
#pragma unroll
    for (int dk = 0; dk < 4; ++dk) qr[dk] = active ? *(const bf16x8*)(Qb + (size_t)(qrow + r32) * HW + h * 64 + dk * 16 + hi * 8) : (bf16x8){0, 0, 0, 0, 0, 0, 0, 0};
    const int srow = tid >> 3, sch = tid & 7;
    const unsigned kst = AL_K + srow * 144 + sch * 16, vst = AL_V + (sch >> 2) * 4096 + srow * 64 + (sch & 3) * 16;
    struct Stage { u32x4 k, v; f32x4 kf0, kf1, vf0, vf1; bool f; };
    Stage sA, sB; sA.f = false; sB.f = false;
    auto issue = [&](int tq, Stage& s) {
        const int t = tq > t_hi ? t_hi : tq;
        if (samp && t < CT) { const unsigned off = ((unsigned)(b * (64 * CT) + 64 * t + srow) * 8u + h) * 64u + sch * 8;
            s.kf0 = *(const f32x4*)(Kc + off); s.kf1 = *(const f32x4*)(Kc + off + 4); s.vf0 = *(const f32x4*)(Vc + off); s.vf1 = *(const f32x4*)(Vc + off + 4); s.f = true; }
        else { const unsigned row = samp ? (unsigned)(MP + b * DSEQ + srow) : (unsigned)(b * SEQ + 64 * t + srow); const unsigned off = row * HW + h * 64 + sch * 8;
            s.k = *(const u32x4*)(Kb + off); s.v = *(const u32x4*)(Vb + off); s.f = false; }
    };
    auto commit = [&](int buf, int t, Stage& s) {
        u32x4 kreg = s.k, vreg = s.v;
        if (s.f) { kreg.x = pk2(s.kf0[0], s.kf0[1]); kreg.y = pk2(s.kf0[2], s.kf0[3]); kreg.z = pk2(s.kf1[0], s.kf1[1]); kreg.w = pk2(s.kf1[2], s.kf1[3]);
                   vreg.x = pk2(s.vf0[0], s.vf0[1]); vreg.y = pk2(s.vf0[2], s.vf0[3]); vreg.z = pk2(s.vf1[0], s.vf1[1]); vreg.w = pk2(s.vf1[2], s.vf1[3]); }
        *(LAS u32x4*)(lds + kst + buf * AL_KB) = kreg; *(LAS u32x4*)(lds + vst + buf * AL_VB) = vreg;
        float* kd = nullptr; float* vd = nullptr;
        if (samp) { if (t == CT) { const unsigned o = (unsigned)(b * DSEQ + srow) * HW + h * 64 + sch * 8; kd = a.out + (KIND == 0 ? O_KA_S : O_KB_S) + o; vd = a.out + (KIND == 0 ? O_VA_S : O_VB_S) + o; } }
        else if (KIND == 1) { if (t >= 4 * blk) { const unsigned o = (unsigned)(b * SEQ + 64 * t + srow) * HW + h * 64 + sch * 8; kd = a.out + O_KB_P + o; vd = a.out + O_VB_P + o; } }
        else { if (t >= 4 * blk && t >= 24) { const unsigned o = (unsigned)(b * ALEN + 64 * (t - 24) + srow) * HW + h * 64 + sch * 8; kd = a.out + O_KA_P + o; vd = a.out + O_VA_P + o; } }
        if (kd) {
            *(f32x4*)kd = (f32x4){bflo(kreg.x), bfhi(kreg.x), bflo(kreg.y), bfhi(kreg.y)}; *(f32x4*)(kd + 4) = (f32x4){bflo(kreg.z), bfhi(kreg.z), bflo(kreg.w), bfhi(kreg.w)};
            *(f32x4*)vd = (f32x4){bflo(vreg.x), bfhi(vreg.x), bflo(vreg.y), bfhi(vreg.y)}; *(f32x4*)(vd + 4) = (f32x4){bflo(vreg.z), bfhi(vreg.z), bflo(vreg.w), bfhi(vreg.w)};
        }
    };
    issue(t_lo, sA); issue(t_lo + 1, sB);
    if (KIND == 0) {
        for (int i = tid; i < 257; i += 512) tab[i] = a.in[I_REL][h * 257 + i] * LOG2E;
    } else {
        const int n0 = samp ? PAST : 256 * (blk + 1);
        const float* src = samp ? a.in[I_CLF] + (size_t)b * PAST * 8 + h : a.out + O_LF_P + (size_t)b * SEQ * 8 + h;
        float v[4];
#pragma unroll
        for (int j = 0; j < 4; ++j) { const int idx = 4 * tid + j; v[j] = idx < n0 ? src[(size_t)idx * 8] : 0.f; }
        v[1] += v[0]; v[2] += v[1]; v[3] += v[2];
        float inc = v[3];
#pragma unroll
        for (int o = 1; o < 64; o <<= 1) { const float t = __shfl_up(inc, o); if (lane >= o) inc += t; }
        if (lane == 63) misc[wid] = inc;
        __syncthreads();
        float off = inc - v[3];
#pragma unroll
        for (int w = 0; w < 8; ++w) if (w < wid) off += misc[w];
        if (4 * tid < n0) { f32x4 o4 = {(off + v[0]) * LOG2E, (off + v[1]) * LOG2E, (off + v[2]) * LOG2E, (off + v[3]) * LOG2E}; *(LAS f32x4*)(cs + 4 * tid) = o4; }
        if (samp) {
            __syncthreads();
            if (wid == 0) {
                float x = a.out[O_LF_S + (size_t)(b * DSEQ + lane) * 8 + h];
#pragma unroll
                for (int o = 1; o < 64; o <<= 1) { const float t = __shfl_up(x, o); if (lane >= o) x += t; }
                cs[PAST + lane] = cs[PAST - 1] + x * LOG2E;
            }
        }
    }
    commit(0, t_lo, sA);
    __syncthreads();
    f32x16 o[2];
#pragma unroll
    for (int r = 0; r < 16; ++r) { o[0][r] = 0.f; o[1][r] = 0.f; }
    float mhat = (KIND == 1 && active) ? -cs[qpos] : 0.f;
    f32x16 lacc;
#pragma unroll
    for (int r = 0; r < 16; ++r) lacc[r] = 0.f;
    const unsigned lds0 = (unsigned)(uintptr_t)lds;
    const unsigned vb0 = lds0 + AL_V + ((lane >> 4) & 1) * 32 + (lane & 3) * 8 + (4 * hi + ((lane & 15) >> 2)) * 64;
    auto tile = [&](const int t, const int buf) {
        if (active && t >= w_lo && t <= w_hi) {
            const LAS unsigned char* Kt = lds + AL_K + buf * AL_KB + r32 * 144 + hi * 16;
            f32x16 p0, p1; const float nmh = -mhat;
            if (KIND == 0) {
                const int delta = cch - t;
                if (delta >= 3) { const float bb = tab[256] + nmh;
#pragma unroll
                    for (int r = 0; r < 16; ++r) { p0[r] = bb; p1[r] = bb; } }
                else { int base = 64 * delta + qpos - 4 * hi + 128; asm volatile("" : "+v"(base));
#pragma unroll
                    for (int r = 0; r < 16; ++r) { const int kv = (r & 3) + 8 * (r >> 2); int i0 = base - kv, i1 = base - kv - 32;
                        i0 = i0 < 0 ? 0 : (i0 > 256 ? 256 : i0); i1 = i1 < 0 ? 0 : (i1 > 256 ? 256 : i1); p0[r] = tab[i0] + nmh; p1[r] = tab[i1] + nmh; } }
            } else {
                const LAS float* ct = cs + 64 * t + 4 * hi;
#pragma unroll
                for (int g = 0; g < 4; ++g) { const f32x4 c0 = *(const LAS f32x4*)(ct + 8 * g), c1 = *(const LAS f32x4*)(ct + 32 + 8 * g);
#pragma unroll
                    for (int e = 0; e < 4; ++e) { p0[4 * g + e] = nmh - c0[e]; p1[4 * g + e] = nmh - c1[e]; } }
            }
#pragma unroll
            for (int dk = 0; dk < 4; ++dk) {
                const bf16x8 a0 = *(const LAS bf16x8*)(Kt + dk * 32), a1 = *(const LAS bf16x8*)(Kt + 32 * 144 + dk * 32);
                p0 = __builtin_amdgcn_mfma_f32_32x32x16_bf16(a0, qr[dk], p0, 0, 0, 0);
                p1 = __builtin_amdgcn_mfma_f32_32x32x16_bf16(a1, qr[dk], p1, 0, 0, 0);
            }
            if (KIND == 1) {
                if (t == w_hi) { int kb = 64 * t + 4 * hi - qpos; asm volatile("" : "+v"(kb));
#pragma unroll
                    for (int r = 0; r < 16; ++r) { const int kv = kb + (r & 3) + 8 * (r >> 2); if (kv > 0) p0[r] = -INFINITY; if (kv + 32 > 0) p1[r] = -INFINITY; } }
            }
            float mxa = fmaxf(p0[0], p1[0]), mxb = fmaxf(p0[1], p1[1]), mxc = fmaxf(p0[2], p1[2]), mxd = fmaxf(p0[3], p1[3]);
#pragma unroll
            for (int r = 4; r < 16; r += 4) { mxa = fmaxf(mxa, fmaxf(p0[r], p1[r])); mxb = fmaxf(mxb, fmaxf(p0[r + 1], p1[r + 1])); mxc = fmaxf(mxc, fmaxf(p0[r + 2], p1[r + 2])); mxd = fmaxf(mxd, fmaxf(p0[r + 3], p1[r + 3])); }
            float mx = halfswap_max(fmaxf(fmaxf(mxa, mxb), fmaxf(mxc, mxd)));
            if (__any(mx > 8.0f)) {
                const float dl = fmaxf(mx, 0.f); const float al = __builtin_amdgcn_exp2f(-dl); mhat += dl;
#pragma unroll
                for (int r = 0; r < 16; ++r) { p0[r] -= dl; p1[r] -= dl; }
                if (hi == 0) wsf[r32] = al;
#pragma unroll
                for (int g = 0; g < 4; ++g) { const f32x4 f = *(const LAS f32x4*)(wsf + 8 * g + 4 * hi);
#pragma unroll
                    for (int e = 0; e < 4; ++e) { o[0][4 * g + e] *= f[e]; o[1][4 * g + e] *= f[e]; lacc[4 * g + e] *= f[e]; } }
            }
#pragma unroll
            for (int r = 0; r < 16; ++r) { p0[r] = __builtin_amdgcn_exp2f(p0[r]); p1[r] = __builtin_amdgcn_exp2f(p1[r]); }
            u32x4 w0, w1, w2, w3;
            w0.x = pk2(p0[0], p0[1]); w0.y = pk2(p0[2], p0[3]); w0.z = pk2(p0[4], p0[5]); w0.w = pk2(p0[6], p0[7]);
            w1.x = pk2(p0[8], p0[9]); w1.y = pk2(p0[10], p0[11]); w1.z = pk2(p0[12], p0[13]); w1.w = pk2(p0[14], p0[15]);
            w2.x = pk2(p1[0], p1[1]); w2.y = pk2(p1[2], p1[3]); w2.z = pk2(p1[4], p1[5]); w2.w = pk2(p1[6], p1[7]);
            w3.x = pk2(p1[8], p1[9]); w3.y = pk2(p1[10], p1[11]); w3.z = pk2(p1[12], p1[13]); w3.w = pk2(p1[14], p1[15]);
            pv_step(o, lacc, vb0 + buf * AL_VB, __builtin_bit_cast(bf16x8, w0), __builtin_bit_cast(bf16x8, w1), __builtin_bit_cast(bf16x8, w2), __builtin_bit_cast(bf16x8, w3));
        }
    };
    for (int t = t_lo;;) {
        issue(t + 2, sA);
        tile(t, 0);
        if (t < t_hi) commit(1, t + 1, sB);
        lds_barrier();
        if (++t > t_hi) break;
        issue(t + 2, sB);
        tile(t, 1);
        if (t < t_hi) commit(0, t + 1, sA);
        lds_barrier();
        if (++t > t_hi) break;
    }
    unsigned nxt = 0u;
    if (tid == 0) nxt = atomicAdd(qctr, 1u);
    if (active) {
        float rl[16];
#pragma unroll
        for (int r = 0; r < 16; ++r) rl[r] = __builtin_amdgcn_rcpf(lacc[r]);
        LAS bf16_t* stg = (LAS bf16_t*)(lds + AL_K + wid * 4096);
#pragma unroll
        for (int r = 0; r < 16; ++r) { const int orow = crow(r, hi); stg[orow * 64 + r32] = (bf16_t)f2bf(o[0][r] * rl[r]); stg[orow * 64 + 32 + r32] = (bf16_t)f2bf(o[1][r] * rl[r]); }
#pragma unroll
        for (int i = 0; i < 4; ++i) { const int row = i * 8 + (lane >> 3), ch = lane & 7; const u32x4 v = *(const LAS u32x4*)(stg + row * 64 + ch * 8);
            *(u32x4*)(Ob + (size_t)(qrow + row) * HW + h * 64 + ch * 8) = v; }
    }
    if (tid == 0) *qnext = nxt;
}

__device__ __forceinline__ void phase_attention(const Args& a, LAS unsigned char* lds, const int wv) {
    const int tid = wv * 64 + lane_id();
    unsigned* ctr = (unsigned*)(a.ws + WS_CTL);
    LAS unsigned* sidx = (LAS unsigned*)(lds + AL_MISC + 64);
    __syncthreads();
    if (tid == 0) *sidx = atomicAdd(ctr, 1u);
    for (;;) {
        lds_barrier();
        const int i = (int)*sidx;
        if (i >= N_ATT_UNITS + N_TR_UNITS) break;
        if (i >= N_ATT_UNITS) {
            const int it = TI_IN + (i - N_ATT_UNITS) * 8 + wv;
            __syncthreads();
            int l2 = lane_id(); asm volatile("" : "+v"(l2));
            if (it < TI_ALL) transpose_item(a, it, (LAS float*)(lds + wv * 8448), l2);
            __syncthreads();
            if (tid == 0) *sidx = atomicAdd(ctr, 1u);
            continue;
        }
        if (i < 128) attn_unit<1>(a, lds, i >> 3, i & 7, 0, 1, wv, ctr, sidx);
        else if (i < 448) { const int j = i - 128; attn_unit<1>(a, lds, (j & 63) >> 3, j & 7, 7 - (j >> 6), 0, wv, ctr, sidx); }
        else if (i < 832) { const int j = i - 448; attn_unit<0>(a, lds, (j & 63) >> 3, j & 7, 7 - (j >> 6), 0, wv, ctr, sidx); }
        else if (i < 896) { const int j = i - 832; attn_unit<1>(a, lds, j >> 3, j & 7, 2, 0, wv, ctr, sidx); }
        else if (i < 1024) { const int j = i - 896; attn_unit<0>(a, lds, j >> 3, j & 7, 0, 1, wv, ctr, sidx); }
        else if (i < 1088) { const int j = i - 1024; attn_unit<0>(a, lds, j >> 3, j & 7, 1, 0, wv, ctr, sidx); }
        else if (i < 1152) { const int j = i - 1088; attn_unit<1>(a, lds, j >> 3, j & 7, 1, 0, wv, ctr, sidx); }
        else if (i < 1216) { const int j = i - 1152; attn_unit<1>(a, lds, j >> 3, j & 7, 0, 0, wv, ctr, sidx); }
        else { const int j = i - 1216; attn_unit<0>(a, lds, j >> 3, j & 7, 0, 0, wv, ctr, sidx); }
    }
}

#define XB_TMO      128
#define XB_XCNT(j)  (256  + 64 * (j))
#define XB_XSUB(j)  (1280 + 64 * (j))
#define XB_XGEN(j)  (2304 + 64 * (j))
#define XB_TOP      3328
#define XB_TOPGEN   3392
#define XCD_BAR_WORDS 3456
#define XB_SPIN_CAP (1u << 18)

__device__ __forceinline__ unsigned xb_ld(unsigned* p)              { return __hip_atomic_load(p, __ATOMIC_RELAXED, __HIP_MEMORY_SCOPE_AGENT); }
__device__ __forceinline__ unsigned xb_add(unsigned* p, unsigned v) { return __hip_atomic_fetch_add(p, v, __ATOMIC_RELAXED, __HIP_MEMORY_SCOPE_AGENT); }
__device__ __forceinline__ unsigned xb_xcc_id() { return (unsigned)__builtin_amdgcn_s_getreg((3 << 11) | 20) & 0xFu; }
#define XB_SPIN(cond, bar) do { unsigned _sp = 0; while (cond) { __builtin_amdgcn_s_sleep(1); \
    if ((++_sp & 255u) == 0u) { if (xb_ld(&(bar)[XB_TMO])) break; if (_sp > XB_SPIN_CAP) { atomicAdd(&(bar)[XB_TMO], 1u); break; } } } } while (0)

struct XcdBarrier {
    unsigned* bar; unsigned x; bool leader;
    volatile LAS unsigned* st;
};

__device__ __forceinline__ XcdBarrier xcd_barrier_post(unsigned* bar, volatile LAS unsigned* st, const bool leader) {
    XcdBarrier b; b.bar = bar; b.x = xb_xcc_id(); b.st = st; b.leader = leader;
    if (leader) (void)xb_add(&bar[XB_XCNT(b.x)], 1u);
    return b;
}
__device__ __forceinline__ void xcd_barrier_complete(unsigned* bar, unsigned x, unsigned& nloc, unsigned& nx) {
    const unsigned G = gridDim.x * gridDim.y * gridDim.z;
    unsigned sum, cnt, mine, sp = 0u;
    for (;;) {
        sum = 0u; cnt = 0u; mine = 0u;
#pragma unroll
        for (unsigned j = 0; j < 16; ++j) { const unsigned c = xb_ld(&bar[XB_XCNT(j)]); sum += c; cnt += (c > 0u) ? 1u : 0u; mine = (j == x) ? c : mine; }
        if (sum == G) break;
        __builtin_amdgcn_s_sleep(1);
        if ((++sp & 255u) == 0u) { if (xb_ld(&bar[XB_TMO])) break; if (sp > XB_SPIN_CAP) { atomicAdd(&bar[XB_TMO], 1u); break; } }
    }
    nloc = mine > 0u ? mine : 1u; nx = cnt > 0u ? cnt : 1u;
}

__device__ __forceinline__ void xcd_barrier(const XcdBarrier& b, const bool leader_now) {
    asm volatile("s_waitcnt vmcnt(0)" ::: "memory");
    __syncthreads();
    if (leader_now) {
        unsigned* bar = b.bar;
        __builtin_amdgcn_s_waitcnt(0);
        unsigned nloc = b.st[0], nx = b.st[1];
        if (nloc == 0u) { xcd_barrier_complete(bar, b.x, nloc, nx); b.st[0] = nloc; b.st[1] = nx; }
        const unsigned old = xb_add(&bar[XB_XSUB(b.x)], 1u);
        const unsigned gen = old / nloc;
        if (old + 1u == (gen + 1u) * nloc) {
            __builtin_amdgcn_fence(__ATOMIC_RELEASE, "agent");
            asm volatile("s_waitcnt vmcnt(0)" ::: "memory");
            const unsigned og = xb_add(&bar[XB_TOP], 1u);
            const unsigned tg = og / nx;
            if (og + 1u == (tg + 1u) * nx) xb_add(&bar[XB_TOPGEN], 1u);
            else XB_SPIN(xb_ld(&bar[XB_TOPGEN]) == tg, bar);
            __builtin_amdgcn_fence(__ATOMIC_ACQUIRE, "agent");
            xb_add(&bar[XB_XGEN(b.x)], 1u);
            asm volatile("s_waitcnt vmcnt(0)" ::: "memory");
        } else {
            XB_SPIN(xb_ld(&bar[XB_XGEN(b.x)]) == gen, bar);
            __builtin_amdgcn_fence(__ATOMIC_ACQUIRE, "agent");
            asm volatile("s_waitcnt vmcnt(0)" ::: "memory");
        }
    }
    __syncthreads();
}

constexpr int N_PHASES = 7;
__device__ __forceinline__ void grid_bar(unsigned* bar, unsigned& epoch, const int wv, const unsigned nblocks) {
    __syncthreads();
    epoch += 1;
    if (wv == 0 && lane_id() == 0) {
        __builtin_amdgcn_fence(__ATOMIC_RELEASE, "agent");
        asm volatile("s_waitcnt vmcnt(0)" ::: "memory");
        __hip_atomic_fetch_add(bar, 1u, __ATOMIC_RELAXED, __HIP_MEMORY_SCOPE_AGENT);
        const unsigned target = epoch * nblocks;
        while (__hip_atomic_load(bar, __ATOMIC_RELAXED, __HIP_MEMORY_SCOPE_AGENT) < target) __builtin_amdgcn_s_sleep(2);
        __builtin_amdgcn_fence(__ATOMIC_ACQUIRE, "agent");
        asm volatile("s_waitcnt vmcnt(0)" ::: "memory");
    }
    __syncthreads();
}
__global__ void __launch_bounds__(512, 2) mega_fwd(Args a) {
    extern __shared__ __attribute__((aligned(16))) unsigned char lds_raw[];
    LAS unsigned char* lds = (LAS unsigned char*)lds_raw;
    unsigned char* ws = a.ws;
    const int lo = a.ph_lo, hi = a.ph_hi, G = gridDim.x, c = (int)blockIdx.x;
    const int wv = __builtin_amdgcn_readfirstlane((int)threadIdx.x >> 6);
    volatile LAS unsigned* bst = (volatile LAS unsigned*)(lds + RING_BYTES + 12288);
    if (threadIdx.x < 2) bst[threadIdx.x] = 0u;
    __syncthreads();
    XcdBarrier xbar; xbar.bar = (unsigned*)(ws + WS_CTL) + 1024; xbar.x = 0; xbar.st = bst; xbar.leader = false;
    if (a.coop == 2) cg::this_grid().sync();
    if (a.coop) xbar = xcd_barrier_post((unsigned*)(ws + WS_CTL) + 1024, bst, wv == 0 && lane_id() == 0);
#define IN(k) (lo <= (k) && (k) < hi)
#define SEAM(k) do { if (IN(k) && IN((k) + 1)) { if (a.coop) { xcd_barrier(xbar, wv == 0 && lane_id() == 0); } } } while (0)
    if (IN(0)) phase_prologue(a, lds, wv);
    SEAM(0);
    if (IN(1)) {
        pg8::Gemm g{(const bf16_t*)(ws + WS_H), (const bf16_t*)(ws + WS_WIN), MP, NIN, DM}; pg8::StaticOrder S; S.init(MP, NIN, G, c);
        EpiIn E{ws, a.out};
        pg8::gemm_phase<EpiIn, pg8::StaticOrder, true, true>(lds, g, S, E, wv);
        small_gemm_a4<EpiIn>(lds, g.A, g.Bt, NIN, E, wv);
    }
    SEAM(1);
    if (IN(2)) phase_attention(a, lds, wv);
    SEAM(2);
    if (IN(3)) {
        { pg8::Gemm g{(const bf16_t*)(ws + WS_OA), (const bf16_t*)(ws + WS_WPA), MP, DM, HW}; pg8::StaticOrder S; S.init(MP, DM, G, c);
          EpiProjA E{(const bf16_t*)(ws + WS_GA), (bf16_t*)(ws + WS_T)};
          pg8::gemm_phase<EpiProjA, pg8::StaticOrder, true, true>(lds, g, S, E, wv);
          small_gemm<EpiProjA>(lds, g.A, g.Bt, HW, DM, E, wv); }
        { pg8::Gemm g{(const bf16_t*)(ws + WS_OB), (const bf16_t*)(ws + WS_WPB), MP, DM, HW}; pg8::StaticOrder S; S.init(MP, DM, G, c);
          EpiProjB E{(const bf16_t*)(ws + WS_GB), (const bf16_t*)(ws + WS_T), (bf16_t*)(ws + WS_MG)};
          pg8::gemm_phase<EpiProjB, pg8::StaticOrder, true, true>(lds, g, S, E, wv);
          small_gemm<EpiProjB>(lds, g.A, g.Bt, HW, DM, E, wv); }
    }
    SEAM(3);
    if (IN(4)) {
        pg8::Gemm g{(const bf16_t*)(ws + WS_MG), (const bf16_t*)(ws + WS_WOUT), MP, DM, DM}; pg8::StaticOrder S; S.init(MP, DM, G, c);
        EpiOutNorm EN{a.in[I_XP], (bf16_t*)(ws + WS_X1), (bf16_t*)(ws + WS_H), a.in[I_G2], a.in[I_G3], RowStat{(float*)(ws + WS_XB1), (unsigned*)(ws + WS_CTL) + CW_CNT1}, RowStat{(float*)(ws + WS_XB2), (unsigned*)(ws + WS_CTL) + CW_CNT2}};
        pg8::gemm_phase<EpiOutNorm, pg8::StaticOrder, false, true>(lds, g, S, EN, wv);
        __syncthreads();
        small_gemm_norm<0>(lds, g.A, g.Bt, DM, a.in[I_XS], a.out + O_Y, (bf16_t*)(ws + WS_X1), (bf16_t*)(ws + WS_H), a.in[I_G2], a.in[I_G3],
                           TailStat{(float*)(ws + WS_XT1), (unsigned*)(ws + WS_CTL) + CW_TC1}, TailStat{(float*)(ws + WS_XT2), (unsigned*)(ws + WS_CTL) + CW_TC2}, wv);
    }
    SEAM(4);
    if (IN(5)) {
        pg8::Gemm g{(const bf16_t*)(ws + WS_H), (const bf16_t*)(ws + WS_WUP), MTOK, NUP, DM}; pg8::StaticOrder S; S.init(MTOK, NUP, G, c);
        EpiUpFused E{(bf16_t*)(ws + WS_A2), a.out, a.in[I_CW], a.in[I_CB], a.in[I_CONV], (float*)(ws + WS_HEAD), (float*)(ws + WS_TAIL), (LAS float*)(lds + RING_BYTES)};
        pg8::gemm_phase<EpiUpFused, pg8::StaticOrder, true, true>(lds, g, S, E, wv);
    }
    SEAM(5);
    if (IN(6)) {
        pg8::Gemm g{(const bf16_t*)(ws + WS_A2), (const bf16_t*)(ws + WS_WDN), MP, DM, DFF}; pg8::StaticOrder S; S.init(MP, DM, G, c);
        { Unit fu; for (int i = 0; S.next(i, fu); ++i) ffn_fixup(a, fu.pm, wv * 64 + lane_id()); }
        __syncthreads();
        EpiDownNorm EN{(const bf16_t*)(ws + WS_X1), a.out + O_Y, a.in[I_G4], RowStat{(float*)(ws + WS_XB3), (unsigned*)(ws + WS_CTL) + CW_CNT3}};
        pg8::gemm_phase<EpiDownNorm, pg8::StaticOrder, false, true>(lds, g, S, EN, wv);
        __syncthreads();
        small_gemm_norm<1>(lds, g.A, g.Bt, DFF, nullptr, a.out + O_Y, (bf16_t*)(ws + WS_X1), nullptr, a.in[I_G4], nullptr,
                           TailStat{(float*)(ws + WS_XT3), (unsigned*)(ws + WS_CTL) + CW_TC3}, TailStat{nullptr, nullptr}, wv);
    }
#undef IN
#undef SEAM
}

#ifndef MK_N_LAUNCHES
#define MK_N_LAUNCHES 1
#endif
extern "C" void kernel_launch(void* const* d_in, const int* in_sizes, int n_in, void* d_out, int out_size, void* d_ws, size_t ws_size, hipStream_t stream) {
    static int grid = 0;
    if (grid == 0) {
        if (n_in != 22 || (size_t)out_size != O_END || ws_size < WS_END) { fprintf(stderr, "kernel_launch: unexpected sizes n_in %d out %d ws %zu\n", n_in, out_size, ws_size); grid = -1; return; }
        int dev = 0, cus = 0, per_cu = 0;
        hipGetDevice(&dev);
        hipDeviceGetAttribute(&cus, hipDeviceAttributeMultiprocessorCount, dev);
        hipFuncSetAttribute((const void*)mega_fwd, hipFuncAttributeMaxDynamicSharedMemorySize, LDS_BYTES);
        hipOccupancyMaxActiveBlocksPerMultiprocessor(&per_cu, (const void*)mega_fwd, 512, LDS_BYTES);
        if (per_cu < 1) { fprintf(stderr, "kernel_launch: occupancy query says %d blocks/CU\n", per_cu); per_cu = 1; }
        (void)hipGetLastError();
        grid = cus;
        if (grid != 256) { fprintf(stderr, "kernel_launch: built for 256 CUs (one 256x256 unit per workgroup in the fused-norm GEMMs), device has %d\n", grid); grid = -1; return; }
    }
    if (grid < 0) return;
    hipMemsetAsync((char*)d_ws + WS_CTL, 0, CTL_BYTES, stream);
    Args a{};
    for (int i = 0; i < 22; ++i) a.in[i] = (const float*)d_in[i];
    a.out = (float*)d_out; a.ws = (unsigned char*)d_ws;
#if MK_N_LAUNCHES == 1
    a.ph_lo = 0; a.ph_hi = N_PHASES; a.coop = 1; a.pad = 0;
    void* args[] = {&a};
    hipError_t e = hipLaunchCooperativeKernel((const void*)mega_fwd, dim3(grid), dim3(512), args, LDS_BYTES, stream);
    if (e != hipSuccess) fprintf(stderr, "cooperative launch failed: %s (grid %d)\n", hipGetErrorString(e), grid);
#else
    for (int p = 0; p < N_PHASES; ++p) {
        a.ph_lo = p; a.ph_hi = p + 1; a.coop = 0; a.pad = 0;
        hipLaunchKernelGGL(mega_fwd, dim3(grid), dim3(512), LDS_BYTES, stream, a);
    }
#endif
}
```

```cpp
#include <hip/hip_runtime.h>
#include <hip/hip_cooperative_groups.h>
#include <cstdio>
#include <cstdint>
namespace cg = cooperative_groups;
namespace pg8 {
#define PG8_LAS __attribute__((address_space(3)))
typedef unsigned short bf16_t;
typedef short bf16x8 __attribute__((ext_vector_type(8)));
typedef float f32x4 __attribute__((ext_vector_type(4)));
typedef unsigned u32x4 __attribute__((ext_vector_type(4)));
constexpr int BM = 256, BK = 64, HALF = 128, HTB = HALF * BK * 2  , STAGE_BYTES = 8 * HTB, NXCD = 8, WGM = 8;

__host__ __device__ __forceinline__ int lds_byte(int r, int c) { const int st = (r >> 4) * 2 + (c >> 5), rr = r & 15, cc = c & 31, ob = rr * 64 + cc * 2; return st * 1024 + (ob ^ (((ob >> 9) & 1) << 5)); }
__host__ __device__ __forceinline__ void stage_rc(int b, int& R, int& C) { const int st = b / 1024, sb = b % 1024, swz = sb ^ (((sb >> 9) & 1) << 5); R = (st >> 1) * 16 + swz / 64; C = (st & 1) * 32 + (swz % 64) / 2; }
__host__ __device__ __forceinline__ int perm32(int rho) { const int n = rho >> 4, i = rho & 15; return 8 * (i >> 2) + 4 * n + (i & 3); }

struct Unit { int pm, pn; };
struct Gemm { const bf16_t* A; const bf16_t* Bt; int M, N, K; };

struct StaticOrder {
    int nM, nN, nwg, G, c;
    __host__ __device__ void init(int M, int N, int G_, int c_) { nM = M / BM; nN = N / BM; nwg = nM * nN; G = G_; c = c_; }
    __host__ __device__ __forceinline__ bool next(int i, Unit& u) const {
        const long L = (long)i * G + c; if (L >= nwg) return false;
        int wgid = (int)L; { const int q = nwg / NXCD, r = nwg % NXCD, xcd = wgid % NXCD, off = wgid / NXCD; wgid = (xcd < r ? xcd * (q + 1) : r * (q + 1) + (xcd - r) * q) + off; }
        const int nig = WGM * nN, gid = wgid / nig, fm = gid * WGM, gsz = (nM - fm) < WGM ? (nM - fm) : WGM;
        u.pm = fm + ((wgid % nig) % gsz); u.pn = (wgid % nig) / gsz; return true;
    }
    __device__ __forceinline__ void a_ready(const Unit&) const {}
    __device__ __forceinline__ void done(const Unit&) const {}
};

__device__ __forceinline__ unsigned cvt_pk_bf16(float lo, float hi) { unsigned r; asm volatile("v_cvt_pk_bf16_f32 %0, %1, %2" : "=v"(r) : "v"(lo), "v"(hi)); return r; }
typedef float f32x2 __attribute__((ext_vector_type(2)));
template <class Epi, class Sched, bool ALIGN_EPI = false, bool SP2 = false>
__device__ __forceinline__ void gemm_phase(PG8_LAS unsigned char* lds, const Gemm g, const Sched& S, const Epi& E, const int wv) {
    const int wid = wv, lane = (int)__builtin_amdgcn_mbcnt_hi(~0u, __builtin_amdgcn_mbcnt_lo(~0u, 0u)), tid = wid * 64 + lane, wr = wid >> 2, wc = wid & 3, fr = lane & 15, fq = lane >> 4;
    const int K = g.K, nt = K / BK;
    unsigned voffA[2], voffB[2];
#pragma unroll
    for (int i = 0; i < 2; ++i) { int R, C; stage_rc(tid * 16 + i * 8192, R, C); const int Rb = Epi::PERM ? ((R & ~31) + perm32(R & 31)) : R;
        voffA[i] = (unsigned)(R * K + C) * 2u; voffB[i] = (unsigned)(Rb * K + C) * 2u; }
    const size_t kstep = (size_t)(BK * 2);
    const size_t hstep = (size_t)HALF * K * 2;
    const size_t tstep = 2 * hstep;
    const unsigned ldsw = (unsigned)wid * 1024u;
    const int aoff = lds_byte(wr * 64 + fr, fq * 8), boff = lds_byte(wc * 32 + fr, fq * 8);
#define PG8_SA(b, h) (((b) * 2 + (h)) * HTB)
#define PG8_SB(b, h) ((4 + (b) * 2 + (h)) * HTB)
#define PG8_STAGE(bufoff, gbase, voff) do { _Pragma("unroll") for (int _i = 0; _i < 2; ++_i) \
        __builtin_amdgcn_global_load_lds((const unsigned*)((const char*)(gbase) + (voff)[_i]), (PG8_LAS unsigned*)(lds + (bufoff) + ldsw + _i * 8192), 16, 0, 0); } while (0)
#define PG8_LDA(dst, b, h) do { _Pragma("unroll") for (int m = 0; m < 4; ++m) _Pragma("unroll") for (int k = 0; k < 2; ++k) dst[m][k] = *(const PG8_LAS bf16x8*)(lds + PG8_SA(b, h) + aoff + m * 2048 + k * 1024); } while (0)
#define PG8_LDB(dst, b, h) do { _Pragma("unroll") for (int n = 0; n < 2; ++n) _Pragma("unroll") for (int k = 0; k < 2; ++k) dst[n][k] = *(const PG8_LAS bf16x8*)(lds + PG8_SB(b, h) + boff + n * 2048 + k * 1024); } while (0)
#define PG8_MMA(ai, bj, At, Bt) do { __builtin_amdgcn_s_setprio(1); _Pragma("unroll") for (int m = 0; m < 4; ++m) _Pragma("unroll") for (int n = 0; n < 2; ++n) _Pragma("unroll") for (int k = 0; k < 2; ++k) \
        acc[ai][bj][m][n] = __builtin_amdgcn_mfma_f32_16x16x32_bf16(Bt[n][k], At[m][k], acc[ai][bj][m][n], 0, 0, 0); __builtin_amdgcn_s_setprio(0); } while (0)
#define PG8_WAIT_V(n) asm volatile("s_waitcnt vmcnt(" #n ")" ::: "memory")
#define PG8_WAIT_L(n) asm volatile("s_waitcnt lgkmcnt(" #n ")" ::: "memory")
#define PG8_BAR __builtin_amdgcn_s_barrier()
#define PG8_SCHED __builtin_amdgcn_sched_barrier(0)
    Unit cur, nxt; int ui = 0;
    if (!S.next(0, cur)) return;
    f32x4 acc[2][2][4][2];
#pragma unroll
    for (int a = 0; a < 2; ++a)
#pragma unroll
        for (int b = 0; b < 2; ++b)
#pragma unroll
            for (int m = 0; m < 4; ++m)
#pragma unroll
                for (int n = 0; n < 2; ++n) acc[a][b][m][n] = (f32x4){0.f, 0.f, 0.f, 0.f};
    bf16x8 At[4][2], B0[2][2], B1[2][2];
    const char* cA = (const char*)g.A + (size_t)cur.pm * tstep; const char* cB = (const char*)g.Bt + (size_t)cur.pn * tstep;
    S.a_ready(cur);
    if constexpr (SP2) {
        PG8_STAGE(PG8_SB(0, 0), cB, voffB); PG8_STAGE(PG8_SB(0, 1), cB + hstep, voffB); PG8_STAGE(PG8_SA(0, 0), cA, voffA); PG8_STAGE(PG8_SA(0, 1), cA + hstep, voffA);
        if (wr == 1) PG8_BAR;
        PG8_WAIT_V(2); PG8_BAR;
        PG8_STAGE(PG8_SB(1, 0), cB + kstep, voffB); PG8_STAGE(PG8_SA(1, 0), cA + kstep, voffA); PG8_STAGE(PG8_SB(1, 1), cB + hstep + kstep, voffB);
        PG8_WAIT_V(6); PG8_BAR;
    } else {
        PG8_STAGE(PG8_SB(0, 0), cB, voffB); PG8_STAGE(PG8_SA(0, 0), cA, voffA); PG8_STAGE(PG8_SB(0, 1), cB + hstep, voffB); PG8_STAGE(PG8_SA(0, 1), cA + hstep, voffA);
        if (wr == 1) PG8_BAR;
        PG8_WAIT_V(4); PG8_BAR;
        PG8_STAGE(PG8_SB(1, 0), cB + kstep, voffB); PG8_STAGE(PG8_SA(1, 0), cA + kstep, voffA); PG8_STAGE(PG8_SB(1, 1), cB + hstep + kstep, voffB);
        PG8_WAIT_V(6); PG8_BAR;
    }
    for (;;) {
        const bool has_next = S.next(ui + 1, nxt);
        const char* nA = has_next ? (const char*)g.A + (size_t)nxt.pm * tstep : cA; const char* nB = has_next ? (const char*)g.Bt + (size_t)nxt.pn * tstep : cB;
        for (int t = 0; t < nt; t += 2) {
            const bool last = (t == nt - 2);
            const char* a1 = cA + (size_t)(t + 1) * kstep;
            const char* a2 = last ? nA : cA + (size_t)(t + 2) * kstep; const char* b2 = last ? nB : cB + (size_t)(t + 2) * kstep;
            const char* a3 = a2 + kstep; const char* b3 = b2 + kstep;
            if (last && has_next) S.a_ready(nxt);
            if constexpr (SP2) {
            PG8_LDB(B0, 0, 0); PG8_LDB(B1, 0, 1); PG8_SCHED; PG8_LDA(At, 0, 0); PG8_STAGE(PG8_SA(1, 1), a1 + hstep, voffA);
            PG8_WAIT_V(8); PG8_WAIT_L(0); PG8_BAR; PG8_MMA(0, 0, At, B0); PG8_MMA(0, 1, At, B1); PG8_BAR; PG8_SCHED;
            PG8_LDA(At, 0, 1); PG8_STAGE(PG8_SB(0, 0), b2, voffB); PG8_STAGE(PG8_SB(0, 1), b2 + hstep, voffB); PG8_STAGE(PG8_SA(0, 0), a2, voffA);
            PG8_WAIT_V(8); PG8_WAIT_L(0); PG8_BAR; PG8_MMA(1, 0, At, B0); PG8_MMA(1, 1, At, B1); PG8_BAR; PG8_SCHED;
            PG8_LDB(B0, 1, 0); PG8_LDB(B1, 1, 1); PG8_SCHED; PG8_LDA(At, 1, 0); PG8_STAGE(PG8_SA(0, 1), a2 + hstep, voffA);
            PG8_WAIT_V(8); PG8_WAIT_L(0); PG8_BAR; PG8_MMA(0, 0, At, B0); PG8_MMA(0, 1, At, B1); PG8_BAR; PG8_SCHED;
            PG8_LDA(At, 1, 1); PG8_STAGE(PG8_SB(1, 0), b3, voffB); PG8_STAGE(PG8_SB(1, 1), b3 + hstep, voffB); PG8_STAGE(PG8_SA(1, 0), a3, voffA);
            PG8_WAIT_V(8); PG8_WAIT_L(0); PG8_BAR; PG8_MMA(1, 0, At, B0); PG8_MMA(1, 1, At, B1); PG8_BAR; PG8_SCHED;
            } else {
            PG8_LDB(B0, 0, 0); PG8_SCHED; PG8_LDA(At, 0, 0); PG8_STAGE(PG8_SA(1, 1), a1 + hstep, voffA);
            PG8_WAIT_L(8); PG8_BAR; PG8_WAIT_L(0); PG8_MMA(0, 0, At, B0); PG8_BAR; PG8_SCHED;
            PG8_LDB(B1, 0, 1); PG8_STAGE(PG8_SB(0, 0), b2, voffB);
            PG8_BAR; PG8_WAIT_L(0); PG8_MMA(0, 1, At, B1); PG8_BAR;
            PG8_LDA(At, 0, 1); PG8_STAGE(PG8_SA(0, 0), a2, voffA);
            PG8_BAR; PG8_WAIT_L(0); PG8_MMA(1, 0, At, B0); PG8_BAR; PG8_SCHED;
            PG8_STAGE(PG8_SB(0, 1), b2 + hstep, voffB);
            PG8_WAIT_V(6); PG8_BAR; PG8_MMA(1, 1, At, B1); PG8_BAR;
            PG8_LDB(B0, 1, 0); PG8_SCHED; PG8_LDA(At, 1, 0); PG8_STAGE(PG8_SA(0, 1), a2 + hstep, voffA);
            PG8_WAIT_L(8); PG8_BAR; PG8_WAIT_L(0); PG8_MMA(0, 0, At, B0); PG8_BAR; PG8_SCHED;
            PG8_LDB(B1, 1, 1); PG8_STAGE(PG8_SB(1, 0), b3, voffB);
            PG8_BAR; PG8_WAIT_L(0); PG8_MMA(0, 1, At, B1); PG8_BAR;
            PG8_LDA(At, 1, 1); PG8_STAGE(PG8_SA(1, 0), a3, voffA);
            PG8_BAR; PG8_WAIT_L(0); PG8_MMA(1, 0, At, B0); PG8_BAR; PG8_SCHED;
            PG8_STAGE(PG8_SB(1, 1), b3 + hstep, voffB);
            PG8_WAIT_V(6); PG8_BAR; PG8_MMA(1, 1, At, B1); PG8_BAR;
            }
        }
        if constexpr (ALIGN_EPI) { if (wr == 0) PG8_BAR; }
        if constexpr (!Epi::AFTER_DRAIN) { E(acc, cur, wr, wc, fr, fq); S.done(cur); }
        if (!has_next) break;
#pragma unroll
        for (int a = 0; a < 2; ++a)
#pragma unroll
            for (int b = 0; b < 2; ++b)
#pragma unroll
                for (int m = 0; m < 4; ++m)
#pragma unroll
                    for (int n = 0; n < 2; ++n) acc[a][b][m][n] = (f32x4){0.f, 0.f, 0.f, 0.f};
        cur = nxt; cA = nA; cB = nB; ++ui;
        if constexpr (ALIGN_EPI) { if (wr == 1) PG8_BAR; }
    }
    PG8_WAIT_V(0);
    if constexpr (!ALIGN_EPI) { if (wr == 0) PG8_BAR; }
    PG8_BAR;
    if constexpr (Epi::AFTER_DRAIN) { E.fused(acc, cur, wr, wc, fr, fq, lds, wid, lane); S.done(cur); }
#undef PG8_SA
#undef PG8_SB
#undef PG8_STAGE
#undef PG8_LDA
#undef PG8_LDB
#undef PG8_MMA
#undef PG8_WAIT_V
#undef PG8_WAIT_L
#undef PG8_BAR
#undef PG8_SCHED
}
}

#define LAS __attribute__((address_space(3)))
using pg8::bf16_t; using pg8::bf16x8; using pg8::f32x4; using pg8::u32x4; using pg8::Unit;
typedef float f32x16 __attribute__((ext_vector_type(16)));
typedef short s16x4 __attribute__((ext_vector_type(4)));
typedef unsigned u32x2 __attribute__((ext_vector_type(2)));

constexpr int DM = 1024, NBAT = 8, SEQ = 2048, DBAT = 16, DSEQ = 64, PAST = 2048, ALEN = 512;
constexpr int MP = NBAT * SEQ, MS = DBAT * DSEQ, MTOK = MP + MS;
constexpr int HW = 512;
constexpr int NIN = 5120;
constexpr int DFF = 2816, NUP = 2 * DFF;
constexpr float EPS = 1e-6f, LOG2E = 1.4426950408889634f, QSCALE = 0.125f * LOG2E;

constexpr size_t O_Y = 0;
constexpr size_t O_KA_P = (size_t)MTOK * DM;
constexpr size_t O_VA_P = O_KA_P + (size_t)NBAT * ALEN * HW;
constexpr size_t O_KB_P = O_VA_P + (size_t)NBAT * ALEN * HW;
constexpr size_t O_VB_P = O_KB_P + (size_t)NBAT * SEQ * HW;
constexpr size_t O_LF_P = O_VB_P + (size_t)NBAT * SEQ * HW;
constexpr size_t O_CV_P = O_LF_P + (size_t)NBAT * SEQ * 8;
constexpr size_t O_KA_S = O_CV_P + (size_t)NBAT * 2 * NUP;
constexpr size_t O_VA_S = O_KA_S + (size_t)MS * HW;
constexpr size_t O_KB_S = O_VA_S + (size_t)MS * HW;
constexpr size_t O_VB_S = O_KB_S + (size_t)MS * HW;
constexpr size_t O_LF_S = O_VB_S + (size_t)MS * HW;
constexpr size_t O_CV_S = O_LF_S + (size_t)MS * 8;
constexpr size_t O_END = O_CV_S + (size_t)DBAT * 2 * NUP;
static_assert(O_END == 41304064, "output size");

constexpr size_t MiB = 1u << 20;
constexpr size_t WS_CTL = 0, CTL_BYTES = 131072;
constexpr int CW_CNT1 = 8192, CW_CNT2 = 12288, CW_CNT3 = 16384, CW_TC1 = 20480, CW_TC2 = 21504, CW_TC3 = 22528;
constexpr size_t WS_WIN = 1 * MiB, WS_WUP = 11 * MiB, WS_WDN = 22 * MiB, WS_WOUT = 28 * MiB, WS_WPA = 30 * MiB, WS_WPB = 31 * MiB;
constexpr size_t WS_H = 32 * MiB;
constexpr size_t WS_OA = 32 * MiB, WS_OB = 236 * MiB;
constexpr size_t WS_QKV = 66 * MiB;
constexpr size_t QKV_STRIDE = (size_t)MTOK * HW;
constexpr size_t WS_GA = 168 * MiB, WS_GB = 202 * MiB;
constexpr size_t WS_T = 66 * MiB;
constexpr size_t WS_X1 = 100 * MiB;
constexpr size_t WS_MG = 134 * MiB;
constexpr size_t WS_U = 66 * MiB;
constexpr size_t WS_A2 = 160 * MiB;
constexpr size_t WS_HEAD = 254 * MiB, WS_TAIL = 258 * MiB;
constexpr size_t WS_XB1 = 262 * MiB, WS_XB2 = WS_XB1 + 262144, WS_XB3 = WS_XB2 + 262144;
constexpr size_t WS_XT1 = WS_XB3 + 262144, WS_XT2 = WS_XT1 + 65536, WS_XT3 = WS_XT2 + 65536;
constexpr size_t WS_END = 264 * MiB;
static_assert(WS_A2 + (size_t)MTOK * DFF * 2 <= WS_END && WS_U + (size_t)MTOK * DFF * 2 <= WS_A2, "ws map");

constexpr int RING_BYTES = 131072, LDS_BYTES = 147456;

struct Args { const float* in[22]; float* out; unsigned char* ws; int ph_lo, ph_hi, coop, pad; };
enum { I_XP = 0, I_XS, I_CKA, I_CVA, I_CKB, I_CVB, I_CLF, I_CONV, I_G1, I_G2, I_G3, I_G4, I_WIN, I_BF, I_REL, I_WPA, I_WPB, I_WOUT, I_WUP, I_CW, I_CB, I_WDN };

__device__ __forceinline__ void lds_barrier() { asm volatile("s_waitcnt lgkmcnt(0)" ::: "memory"); __builtin_amdgcn_s_barrier(); asm volatile("" ::: "memory"); }
__device__ __forceinline__ int lane_id() { return (int)__builtin_amdgcn_mbcnt_hi(~0u, __builtin_amdgcn_mbcnt_lo(~0u, 0u)); }
__device__ __forceinline__ unsigned f2bf(float f) { unsigned u = __builtin_bit_cast(unsigned, f); return (u + 0x7fffu + ((u >> 16) & 1u)) >> 16; }
__device__ __forceinline__ unsigned pk2(float lo, float hi) { return pg8::cvt_pk_bf16(lo, hi); }
__device__ __forceinline__ float bflo(unsigned w) { return __uint_as_float(w << 16); }
__device__ __forceinline__ float bfhi(unsigned w) { return __uint_as_float(w & 0xffff0000u); }
__device__ __forceinline__ float wave_sum(float v) {
#pragma unroll
    for (int o = 1; o < 64; o <<= 1) v += __shfl_xor(v, o);
    return v;
}
__device__ __forceinline__ float sigmoidf_(float x) { return __builtin_amdgcn_rcpf(1.0f + __builtin_amdgcn_exp2f(-x * LOG2E)); }
__device__ __forceinline__ const float* xrow_ptr(const Args& a, int m) { return m < MP ? a.in[I_XP] + (size_t)m * DM : a.in[I_XS] + (size_t)(m - MP) * DM; }

#define EPI_MAIN_CALL \
    __device__ __forceinline__ void operator()(const f32x4 (&acc)[2][2][4][2], const Unit& u, int wr, int wc, int fr, int fq) const { \
        _Pragma("unroll") for (int ai = 0; ai < 2; ++ai) _Pragma("unroll") for (int m = 0; m < 4; ++m) { \
            const int row = u.pm * 256 + ai * 128 + wr * 64 + m * 16 + fr; \
            _Pragma("unroll") for (int bj = 0; bj < 2; ++bj) store8(row, u.pn * 256 + bj * 128 + wc * 32 + 8 * fq, acc[ai][bj][m][0], acc[ai][bj][m][1]); } }
struct EpiIn {
    static constexpr bool PERM = true, AFTER_DRAIN = false;
    unsigned char* ws; float* out;
    __device__ __forceinline__ void store8(int row, int col, f32x4 v0, f32x4 v1) const {
        const int pn = col >> 8, seg = pn >> 1;
        bf16_t* bdst; int pitch, cl; float sc = 1.f; const bool sig = pn >= 12;
        if (!sig) { bdst = (bf16_t*)(ws + WS_QKV) + (size_t)seg * QKV_STRIDE; pitch = HW; cl = col & 511; if (seg == 0 || seg == 3) sc = QSCALE; }
        else { bdst = (bf16_t*)(ws + (pn < 16 ? WS_GA : WS_GB)); pitch = DM; cl = (col - 3072) & 1023; }
        if (sig) {
#pragma unroll
            for (int e = 0; e < 4; ++e) { v0[e] = sigmoidf_(v0[e]); v1[e] = sigmoidf_(v1[e]); }
        } else { v0 = v0 * sc; v1 = v1 * sc; }
        u32x4 w; w.x = pk2(v0[0], v0[1]); w.y = pk2(v0[2], v0[3]); w.z = pk2(v1[0], v1[1]); w.w = pk2(v1[2], v1[3]);
        *(u32x4*)(bdst + (size_t)row * pitch + cl) = w;
    }
    EPI_MAIN_CALL
};
struct EpiProjA {
    static constexpr bool PERM = true, AFTER_DRAIN = false;
    const bf16_t* G; bf16_t* T;
    __device__ __forceinline__ void store8(int row, int c, f32x4 v0, f32x4 v1) const {
        const u32x4 g = *(const u32x4*)(G + (size_t)row * DM + c);
        v0[0] *= bflo(g.x); v0[1] *= bfhi(g.x); v0[2] *= bflo(g.y); v0[3] *= bfhi(g.y);
        v1[0] *= bflo(g.z); v1[1] *= bfhi(g.z); v1[2] *= bflo(g.w); v1[3] *= bfhi(g.w);
        u32x4 w; w.x = pk2(v0[0], v0[1]); w.y = pk2(v0[2], v0[3]); w.z = pk2(v1[0], v1[1]); w.w = pk2(v1[2], v1[3]);
        *(u32x4*)(T + (size_t)row * DM + c) = w;
    }
    EPI_MAIN_CALL
};
struct EpiProjB {
    static constexpr bool PERM = true, AFTER_DRAIN = false;
    const bf16_t* G; const bf16_t* T; bf16_t* MG;
    __device__ __forceinline__ void store8(int row, int c, f32x4 v0, f32x4 v1) const {
        const u32x4 g = *(const u32x4*)(G + (size_t)row * DM + c);
        const u32x4 tw = *(const u32x4*)(T + (size_t)row * DM + c);
        const f32x4 t0 = {bflo(tw.x), bfhi(tw.x), bflo(tw.y), bfhi(tw.y)}, t1 = {bflo(tw.z), bfhi(tw.z), bflo(tw.w), bfhi(tw.w)};
        v0[0] = t0[0] + v0[0] * bflo(g.x); v0[1] = t0[1] + v0[1] * bfhi(g.x); v0[2] = t0[2] + v0[2] * bflo(g.y); v0[3] = t0[3] + v0[3] * bfhi(g.y);
        v1[0] = t1[0] + v1[0] * bflo(g.z); v1[1] = t1[1] + v1[1] * bfhi(g.z); v1[2] = t1[2] + v1[2] * bflo(g.w); v1[3] = t1[3] + v1[3] * bfhi(g.w);
        u32x4 w; w.x = pk2(v0[0], v0[1]); w.y = pk2(v0[2], v0[3]); w.z = pk2(v1[0], v1[1]); w.w = pk2(v1[2], v1[3]);
        *(u32x4*)(MG + (size_t)row * DM + c) = w;
    }
    EPI_MAIN_CALL
};
struct EpiF32 {
    static constexpr bool PERM = true, AFTER_DRAIN = false;
    bf16_t* T;
    __device__ __forceinline__ void store8(int row, int c, f32x4 v0, f32x4 v1) const {
        u32x4 w; w.x = pk2(v0[0], v0[1]); w.y = pk2(v0[2], v0[3]); w.z = pk2(v1[0], v1[1]); w.w = pk2(v1[2], v1[3]);
        *(u32x4*)(T + (size_t)row * DM + c) = w;
    }
    EPI_MAIN_CALL
};

__device__ __forceinline__ bf16x8 frag_perm(const u32x4 v, const int paddr) {
    u32x4 r; r.x = (unsigned)__builtin_amdgcn_ds_bpermute(paddr, (int)v.x); r.y = (unsigned)__builtin_amdgcn_ds_bpermute(paddr, (int)v.y);
    r.z = (unsigned)__builtin_amdgcn_ds_bpermute(paddr, (int)v.z); r.w = (unsigned)__builtin_amdgcn_ds_bpermute(paddr, (int)v.w);
    return __builtin_bit_cast(bf16x8, r);
}
template <class Epi>
__device__ __forceinline__ void small_gemm_range(LAS unsigned char* lds, const bf16_t* A, const bf16_t* Bt, const int K, const int ubeg, const int uend, const int ustride, const Epi& E, const int wv) {
    int lane_ = lane_id(); asm volatile("" : "+v"(lane_));
    const int lane = lane_, fr = lane & 15, fq = lane >> 4, tid = wv * 64 + lane;
    const int kw = K >> 3;
    LAS float* red = (LAS float*)lds;
    for (int u = ubeg; u < uend; u += ustride) {
        const int rc = u & 15, cc = u >> 4;
        const bf16_t* Ap = A + (size_t)(MP + rc * 64 + (lane >> 2)) * K + wv * kw + 8 * (lane & 3);
        const bf16_t* Bp = Bt + (size_t)(cc * 64 + (lane >> 2)) * K + wv * kw + 8 * (lane & 3);
        const int paddr = ((lane & 15) * 4 + (lane >> 4)) * 4;
        f32x4 acc[4][4];
#pragma unroll
        for (int m = 0; m < 4; ++m)
#pragma unroll
            for (int n = 0; n < 4; ++n) acc[m][n] = (f32x4){0.f, 0.f, 0.f, 0.f};
#pragma unroll 4
        for (int ks = 0; ks < kw; ks += 32) {
            u32x4 ar[4], br[4]; bf16x8 af[4], bfr[4];
#pragma unroll
            for (int m = 0; m < 4; ++m) { ar[m] = *(const u32x4*)(Ap + (size_t)(m * 16) * K + ks); br[m] = *(const u32x4*)(Bp + (size_t)(m * 16) * K + ks); }
#pragma unroll
            for (int m = 0; m < 4; ++m) { af[m] = frag_perm(ar[m], paddr); bfr[m] = frag_perm(br[m], paddr); }
#pragma unroll
            for (int m = 0; m < 4; ++m)
#pragma unroll
                for (int n = 0; n < 4; ++n) acc[m][n] = __builtin_amdgcn_mfma_f32_16x16x32_bf16(bfr[n], af[m], acc[m][n], 0, 0, 0);
        }
#pragma unroll
        for (int m = 0; m < 4; ++m)
#pragma unroll
            for (int n = 0; n < 4; ++n) *(LAS f32x4*)(red + (wv * 64 + 16 * m + fr) * 68 + 16 * n + 4 * fq) = acc[m][n];
        __syncthreads();
        const int r = tid >> 3, c8 = (tid & 7) * 8;
        f32x4 s0 = {0.f, 0.f, 0.f, 0.f}, s1 = {0.f, 0.f, 0.f, 0.f};
#pragma unroll
        for (int w = 0; w < 8; ++w) { s0 += *(const LAS f32x4*)(red + (w * 64 + r) * 68 + c8); s1 += *(const LAS f32x4*)(red + (w * 64 + r) * 68 + c8 + 4); }
        E.store8(MP + rc * 64 + r, cc * 64 + c8, s0, s1);
        __syncthreads();
    }
}
template <class Epi>
__device__ __forceinline__ void small_gemm(LAS unsigned char* lds, const bf16_t* A, const bf16_t* Bt, const int K, const int N, const Epi& E, const int wv) {
    small_gemm_range<Epi>(lds, A, Bt, K, (int)blockIdx.x, 16 * (N >> 6), (int)gridDim.x, E, wv);
}
struct TailStat { float* xs; unsigned* cnt; };
__device__ __forceinline__ float tail_row_stat(const TailStat& st, const float part8, const int rc, const int cc, const int r, const int tid) {
    float p = part8; p += __shfl_xor(p, 1); p += __shfl_xor(p, 2); p += __shfl_xor(p, 4);
    if ((tid & 7) == 0) __hip_atomic_store(st.xs + (size_t)(rc * 64 + r) * 16 + cc, p, __ATOMIC_RELAXED, __HIP_MEMORY_SCOPE_AGENT);
    asm volatile("s_waitcnt vmcnt(0)" ::: "memory"); __syncthreads();
    if (tid == 0) {
        __hip_atomic_fetch_add(st.cnt + 64 * rc, 1u, __ATOMIC_RELAXED, __HIP_MEMORY_SCOPE_AGENT);
        while (__hip_atomic_load(st.cnt + 64 * rc, __ATOMIC_RELAXED, __HIP_MEMORY_SCOPE_AGENT) < 16u) __builtin_amdgcn_s_sleep(1);
        __builtin_amdgcn_fence(__ATOMIC_ACQUIRE, "agent");
    }
    __syncthreads();
    float q = 0.f;
#pragma unroll
    for (int j = 0; j < 16; ++j) q += __hip_atomic_load(st.xs + (size_t)(rc * 64 + r) * 16 + j, __ATOMIC_RELAXED, __HIP_MEMORY_SCOPE_AGENT);
    return 1.0f / sqrtf(q * (1.0f / DM) + EPS);
}
template <int MODE>
__device__ __forceinline__ void small_gemm_norm(LAS unsigned char* lds, const bf16_t* A, const bf16_t* Bt, const int K, const float* xin, float* y, bf16_t* X1, bf16_t* H, const float* ga, const float* gb,
                                                const TailStat st1, const TailStat st2, const int wv) {
    int lane_ = lane_id(); asm volatile("" : "+v"(lane_));
    const int lane = lane_, fr = lane & 15, fq = lane >> 4, tid = wv * 64 + lane;
    const int kw = K >> 3, u = blockIdx.x, rc = u & 15, cc = u >> 4;
    LAS float* red = (LAS float*)lds;
    const bf16_t* Ap = A + (size_t)(MP + rc * 64 + (lane >> 2)) * K + wv * kw + 8 * (lane & 3);
    const bf16_t* Bp = Bt + (size_t)(cc * 64 + (lane >> 2)) * K + wv * kw + 8 * (lane & 3);
    const int paddr = ((lane & 15) * 4 + (lane >> 4)) * 4;
    f32x4 acc[4][4];
#pragma unroll
    for (int m = 0; m < 4; ++m)
#pragma unroll
        for (int n = 0; n < 4; ++n) acc[m][n] = (f32x4){0.f, 0.f, 0.f, 0.f};
#pragma unroll 4
    for (int ks = 0; ks < kw; ks += 32) {
        u32x4 ar[4], br[4]; bf16x8 af[4], bfr[4];
#pragma unroll
        for (int m = 0; m < 4; ++m) { ar[m] = *(const u32x4*)(Ap + (size_t)(m * 16) * K + ks); br[m] = *(const u32x4*)(Bp + (size_t)(m * 16) * K + ks); }
#pragma unroll
        for (int m = 0; m < 4; ++m) { af[m] = frag_perm(ar[m], paddr); bfr[m] = frag_perm(br[m], paddr); }
#pragma unroll
        for (int m = 0; m < 4; ++m)
#pragma unroll
            for (int n = 0; n < 4; ++n) acc[m][n] = __builtin_amdgcn_mfma_f32_16x16x32_bf16(bfr[n], af[m], acc[m][n], 0, 0, 0);
    }
#pragma unroll
    for (int m = 0; m < 4; ++m)
#pragma unroll
        for (int n = 0; n < 4; ++n) *(LAS f32x4*)(red + (wv * 64 + 16 * m + fr) * 68 + 16 * n + 4 * fq) = acc[m][n];
    __syncthreads();
    const int r = tid >> 3, c8 = (tid & 7) * 8;
    f32x4 s0 = {0.f, 0.f, 0.f, 0.f}, s1 = {0.f, 0.f, 0.f, 0.f};
#pragma unroll
    for (int w = 0; w < 8; ++w) { s0 += *(const LAS f32x4*)(red + (w * 64 + r) * 68 + c8); s1 += *(const LAS f32x4*)(red + (w * 64 + r) * 68 + c8 + 4); }
    const int row = rc * 64 + r, col = cc * 64 + c8;
    const float rs1 = tail_row_stat(st1, (s0[0] * s0[0] + s0[1] * s0[1]) + (s0[2] * s0[2] + s0[3] * s0[3]) + (s1[0] * s1[0] + s1[1] * s1[1]) + (s1[2] * s1[2] + s1[3] * s1[3]), rc, cc, r, tid);
    const f32x4 ga0 = *(const f32x4*)(ga + col), ga1 = *(const f32x4*)(ga + col + 4);
    float* yp = y + (size_t)(MP + row) * DM + col;
    if (MODE == 1) {
        const u32x4 xw = *(const u32x4*)(X1 + (size_t)(MP + row) * DM + col);
        const f32x4 y0 = {bflo(xw.x), bfhi(xw.x), bflo(xw.y), bfhi(xw.y)}, y1 = {bflo(xw.z), bfhi(xw.z), bflo(xw.w), bfhi(xw.w)};
        *(f32x4*)yp = y0 + s0 * rs1 * ga0; *(f32x4*)(yp + 4) = y1 + s1 * rs1 * ga1;
    } else {
        const float* xp = xin + (size_t)row * DM + col;
        const f32x4 x0 = *(const f32x4*)xp + s0 * rs1 * ga0, x1 = *(const f32x4*)(xp + 4) + s1 * rs1 * ga1;
        { u32x4 xw; xw.x = pk2(x0[0], x0[1]); xw.y = pk2(x0[2], x0[3]); xw.z = pk2(x1[0], x1[1]); xw.w = pk2(x1[2], x1[3]); *(u32x4*)(X1 + (size_t)(MP + row) * DM + col) = xw; }
        const float rs2 = tail_row_stat(st2, (x0[0] * x0[0] + x0[1] * x0[1]) + (x0[2] * x0[2] + x0[3] * x0[3]) + (x1[0] * x1[0] + x1[1] * x1[1]) + (x1[2] * x1[2] + x1[3] * x1[3]), rc, cc, r, tid);
        const f32x4 gb0 = *(const f32x4*)(gb + col), gb1 = *(const f32x4*)(gb + col + 4);
        const f32x4 h0 = x0 * rs2 * gb0, h1 = x1 * rs2 * gb1;
        u32x4 w; w.x = pk2(h0[0], h0[1]); w.y = pk2(h0[2], h0[3]); w.z = pk2(h1[0], h1[1]); w.w = pk2(h1[2], h1[3]);
        *(u32x4*)(H + (size_t)(MP + row) * DM + col) = w;
    }
    __syncthreads();
}
template <class Epi>
__device__ __forceinline__ void small_gemm_a4(LAS unsigned char* lds, const bf16_t* A, const bf16_t* Bt, const int N, const Epi& E, const int wv) {
    constexpr int K = 1024, kw = 128;
    int lane_ = lane_id(); asm volatile("" : "+v"(lane_));
    const int lane = lane_, fr = lane & 15, fq = lane >> 4, tid = wv * 64 + lane;
    const int nunits = 16 * (N >> 6), G = gridDim.x;
    LAS float* red = (LAS float*)lds;
    const int lrow = lane >> 2, lch = 8 * (lane & 3), paddr = ((lane & 15) * 4 + (lane >> 4)) * 4;
    const int rc = blockIdx.x & 15;
    bf16x8 pa[4][4];
    {   const bf16_t* Ap = A + (size_t)(MP + rc * 64 + lrow) * K + wv * kw + lch;
        u32x4 ar[4][4];
#pragma unroll
        for (int ks = 0; ks < 4; ++ks)
#pragma unroll
            for (int m = 0; m < 4; ++m) ar[ks][m] = *(const u32x4*)(Ap + (size_t)(m * 16) * K + ks * 32);
#pragma unroll
        for (int ks = 0; ks < 4; ++ks)
#pragma unroll
            for (int m = 0; m < 4; ++m) pa[ks][m] = frag_perm(ar[ks][m], paddr); }
    u32x4 br[4][4];
    if ((int)blockIdx.x < nunits) { const bf16_t* Bp = Bt + (size_t)((blockIdx.x >> 4) * 64 + lrow) * K + wv * kw + lch;
#pragma unroll
        for (int ks = 0; ks < 4; ++ks)
#pragma unroll
            for (int n = 0; n < 4; ++n) br[ks][n] = *(const u32x4*)(Bp + (size_t)(n * 16) * K + ks * 32); }
    for (int u = blockIdx.x; u < nunits; u += G) {
        const int cc = u >> 4;
        f32x4 acc[4][4];
#pragma unroll
        for (int m = 0; m < 4; ++m)
#pragma unroll
            for (int n = 0; n < 4; ++n) acc[m][n] = (f32x4){0.f, 0.f, 0.f, 0.f};
#pragma unroll
        for (int ks = 0; ks < 4; ++ks) {
            bf16x8 pb[4];
#pragma unroll
            for (int n = 0; n < 4; ++n) pb[n] = frag_perm(br[ks][n], paddr);
#pragma unroll
            for (int m = 0; m < 4; ++m)
#pragma unroll
                for (int n = 0; n < 4; ++n) acc[m][n] = __builtin_amdgcn_mfma_f32_16x16x32_bf16(pb[n], pa[ks][m], acc[m][n], 0, 0, 0);
        }
        { const int un = u + G < nunits ? u + G : u;
          const bf16_t* Bp = Bt + (size_t)((un >> 4) * 64 + lrow) * K + wv * kw + lch;
#pragma unroll
          for (int ks = 0; ks < 4; ++ks)
#pragma unroll
              for (int n = 0; n < 4; ++n) br[ks][n] = *(const u32x4*)(Bp + (size_t)(n * 16) * K + ks * 32); }
#pragma unroll
        for (int m = 0; m < 4; ++m)
#pragma unroll
            for (int n = 0; n < 4; ++n) *(LAS f32x4*)(red + (wv * 64 + 16 * m + fr) * 68 + 16 * n + 4 * fq) = acc[m][n];
        lds_barrier();
        const int r = tid >> 3, c8 = (tid & 7) * 8;
        f32x4 s0 = {0.f, 0.f, 0.f, 0.f}, s1 = {0.f, 0.f, 0.f, 0.f};
#pragma unroll
        for (int w = 0; w < 8; ++w) { s0 += *(const LAS f32x4*)(red + (w * 64 + r) * 68 + c8); s1 += *(const LAS f32x4*)(red + (w * 64 + r) * 68 + c8 + 4); }
        E.store8(MP + rc * 64 + r, cc * 64 + c8, s0, s1);
        lds_barrier();
    }
}
template <class Epi>
__device__ __forceinline__ void small_gemm_k1024(LAS unsigned char* lds, const bf16_t* A, const bf16_t* Bt, const int N, const Epi& E, const int wv) {
    constexpr int K = 1024, kw = 128;
    const int lane = lane_id(), fr = lane & 15, fq = lane >> 4, tid = wv * 64 + lane;
    const int nunits = 16 * (N >> 6), G = gridDim.x;
    LAS float* red = (LAS float*)lds;
    int u = blockIdx.x;
    if (u >= nunits) return;
    u32x4 fa[4][4], fb[4][4];
    const int lrow = lane >> 2, lch = 8 * (lane & 3), paddr = ((lane & 15) * 4 + (lane >> 4)) * 4;
    {   const bf16_t* Ap = A + (size_t)(MP + (u & 15) * 64 + lrow) * K + wv * kw + lch; const bf16_t* Bp = Bt + (size_t)((u >> 4) * 64 + lrow) * K + wv * kw + lch;
#pragma unroll
        for (int ks = 0; ks < 4; ++ks)
#pragma unroll
            for (int m = 0; m < 4; ++m) { fa[ks][m] = *(const u32x4*)(Ap + (size_t)(m * 16) * K + ks * 32); fb[ks][m] = *(const u32x4*)(Bp + (size_t)(m * 16) * K + ks * 32); } }
    for (; u < nunits; u += G) {
        const int rc = u & 15, cc = u >> 4, nu = u + G; const bool has_next = nu < nunits;
        const bf16_t* Ap = A + (size_t)(MP + (nu & 15) * 64 + lrow) * K + wv * kw + lch; const bf16_t* Bp = Bt + (size_t)((nu >> 4) * 64 + lrow) * K + wv * kw + lch;
        f32x4 acc[4][4];
#pragma unroll
        for (int m = 0; m < 4; ++m)
#pragma unroll
            for (int n = 0; n < 4; ++n) acc[m][n] = (f32x4){0.f, 0.f, 0.f, 0.f};
#pragma unroll
        for (int ks = 0; ks < 4; ++ks) {
            bf16x8 pa[4], pb[4];
#pragma unroll
            for (int m = 0; m < 4; ++m) { pa[m] = frag_perm(fa[ks][m], paddr); pb[m] = frag_perm(fb[ks][m], paddr); }
            if (has_next) {
#pragma unroll
                for (int m = 0; m < 4; ++m) { fa[ks][m] = *(const u32x4*)(Ap + (size_t)(m * 16) * K + ks * 32); fb[ks][m] = *(const u32x4*)(Bp + (size_t)(m * 16) * K + ks * 32); }
            }
#pragma unroll
            for (int m = 0; m < 4; ++m)
#pragma unroll
                for (int n = 0; n < 4; ++n) acc[m][n] = __builtin_amdgcn_mfma_f32_16x16x32_bf16(pb[n], pa[m], acc[m][n], 0, 0, 0);
        }
#pragma unroll
        for (int m = 0; m < 4; ++m)
#pragma unroll
            for (int n = 0; n < 4; ++n) *(LAS f32x4*)(red + (wv * 64 + 16 * m + fr) * 68 + 16 * n + 4 * fq) = acc[m][n];
        __syncthreads();
        const int r = tid >> 3, c8 = (tid & 7) * 8;
        f32x4 s0 = {0.f, 0.f, 0.f, 0.f}, s1 = {0.f, 0.f, 0.f, 0.f};
#pragma unroll
        for (int w = 0; w < 8; ++w) { s0 += *(const LAS f32x4*)(red + (w * 64 + r) * 68 + c8); s1 += *(const LAS f32x4*)(red + (w * 64 + r) * 68 + c8 + 4); }
        E.store8(MP + rc * 64 + r, cc * 64 + c8, s0, s1);
        __syncthreads();
    }
}
template <int CTRL> __device__ __forceinline__ float dppf(float old, float src) {
    return __builtin_bit_cast(float, __builtin_amdgcn_update_dpp(__builtin_bit_cast(int, old), __builtin_bit_cast(int, src), CTRL, 0xf, 0xf, false));
}
__device__ __forceinline__ float gelu_tanh(float x) {
    const float u = 1.5957691216057308f * (x + 0.044715f * x * x * x);
    return x * __builtin_amdgcn_rcpf(1.0f + __builtin_amdgcn_exp2f(-u * LOG2E));
}
struct EpiUpFused {
    static constexpr bool PERM = true, AFTER_DRAIN = false;
    bf16_t* A2; float* out; const float* cw; const float* cb; const float* st; float* head; float* tail; LAS float* halo;
    __device__ __forceinline__ void operator()(const f32x4 (&acc)[2][2][4][2], const Unit& u, int wr, int wc, int fr, int fq) const {
        const int pm = u.pm, gt = u.pn; const bool samp = pm >= 64;
        const int colq = wc * 32 + 8 * fq, oc = gt * 128 + colq;
#pragma unroll
        for (int ai = 0; ai < 2; ++ai) {
            const int g = ai * 2 + wr;
            if (fr >= 14) {
                const int r = fr - 14;
                float* cdst = nullptr;
                if (samp) cdst = out + O_CV_S + ((size_t)((pm - 64) * 4 + g) * 2 + r) * NUP;
                else if (g == 3) cdst = ((pm & 7) == 7) ? out + O_CV_P + ((size_t)(pm >> 3) * 2 + r) * NUP : tail + ((size_t)pm * 2 + r) * NUP;
#pragma unroll
                for (int bj = 0; bj < 2; ++bj) {
                    const f32x4 v0 = acc[ai][bj][3][0], v1 = acc[ai][bj][3][1];
                    LAS float* hp = halo + ((g * 2 + r) * 2 + bj) * 128 + colq;
                    *(LAS f32x4*)hp = v0; *(LAS f32x4*)(hp + 4) = v1;
                    if (cdst) { *(f32x4*)(cdst + bj * DFF + oc) = v0; *(f32x4*)(cdst + bj * DFF + oc + 4) = v1; }
                }
            }
        }
        const bool defer = !samp && (pm & 7) != 0;
        if (defer && wr == 0 && fr < 2) {
            float* hd = head + ((size_t)pm * 2 + fr) * NUP;
#pragma unroll
            for (int bj = 0; bj < 2; ++bj) { *(f32x4*)(hd + bj * DFF + oc) = acc[0][bj][0][0]; *(f32x4*)(hd + bj * DFF + oc + 4) = acc[0][bj][0][1]; }
        }
        f32x4 wg[3], wq[3], bg, bq;
#pragma unroll
        for (int k = 0; k < 3; ++k) { wg[k] = *(const f32x4*)(cw + (size_t)k * NUP + oc); wq[k] = *(const f32x4*)(cw + (size_t)k * NUP + DFF + oc); }
        bg = *(const f32x4*)(cb + oc); bq = *(const f32x4*)(cb + DFF + oc);
        asm volatile("s_waitcnt lgkmcnt(0)" ::: "memory"); __builtin_amdgcn_s_barrier(); asm volatile("" ::: "memory");
        u32x2 keep[2][4];
#pragma unroll
        for (int n = 0; n < 2; ++n) {
            if (n == 1) {
#pragma unroll
                for (int k = 0; k < 3; ++k) { wg[k] = *(const f32x4*)(cw + (size_t)k * NUP + oc + 4); wq[k] = *(const f32x4*)(cw + (size_t)k * NUP + DFF + oc + 4); }
                bg = *(const f32x4*)(cb + oc + 4); bq = *(const f32x4*)(cb + DFF + oc + 4);
            }
#pragma unroll
            for (int ai = 0; ai < 2; ++ai) {
                const int g = ai * 2 + wr;
                f32x4 xm1[2];
                xm1[0] = (f32x4){0.f, 0.f, 0.f, 0.f}; xm1[1] = (f32x4){0.f, 0.f, 0.f, 0.f};
                if (fr >= 14) {
                    const int r = fr - 14;
                    if (samp) { const float* sp = st + ((size_t)((pm - 64) * 4 + g) * 2 + r) * NUP; xm1[0] = *(const f32x4*)(sp + oc + 4 * n); xm1[1] = *(const f32x4*)(sp + DFF + oc + 4 * n); }
                    else if (g > 0) { const LAS float* hp = halo + (((g - 1) * 2 + r) * 2) * 128 + colq + 4 * n; xm1[0] = *(const LAS f32x4*)hp; xm1[1] = *(const LAS f32x4*)(hp + 128); }
                }
#pragma unroll
                for (int m = 0; m < 4; ++m) {
                    const size_t row = (size_t)pm * 256 + g * 64 + m * 16 + fr;
                    float res[4];
#pragma unroll
                    for (int e = 0; e < 4; ++e) {
                        const float xg = acc[ai][0][m][n][e], xgp = (m == 0) ? xm1[0][e] : acc[ai][0][m > 0 ? m - 1 : 0][n][e];
                        const float xv = acc[ai][1][m][n][e], xvp = (m == 0) ? xm1[1][e] : acc[ai][1][m > 0 ? m - 1 : 0][n][e];
                        const float g1 = dppf<0x111>(dppf<0x121>(0.f, xgp), xg), g2 = dppf<0x112>(dppf<0x122>(0.f, xgp), xg);
                        const float v1 = dppf<0x111>(dppf<0x121>(0.f, xvp), xv), v2 = dppf<0x112>(dppf<0x122>(0.f, xvp), xv);
                        const float yg = bg[e] + wg[0][e] * g2 + wg[1][e] * g1 + wg[2][e] * xg;
                        const float yv = bq[e] + wq[0][e] * v2 + wq[1][e] * v1 + wq[2][e] * xv;
                        res[e] = gelu_tanh(yg) * yv;
                    }
                    u32x2 w; w.x = pk2(res[0], res[1]); w.y = pk2(res[2], res[3]);
                    if (n == 0) keep[ai][m] = w;
                    else if (!(defer && g == 0 && m == 0 && fr < 2)) { u32x4 ww; ww.x = keep[ai][m].x; ww.y = keep[ai][m].y; ww.z = w.x; ww.w = w.y; *(u32x4*)(A2 + row * DFF + oc) = ww; }
                    asm volatile("" ::: "memory");
                }
            }
        }
    }
};
__device__ __forceinline__ void ffn_fixup(const Args& a, const int pm, const int tid) {
    if (pm >= 64 || (pm & 7) == 0) return;
    const float* head = (const float*)(a.ws + WS_HEAD) + (size_t)pm * 2 * NUP; const float* tail = (const float*)(a.ws + WS_TAIL) + (size_t)(pm - 1) * 2 * NUP;
    const float* cw = a.in[I_CW]; const float* cb = a.in[I_CB]; bf16_t* A2 = (bf16_t*)(a.ws + WS_A2);
    for (int it = tid; it < 704; it += 512) {
        const int r = it >= 352 ? 1 : 0, oc = (it - r * 352) * 8;
        const float* x0 = r == 0 ? tail : tail + NUP; const float* x1 = r == 0 ? tail + NUP : head; const float* x2 = r == 0 ? head : head + NUP;
        float y[2][8];
#pragma unroll
        for (int hh = 0; hh < 2; ++hh) { const int c = hh * DFF + oc;
#pragma unroll
            for (int q = 0; q < 2; ++q) {
                const f32x4 bb = *(const f32x4*)(cb + c + 4 * q), w0 = *(const f32x4*)(cw + c + 4 * q), w1 = *(const f32x4*)(cw + NUP + c + 4 * q), w2 = *(const f32x4*)(cw + 2 * NUP + c + 4 * q);
                const f32x4 a0 = *(const f32x4*)(x0 + c + 4 * q), a1 = *(const f32x4*)(x1 + c + 4 * q), a2 = *(const f32x4*)(x2 + c + 4 * q);
#pragma unroll
                for (int e = 0; e < 4; ++e) y[hh][4 * q + e] = bb[e] + w0[e] * a0[e] + w1[e] * a1[e] + w2[e] * a2[e];
            } }
        float res[8];
#pragma unroll
        for (int e = 0; e < 8; ++e) res[e] = gelu_tanh(y[0][e]) * y[1][e];
        u32x4 w; w.x = pk2(res[0], res[1]); w.y = pk2(res[2], res[3]); w.z = pk2(res[4], res[5]); w.w = pk2(res[6], res[7]);
        *(u32x4*)(A2 + ((size_t)pm * 256 + r) * DFF + oc) = w;
    }
}

struct RowStat {
    float* xbuf; unsigned* cnt;
    __device__ __forceinline__ void run(const f32x4 (&v)[2][2][4][2], const Unit& u, int wr, int wc, int fr, int fq, LAS unsigned char* lds, int wid, int lane) const {
        LAS float* P = (LAS float*)lds; LAS float* S = (LAS float*)(lds + 4096);
#pragma unroll
        for (int ai = 0; ai < 2; ++ai)
#pragma unroll
            for (int m = 0; m < 4; ++m) { float s = 0.f;
#pragma unroll
                for (int bj = 0; bj < 2; ++bj)
#pragma unroll
                    for (int n = 0; n < 2; ++n) { const f32x4 x = v[ai][bj][m][n]; s += (x[0] * x[0] + x[1] * x[1]) + (x[2] * x[2] + x[3] * x[3]); }
                s += __shfl_xor(s, 16); s += __shfl_xor(s, 32);
                if (fq == 0) P[(ai * 128 + wr * 64 + m * 16 + fr) * 4 + wc] = s; }
        asm volatile("s_waitcnt lgkmcnt(0)" ::: "memory"); __builtin_amdgcn_s_barrier(); asm volatile("" ::: "memory");
        const int tid = wid * 64 + lane;
        if (tid < 256) { const f32x4 p = *(const LAS f32x4*)(P + tid * 4);
            __hip_atomic_store(xbuf + ((size_t)u.pm * 256 + tid) * 4 + u.pn, (p[0] + p[1]) + (p[2] + p[3]), __ATOMIC_RELAXED, __HIP_MEMORY_SCOPE_AGENT); }
        asm volatile("s_waitcnt vmcnt(0)" ::: "memory"); __builtin_amdgcn_s_barrier(); asm volatile("" ::: "memory");
        if (tid == 0) {
            __hip_atomic_fetch_add(cnt + 64 * u.pm, 1u, __ATOMIC_RELAXED, __HIP_MEMORY_SCOPE_AGENT);
            while (__hip_atomic_load(cnt + 64 * u.pm, __ATOMIC_RELAXED, __HIP_MEMORY_SCOPE_AGENT) < 4u) __builtin_amdgcn_s_sleep(1);
            __builtin_amdgcn_fence(__ATOMIC_ACQUIRE, "agent");
        }
        asm volatile("s_waitcnt vmcnt(0) lgkmcnt(0)" ::: "memory"); __builtin_amdgcn_s_barrier(); asm volatile("" ::: "memory");
        if (tid < 256) { const float* slot = xbuf + ((size_t)u.pm * 256 + tid) * 4; float q = 0.f;
#pragma unroll
            for (int t = 0; t < 4; ++t) q += __hip_atomic_load(slot + t, __ATOMIC_RELAXED, __HIP_MEMORY_SCOPE_AGENT);
            S[tid] = 1.0f / sqrtf(q * (1.0f / DM) + EPS); }
        asm volatile("s_waitcnt vmcnt(0) lgkmcnt(0)" ::: "memory"); __builtin_amdgcn_s_barrier(); asm volatile("" ::: "memory");
    }
};
struct EpiOutNorm {
    static constexpr bool PERM = true, AFTER_DRAIN = true;
    const float* x; bf16_t* X1; bf16_t* H; const float* g2; const float* g3; RowStat st1, st2;
    __device__ __forceinline__ void fused(f32x4 (&acc)[2][2][4][2], const Unit& u, int wr, int wc, int fr, int fq, LAS unsigned char* lds, int wid, int lane) const {
        st1.run(acc, u, wr, wc, fr, fq, lds, wid, lane);
        const LAS float* S = (const LAS float*)(lds + 4096);
        const int c0 = u.pn * 256 + wc * 32 + 8 * fq;
#pragma unroll
        for (int ai = 0; ai < 2; ++ai)
#pragma unroll
            for (int m = 0; m < 4; ++m) { const int rl = ai * 128 + wr * 64 + m * 16 + fr; const size_t row = (size_t)u.pm * 256 + rl; const float rs = S[rl];
#pragma unroll
                for (int bj = 0; bj < 2; ++bj) { const int c = c0 + bj * 128;
                    const f32x4 xa = *(const f32x4*)(x + row * DM + c) + acc[ai][bj][m][0] * rs * *(const f32x4*)(g2 + c);
                    const f32x4 xb = *(const f32x4*)(x + row * DM + c + 4) + acc[ai][bj][m][1] * rs * *(const f32x4*)(g2 + c + 4);
                    u32x4 xw; xw.x = pk2(xa[0], xa[1]); xw.y = pk2(xa[2], xa[3]); xw.z = pk2(xb[0], xb[1]); xw.w = pk2(xb[2], xb[3]);
                    *(u32x4*)(X1 + row * DM + c) = xw; acc[ai][bj][m][0] = xa; acc[ai][bj][m][1] = xb; }
                asm volatile("" : "+v"(acc[ai][0][m][0]), "+v"(acc[ai][0][m][1]), "+v"(acc[ai][1][m][0]), "+v"(acc[ai][1][m][1]));
                asm volatile("" ::: "memory"); }
        st2.run(acc, u, wr, wc, fr, fq, lds, wid, lane);
#pragma unroll
        for (int ai = 0; ai < 2; ++ai)
#pragma unroll
            for (int m = 0; m < 4; ++m) { const int rl = ai * 128 + wr * 64 + m * 16 + fr; const size_t row = (size_t)u.pm * 256 + rl; const float rs = S[rl];
#pragma unroll
                for (int bj = 0; bj < 2; ++bj) { const int c = c0 + bj * 128;
                    const f32x4 ga = *(const f32x4*)(g3 + c), gb = *(const f32x4*)(g3 + c + 4); const f32x4 v0 = acc[ai][bj][m][0] * rs * ga, v1 = acc[ai][bj][m][1] * rs * gb;
                    u32x4 w; w.x = pk2(v0[0], v0[1]); w.y = pk2(v0[2], v0[3]); w.z = pk2(v1[0], v1[1]); w.w = pk2(v1[2], v1[3]);
                    *(u32x4*)(H + row * DM + c) = w; } }
    }
};
struct EpiDownNorm {
    static constexpr bool PERM = true, AFTER_DRAIN = true;
    const bf16_t* X1; float* y; const float* g4; RowStat st;
    __device__ __forceinline__ void fused(f32x4 (&acc)[2][2][4][2], const Unit& u, int wr, int wc, int fr, int fq, LAS unsigned char* lds, int wid, int lane) const {
        st.run(acc, u, wr, wc, fr, fq, lds, wid, lane);
        const LAS float* S = (const LAS float*)(lds + 4096);
        const int c0 = u.pn * 256 + wc * 32 + 8 * fq;
#pragma unroll
        for (int ai = 0; ai < 2; ++ai)
#pragma unroll
            for (int m = 0; m < 4; ++m) { const int rl = ai * 128 + wr * 64 + m * 16 + fr; const size_t row = (size_t)u.pm * 256 + rl; const float rs = S[rl];
#pragma unroll
                for (int bj = 0; bj < 2; ++bj) { const int c = c0 + bj * 128;
                    const u32x4 xw = *(const u32x4*)(X1 + row * DM + c);
                    const f32x4 xa = {bflo(xw.x), bfhi(xw.x), bflo(xw.y), bfhi(xw.y)}, xb = {bflo(xw.z), bfhi(xw.z), bflo(xw.w), bfhi(xw.w)};
                    *(f32x4*)(y + row * DM + c) = xa + acc[ai][bj][m][0] * rs * *(const f32x4*)(g4 + c);
                    *(f32x4*)(y + row * DM + c + 4) = xb + acc[ai][bj][m][1] * rs * *(const f32x4*)(g4 + c + 4); }
                asm volatile("" ::: "memory"); }
    }
};

__device__ __forceinline__ void p0_transpose_item(const float* W, int N, int K, bf16_t* WT, int k0, int src_n0, int dst_n0, LAS float* scr, int lane) {
    float tv[32];
#pragma unroll
    for (int i = 0; i < 32; ++i) tv[i] = W[(size_t)(k0 + 2 * i + (lane >> 5)) * N + src_n0 + (lane & 31)];
#pragma unroll
    for (int i = 0; i < 32; ++i) scr[(2 * i + (lane >> 5)) * 33 + (lane & 31)] = tv[i];
    asm volatile("s_waitcnt lgkmcnt(0)" ::: "memory");
    const int c = lane & 7;
#pragma unroll
    for (int j = 0; j < 4; ++j) { const int n = (lane >> 3) + 8 * j; const LAS float* s = scr + (8 * c) * 33 + n;
        u32x4 o; o.x = pk2(s[0 * 33], s[1 * 33]); o.y = pk2(s[2 * 33], s[3 * 33]); o.z = pk2(s[4 * 33], s[5 * 33]); o.w = pk2(s[6 * 33], s[7 * 33]);
        *(u32x4*)(WT + (size_t)(dst_n0 + n) * K + k0 + 8 * c) = o; }
    asm volatile("s_waitcnt lgkmcnt(0)" ::: "memory");
}

constexpr int TI_IN = 16 * 160, TI_PA = 8 * 32, TI_PB = 8 * 32, TI_OUT = 16 * 32, TI_UP = 16 * 176, TI_DN = 44 * 32;
constexpr int TI_ALL = TI_IN + TI_PA + TI_PB + TI_OUT + TI_UP + TI_DN;
__device__ __forceinline__ void transpose_item(const Args& a, const int it, LAS float* scr, const int lane) {
    unsigned char* ws = a.ws; int r = it;
    if (r < TI_IN) { const int kb = r / 160, nb = r % 160, d0 = nb * 32; p0_transpose_item(a.in[I_WIN], 5128, DM, (bf16_t*)(ws + WS_WIN), kb * 64, d0 + (d0 >= 3072 ? 8 : 0), d0, scr, lane); return; } r -= TI_IN;
    if (r < TI_PA) { const int kb = r / 32, nb = r % 32; p0_transpose_item(a.in[I_WPA], DM, HW, (bf16_t*)(ws + WS_WPA), kb * 64, nb * 32, nb * 32, scr, lane); return; } r -= TI_PA;
    if (r < TI_PB) { const int kb = r / 32, nb = r % 32; p0_transpose_item(a.in[I_WPB], DM, HW, (bf16_t*)(ws + WS_WPB), kb * 64, nb * 32, nb * 32, scr, lane); return; } r -= TI_PB;
    if (r < TI_OUT) { const int kb = r / 32, nb = r % 32; p0_transpose_item(a.in[I_WOUT], DM, DM, (bf16_t*)(ws + WS_WOUT), kb * 64, nb * 32, nb * 32, scr, lane); return; } r -= TI_OUT;
    if (r < TI_UP) { const int kb = r / 176, nb = r % 176, d0 = nb * 32, tile = d0 >> 8, w = d0 & 255; const int s0 = (w < 128) ? tile * 128 + w : DFF + tile * 128 + (w - 128);
        p0_transpose_item(a.in[I_WUP], NUP, DM, (bf16_t*)(ws + WS_WUP), kb * 64, s0, d0, scr, lane); return; } r -= TI_UP;
    { const int kb = r / 32, nb = r % 32; p0_transpose_item(a.in[I_WDN], DM, DFF, (bf16_t*)(ws + WS_WDN), kb * 64, nb * 32, nb * 32, scr, lane); }
}
__device__ __forceinline__ void phase_prologue(const Args& a, LAS unsigned char* lds, const int wv) {
    const int lane = lane_id(), wave = wv, tid = wv * 64 + lane;
    const int G = gridDim.x, gw = blockIdx.x * 8 + wave, NGW = G * 8;
    unsigned char* ws = a.ws;
    LAS float* scr = (LAS float*)(lds + wave * 8448);
    LAS float* wfg = (LAS float*)(lds + 69632);
    {
        const float* win = a.in[I_WIN]; const float* g1 = a.in[I_G1];
        for (int k = tid; k < DM; k += 512) {
            const f32x4 w0 = *(const f32x4*)(win + (size_t)k * 5128 + 3072), w1 = *(const f32x4*)(win + (size_t)k * 5128 + 3076); const float g = g1[k];
            wfg[0 * DM + k] = w0[0] * g; wfg[1 * DM + k] = w0[1] * g; wfg[2 * DM + k] = w0[2] * g; wfg[3 * DM + k] = w0[3] * g;
            wfg[4 * DM + k] = w1[0] * g; wfg[5 * DM + k] = w1[1] * g; wfg[6 * DM + k] = w1[2] * g; wfg[7 * DM + k] = w1[3] * g;
        }
    }
    __syncthreads();
    for (int it = gw; it < TI_IN; it += NGW) transpose_item(a, it, scr, lane);
    const float* g1 = a.in[I_G1]; const float* bfp = a.in[I_BF];
    f32x4 gv[4];
#pragma unroll
    for (int j = 0; j < 4; ++j) gv[j] = *(const f32x4*)(g1 + 4 * lane + 256 * j);
    bf16_t* H = (bf16_t*)(ws + WS_H);
    constexpr int RB = 4;
    for (int mb = (NGW - 1 - gw) * RB; mb < MTOK; mb += NGW * RB) {
        f32x4 v[RB][4]; float ss[RB], z[RB][8];
#pragma unroll
        for (int i = 0; i < RB; ++i) { const float* xr = xrow_ptr(a, mb + i);
#pragma unroll
            for (int j = 0; j < 4; ++j) v[i][j] = *(const f32x4*)(xr + 4 * lane + 256 * j); }
#pragma unroll
        for (int i = 0; i < RB; ++i) { ss[i] = 0.f;
#pragma unroll
            for (int j = 0; j < 4; ++j) ss[i] += (v[i][j][0] * v[i][j][0] + v[i][j][1] * v[i][j][1]) + (v[i][j][2] * v[i][j][2] + v[i][j][3] * v[i][j][3]); }
#pragma unroll
        for (int q = 0; q < 8; ++q) {
            f32x4 w[4];
#pragma unroll
            for (int j = 0; j < 4; ++j) w[j] = *(const LAS f32x4*)(wfg + q * DM + 4 * lane + 256 * j);
#pragma unroll
            for (int i = 0; i < RB; ++i) { float s = 0.f;
#pragma unroll
                for (int j = 0; j < 4; ++j) s += (v[i][j][0] * w[j][0] + v[i][j][1] * w[j][1]) + (v[i][j][2] * w[j][2] + v[i][j][3] * w[j][3]);
                z[i][q] = s; }
        }
#pragma unroll
        for (int i = 0; i < RB; ++i) {
            const int m = mb + i;
            const float sst = wave_sum(ss[i]);
#pragma unroll
            for (int q = 0; q < 8; ++q) z[i][q] = wave_sum(z[i][q]);
            const float rs = 1.0f / sqrtf(sst * (1.0f / DM) + EPS);
#pragma unroll
            for (int j = 0; j < 4; ++j) {
                u32x2 o; o.x = pk2(v[i][j][0] * rs * gv[j][0], v[i][j][1] * rs * gv[j][1]); o.y = pk2(v[i][j][2] * rs * gv[j][2], v[i][j][3] * rs * gv[j][3]);
                *(u32x2*)(H + (size_t)m * DM + 4 * lane + 256 * j) = o;
            }
            float zz = z[i][0];
#pragma unroll
            for (int q = 1; q < 8; ++q) zz = (lane == q) ? z[i][q] : zz;
            if (lane < 8) {
                const float t = zz * rs + bfp[lane];
                const float lf = fminf(t, 0.f) - log1pf(expf(-fabsf(t)));
                float* dst = m < MP ? a.out + O_LF_P + (size_t)m * 8 : a.out + O_LF_S + (size_t)(m - MP) * 8;
                dst[lane] = lf;
            }
        }
    }
}

__device__ __forceinline__ void phase_rows1(const Args& a, const int wv) {
    const int lane = lane_id(), wave = wv; const int gw = blockIdx.x * 8 + wave, NGW = gridDim.x * 8;
    const bf16_t* T = (const bf16_t*)(a.ws + WS_T); bf16_t* H = (bf16_t*)(a.ws + WS_H);
    f32x4 g2[4], g3[4];
#pragma unroll
    for (int j = 0; j < 4; ++j) { g2[j] = *(const f32x4*)(a.in[I_G2] + 4 * lane + 256 * j); g3[j] = *(const f32x4*)(a.in[I_G3] + 4 * lane + 256 * j); }
    constexpr int RB = 2;
    for (int mb = MP + gw * RB; mb < MTOK; mb += NGW * RB) {
        f32x4 t[RB][4], x[RB][4];
#pragma unroll
        for (int i = 0; i < RB; ++i) { const float* xr = xrow_ptr(a, mb + i); const bf16_t* tr = T + (size_t)(mb + i) * DM;
#pragma unroll
            for (int j = 0; j < 4; ++j) { const u32x2 tw = *(const u32x2*)(tr + 4 * lane + 256 * j); t[i][j] = (f32x4){bflo(tw.x), bfhi(tw.x), bflo(tw.y), bfhi(tw.y)}; x[i][j] = *(const f32x4*)(xr + 4 * lane + 256 * j); } }
#pragma unroll
        for (int i = 0; i < RB; ++i) {
            const int m = mb + i; float ss = 0.f;
#pragma unroll
            for (int j = 0; j < 4; ++j) ss += (t[i][j][0] * t[i][j][0] + t[i][j][1] * t[i][j][1]) + (t[i][j][2] * t[i][j][2] + t[i][j][3] * t[i][j][3]);
            const float rs = 1.0f / sqrtf(wave_sum(ss) * (1.0f / DM) + EPS);
            float s2 = 0.f;
#pragma unroll
            for (int j = 0; j < 4; ++j) { x[i][j] = x[i][j] + t[i][j] * rs * g2[j]; s2 += (x[i][j][0] * x[i][j][0] + x[i][j][1] * x[i][j][1]) + (x[i][j][2] * x[i][j][2] + x[i][j][3] * x[i][j][3]);
                *(f32x4*)(a.out + O_Y + (size_t)m * DM + 4 * lane + 256 * j) = x[i][j]; }
            const float r2 = 1.0f / sqrtf(wave_sum(s2) * (1.0f / DM) + EPS);
#pragma unroll
            for (int j = 0; j < 4; ++j) { u32x2 o; o.x = pk2(x[i][j][0] * r2 * g3[j][0], x[i][j][1] * r2 * g3[j][1]); o.y = pk2(x[i][j][2] * r2 * g3[j][2], x[i][j][3] * r2 * g3[j][3]);
                *(u32x2*)(H + (size_t)m * DM + 4 * lane + 256 * j) = o; }
        }
    }
}
__device__ __forceinline__ void phase_rows2(const Args& a, const int wv) {
    const int lane = lane_id(), wave = wv; const int gw = blockIdx.x * 8 + wave, NGW = gridDim.x * 8;
    const bf16_t* T = (const bf16_t*)(a.ws + WS_T);
    f32x4 g4[4];
#pragma unroll
    for (int j = 0; j < 4; ++j) g4[j] = *(const f32x4*)(a.in[I_G4] + 4 * lane + 256 * j);
    constexpr int RB = 2;
    for (int mb = MP + gw * RB; mb < MTOK; mb += NGW * RB) {
        f32x4 t[RB][4], x[RB][4];
#pragma unroll
        for (int i = 0; i < RB; ++i) { const bf16_t* tr = T + (size_t)(mb + i) * DM; const float* yr = a.out + O_Y + (size_t)(mb + i) * DM;
#pragma unroll
            for (int j = 0; j < 4; ++j) { const u32x2 tw = *(const u32x2*)(tr + 4 * lane + 256 * j); t[i][j] = (f32x4){bflo(tw.x), bfhi(tw.x), bflo(tw.y), bfhi(tw.y)}; x[i][j] = *(const f32x4*)(yr + 4 * lane + 256 * j); } }
#pragma unroll
        for (int i = 0; i < RB; ++i) {
            float* yr = a.out + O_Y + (size_t)(mb + i) * DM; float ss = 0.f;
#pragma unroll
            for (int j = 0; j < 4; ++j) ss += (t[i][j][0] * t[i][j][0] + t[i][j][1] * t[i][j][1]) + (t[i][j][2] * t[i][j][2] + t[i][j][3] * t[i][j][3]);
            const float rs = 1.0f / sqrtf(wave_sum(ss) * (1.0f / DM) + EPS);
#pragma unroll
            for (int j = 0; j < 4; ++j) *(f32x4*)(yr + 4 * lane + 256 * j) = x[i][j] + t[i][j] * rs * g4[j];
        }
    }
}


constexpr int AL_K = 0, AL_KB = 64 * 144, AL_V = 2 * AL_KB, AL_VB = 8192, AL_WS = AL_V + 2 * AL_VB, AL_CS = AL_WS + 8 * 256, AL_TAB = AL_CS + 2112 * 4, AL_MISC = AL_TAB + 260 * 4;
constexpr int N_ATT_UNITS = 1280, N_TR_UNITS = (TI_ALL - TI_IN + 7) / 8;
__device__ __forceinline__ int crow(int r, int hi) { return (r & 3) + 8 * (r >> 2) + 4 * hi; }
__device__ __forceinline__ float halfswap_max(float m) { auto rr = __builtin_amdgcn_permlane32_swap(__float_as_uint(m), __float_as_uint(m), false, false); return fmaxf(__uint_as_float(rr[0]), __uint_as_float(rr[1])); }
__device__ __forceinline__ float halfswap_sum(float m) { auto rr = __builtin_amdgcn_permlane32_swap(__float_as_uint(m), __float_as_uint(m), false, false); return __uint_as_float(rr[0]) + __uint_as_float(rr[1]); }

__device__ __forceinline__ void pv_step(f32x16* o, f32x16& lacc, unsigned vb, bf16x8 pa0, bf16x8 pa1, bf16x8 pa2, bf16x8 pa3) {
#pragma unroll
    for (int d0 = 0; d0 < 2; ++d0) { s16x4 lo[4], hh[4];
#pragma unroll
        for (int ks = 0; ks < 4; ++ks) {
            asm volatile("ds_read_b64_tr_b16 %0,%1 offset:%c2" : "=&v"(lo[ks]) : "v"(vb), "i"(d0 * 4096 + ks * 1024) : "memory");
            asm volatile("ds_read_b64_tr_b16 %0,%1 offset:%c2" : "=&v"(hh[ks]) : "v"(vb), "i"(d0 * 4096 + ks * 1024 + 512) : "memory"); }
        if (d0 == 0) {
            __builtin_amdgcn_sched_barrier(0);
            const u32x4 one4 = {0x3F803F80u, 0x3F803F80u, 0x3F803F80u, 0x3F803F80u}; const bf16x8 ones = __builtin_bit_cast(bf16x8, one4);
            lacc = __builtin_amdgcn_mfma_f32_32x32x16_bf16(pa0, ones, lacc, 0, 0, 0); lacc = __builtin_amdgcn_mfma_f32_32x32x16_bf16(pa1, ones, lacc, 0, 0, 0);
            lacc = __builtin_amdgcn_mfma_f32_32x32x16_bf16(pa2, ones, lacc, 0, 0, 0); lacc = __builtin_amdgcn_mfma_f32_32x32x16_bf16(pa3, ones, lacc, 0, 0, 0);
            __builtin_amdgcn_sched_barrier(0);
        }
        asm volatile("s_waitcnt lgkmcnt(0)" ::: "memory"); __builtin_amdgcn_sched_barrier(0);
#define PK_(k) (bf16x8){lo[k][0], lo[k][1], lo[k][2], lo[k][3], hh[k][0], hh[k][1], hh[k][2], hh[k][3]}
        o[d0] = __builtin_amdgcn_mfma_f32_32x32x16_bf16(pa0, PK_(0), o[d0], 0, 0, 0);
        o[d0] = __builtin_amdgcn_mfma_f32_32x32x16_bf16(pa1, PK_(1), o[d0], 0, 0, 0);
        o[d0] = __builtin_amdgcn_mfma_f32_32x32x16_bf16(pa2, PK_(2), o[d0], 0, 0, 0);
        o[d0] = __builtin_amdgcn_mfma_f32_32x32x16_bf16(pa3, PK_(3), o[d0], 0, 0, 0);
#undef PK_
    }
}

template <int KIND>
__device__ __forceinline__ void attn_unit(const Args& a, LAS unsigned char* lds, int b, int h, int blk, int samp, const int wv, unsigned* qctr, LAS unsigned* qnext) {
    int lane_ = lane_id(); asm volatile("" : "+v"(lane_));
    const int lane = lane_, r32 = lane & 31, hi = lane >> 5, wid = wv, tid = wv * 64 + lane;
    const bf16_t* QKV = (const bf16_t*)(a.ws + WS_QKV);
    const bf16_t* Qb = QKV + (size_t)(KIND == 0 ? 0 : 3) * QKV_STRIDE; const bf16_t* Kb = Qb + QKV_STRIDE; const bf16_t* Vb = Kb + QKV_STRIDE;
    bf16_t* Ob = (bf16_t*)(a.ws + (KIND == 0 ? WS_OA : WS_OB));
    const float* Kc = a.in[KIND == 0 ? I_CKA : I_CKB]; const float* Vc = a.in[KIND == 0 ? I_CVA : I_CVB];
    constexpr int CT = (KIND == 0) ? 8 : 32;
    int t_lo, t_hi, w_lo, w_hi, qrow, cch = 0, qpos = 0;
    if (KIND == 0) {
        if (!samp) { const int c0 = 4 * blk; cch = c0 + (wid >> 1); t_lo = c0 - 8 < 0 ? 0 : c0 - 8; t_hi = c0 + 3; w_lo = cch - 8 < 0 ? 0 : cch - 8; w_hi = cch; qrow = b * SEQ + 64 * cch + 32 * (wid & 1); qpos = 32 * (wid & 1) + r32; }
        else { cch = 8; t_lo = 0; t_hi = 8; w_lo = 0; w_hi = wid < 2 ? 8 : -1; qrow = MP + b * DSEQ + 32 * (wid & 1); qpos = 32 * (wid & 1) + r32; }
    } else {
        if (!samp) { t_lo = 0; t_hi = 4 * blk + 3; w_lo = 0; w_hi = 4 * blk + (wid >> 1); qrow = b * SEQ + 256 * blk + 32 * wid; qpos = 256 * blk + 32 * wid + r32; }
        else { t_lo = 0; t_hi = 32; w_lo = 0; w_hi = wid < 2 ? 32 : -1; qrow = MP + b * DSEQ + 32 * (wid & 1); qpos = PAST + 32 * (wid & 1) + r32; }
    }
    const bool active = w_hi >= w_lo;
    LAS float* wsf = (LAS float*)(lds + AL_WS) + wid * 64;
    LAS float* cs = (LAS float*)(lds + AL_CS);
    LAS float* tab = (LAS float*)(lds + AL_TAB);
    LAS float* misc = (LAS float*)(lds + AL_MISC);
    lds_barrier();
    bf16x8 qr[4];
#pragma unroll
    for (int dk = 0; dk < 4; ++dk) qr[dk] = active ? *(const bf16x8*)(Qb + (size_t)(qrow + r32) * HW + h * 64 + dk * 16 + hi * 8) : (bf16x8){0, 0, 0, 0, 0, 0, 0, 0};
    const int srow = tid >> 3, sch = tid & 7;
    const unsigned kst = AL_K + srow * 144 + sch * 16, vst = AL_V + (sch >> 2) * 4096 + srow * 64 + (sch & 3) * 16;
    struct Stage { u32x4 k, v; f32x4 kf0, kf1, vf0, vf1; bool f; };
    Stage sA, sB; sA.f = false; sB.f = false;
    auto issue = [&](int tq, Stage& s) {
        const int t = tq > t_hi ? t_hi : tq;
        if (samp && t < CT) { const unsigned off = ((unsigned)(b * (64 * CT) + 64 * t + srow) * 8u + h) * 64u + sch * 8;
            s.kf0 = *(const f32x4*)(Kc + off); s.kf1 = *(const f32x4*)(Kc + off + 4); s.vf0 = *(const f32x4*)(Vc + off); s.vf1 = *(const f32x4*)(Vc + off + 4); s.f = true; }
        else { const unsigned row = samp ? (unsigned)(MP + b * DSEQ + srow) : (unsigned)(b * SEQ + 64 * t + srow); const unsigned off = row * HW + h * 64 + sch * 8;
            s.k = *(const u32x4*)(Kb + off); s.v = *(const u32x4*)(Vb + off); s.f = false; }
    };
    auto commit = [&](int buf, int t, Stage& s) {
        u32x4 kreg = s.k, vreg = s.v;
        if (s.f) { kreg.x = pk2(s.kf0[0], s.kf0[1]); kreg.y = pk2(s.kf0[2], s.kf0[3]); kreg.z = pk2(s.kf1[0], s.kf1[1]); kreg.w = pk2(s.kf1[2], s.kf1[3]);
                   vreg.x = pk2(s.vf0[0], s.vf0[1]); vreg.y = pk2(s.vf0[2], s.vf0[3]); vreg.z = pk2(s.vf1[0], s.vf1[1]); vreg.w = pk2(s.vf1[2], s.vf1[3]); }
        *(LAS u32x4*)(lds + kst + buf * AL_KB) = kreg; *(LAS u32x4*)(lds + vst + buf * AL_VB) = vreg;
        float* kd = nullptr; float* vd = nullptr;
        if (samp) { if (t == CT) { const unsigned o = (unsigned)(b * DSEQ + srow) * HW + h * 64 + sch * 8; kd = a.out + (KIND == 0 ? O_KA_S : O_KB_S) + o; vd = a.out + (KIND == 0 ? O_VA_S : O_VB_S) + o; } }
        else if (KIND == 1) { if (t >= 4 * blk) { const unsigned o = (unsigned)(b * SEQ + 64 * t + srow) * HW + h * 64 + sch * 8; kd = a.out + O_KB_P + o; vd = a.out + O_VB_P + o; } }
        else { if (t >= 4 * blk && t >= 24) { const unsigned o = (unsigned)(b * ALEN + 64 * (t - 24) + srow) * HW + h * 64 + sch * 8; kd = a.out + O_KA_P + o; vd = a.out + O_VA_P + o; } }
        if (kd) {
            *(f32x4*)kd = (f32x4){bflo(kreg.x), bfhi(kreg.x), bflo(kreg.y), bfhi(kreg.y)}; *(f32x4*)(kd + 4) = (f32x4){bflo(kreg.z), bfhi(kreg.z), bflo(kreg.w), bfhi(kreg.w)};
            *(f32x4*)vd = (f32x4){bflo(vreg.x), bfhi(vreg.x), bflo(vreg.y), bfhi(vreg.y)}; *(f32x4*)(vd + 4) = (f32x4){bflo(vreg.z), bfhi(vreg.z), bflo(vreg.w), bfhi(vreg.w)};
        }
    };
    issue(t_lo, sA); issue(t_lo + 1, sB);
    if (KIND == 0) {
        for (int i = tid; i < 257; i += 512) tab[i] = a.in[I_REL][h * 257 + i] * LOG2E;
    } else {
        const int n0 = samp ? PAST : 256 * (blk + 1);
        const float* src = samp ? a.in[I_CLF] + (size_t)b * PAST * 8 + h : a.out + O_LF_P + (size_t)b * SEQ * 8 + h;
        float v[4];
#pragma unroll
        for (int j = 0; j < 4; ++j) { const int idx = 4 * tid + j; v[j] = idx < n0 ? src[(size_t)idx * 8] : 0.f; }
        v[1] += v[0]; v[2] += v[1]; v[3] += v[2];
        float inc = v[3];
#pragma unroll
        for (int o = 1; o < 64; o <<= 1) { const float t = __shfl_up(inc, o); if (lane >= o) inc += t; }
        if (lane == 63) misc[wid] = inc;
        __syncthreads();
        float off = inc - v[3];
#pragma unroll
        for (int w = 0; w < 8; ++w) if (w < wid) off += misc[w];
        if (4 * tid < n0) { f32x4 o4 = {(off + v[0]) * LOG2E, (off + v[1]) * LOG2E, (off + v[2]) * LOG2E, (off + v[3]) * LOG2E}; *(LAS f32x4*)(cs + 4 * tid) = o4; }
        if (samp) {
            __syncthreads();
            if (wid == 0) {
                float x = a.out[O_LF_S + (size_t)(b * DSEQ + lane) * 8 + h];
#pragma unroll
                for (int o = 1; o < 64; o <<= 1) { const float t = __shfl_up(x, o); if (lane >= o) x += t; }
                cs[PAST + lane] = cs[PAST - 1] + x * LOG2E;
            }
        }
    }
    commit(0, t_lo, sA);
    __syncthreads();
    f32x16 o[2];
#pragma unroll
    for (int r = 0; r < 16; ++r) { o[0][r] = 0.f; o[1][r] = 0.f; }
    float mhat = (KIND == 1 && active) ? -cs[qpos] : 0.f;
    f32x16 lacc;
#pragma unroll
    for (int r = 0; r < 16; ++r) lacc[r] = 0.f;
    const unsigned lds0 = (unsigned)(uintptr_t)lds;
    const unsigned vb0 = lds0 + AL_V + ((lane >> 4) & 1) * 32 + (lane & 3) * 8 + (4 * hi + ((lane & 15) >> 2)) * 64;
    auto tile = [&](const int t, const int buf) {
        if (active && t >= w_lo && t <= w_hi) {
            const LAS unsigned char* Kt = lds + AL_K + buf * AL_KB + r32 * 144 + hi * 16;
            f32x16 p0, p1; const float nmh = -mhat;
            if (KIND == 0) {
                const int delta = cch - t;
                if (delta >= 3) { const float bb = tab[256] + nmh;
#pragma unroll
                    for (int r = 0; r < 16; ++r) { p0[r] = bb; p1[r] = bb; } }
                else { int base = 64 * delta + qpos - 4 * hi + 128; asm volatile("" : "+v"(base));
#pragma unroll
                    for (int r = 0; r < 16; ++r) { const int kv = (r & 3) + 8 * (r >> 2); int i0 = base - kv, i1 = base - kv - 32;
                        i0 = i0 < 0 ? 0 : (i0 > 256 ? 256 : i0); i1 = i1 < 0 ? 0 : (i1 > 256 ? 256 : i1); p0[r] = tab[i0] + nmh; p1[r] = tab[i1] + nmh; } }
            } else {
                const LAS float* ct = cs + 64 * t + 4 * hi;
#pragma unroll
                for (int g = 0; g < 4; ++g) { const f32x4 c0 = *(const LAS f32x4*)(ct + 8 * g), c1 = *(const LAS f32x4*)(ct + 32 + 8 * g);
#pragma unroll
                    for (int e = 0; e < 4; ++e) { p0[4 * g + e] = nmh - c0[e]; p1[4 * g + e] = nmh - c1[e]; } }
            }
#pragma unroll
            for (int dk = 0; dk < 4; ++dk) {
                const bf16x8 a0 = *(const LAS bf16x8*)(Kt + dk * 32), a1 = *(const LAS bf16x8*)(Kt + 32 * 144 + dk * 32);
                p0 = __builtin_amdgcn_mfma_f32_32x32x16_bf16(a0, qr[dk], p0, 0, 0, 0);
                p1 = __builtin_amdgcn_mfma_f32_32x32x16_bf16(a1, qr[dk], p1, 0, 0, 0);
            }
            if (KIND == 1) {
                if (t == w_hi) { int kb = 64 * t + 4 * hi - qpos; asm volatile("" : "+v"(kb));
#pragma unroll
                    for (int r = 0; r < 16; ++r) { const int kv = kb + (r & 3) + 8 * (r >> 2); if (kv > 0) p0[r] = -INFINITY; if (kv + 32 > 0) p1[r] = -INFINITY; } }
            }
            float mxa = fmaxf(p0[0], p1[0]), mxb = fmaxf(p0[1], p1[1]), mxc = fmaxf(p0[2], p1[2]), mxd = fmaxf(p0[3], p1[3]);
#pragma unroll
            for (int r = 4; r < 16; r += 4) { mxa = fmaxf(mxa, fmaxf(p0[r], p1[r])); mxb = fmaxf(mxb, fmaxf(p0[r + 1], p1[r + 1])); mxc = fmaxf(mxc, fmaxf(p0[r + 2], p1[r + 2])); mxd = fmaxf(mxd, fmaxf(p0[r + 3], p1[r + 3])); }
            float mx = halfswap_max(fmaxf(fmaxf(mxa, mxb), fmaxf(mxc, mxd)));
            if (__any(mx > 8.0f)) {
                const float dl = fmaxf(mx, 0.f); const float al = __builtin_amdgcn_exp2f(-dl); mhat += dl;
#pragma unroll
                for (int r = 0; r < 16; ++r) { p0[r] -= dl; p1[r] -= dl; }
                if (hi == 0) wsf[r32] = al;
#pragma unroll
                for (int g = 0; g < 4; ++g) { const f32x4 f = *(const LAS f32x4*)(wsf + 8 * g + 4 * hi);
#pragma unroll
                    for (int e = 0; e < 4; ++e) { o[0][4 * g + e] *= f[e]; o[1][4 * g + e] *= f[e]; lacc[4 * g + e] *= f[e]; } }
            }
#pragma unroll
            for (int r = 0; r < 16; ++r) { p0[r] = __builtin_amdgcn_exp2f(p0[r]); p1[r] = __builtin_amdgcn_exp2f(p1[r]); }
            u32x4 w0, w1, w2, w3;
            w0.x = pk2(p0[0], p0[1]); w0.y = pk2(p0[2], p0[3]); w0.z = pk2(p0[4], p0[5]); w0.w = pk2(p0[6], p0[7]);
            w1.x = pk2(p0[8], p0[9]); w1.y = pk2(p0[10], p0[11]); w1.z = pk2(p0[12], p0[13]); w1.w = pk2(p0[14], p0[15]);
            w2.x = pk2(p1[0], p1[1]); w2.y = pk2(p1[2], p1[3]); w2.z = pk2(p1[4], p1[5]); w2.w = pk2(p1[6], p1[7]);
            w3.x = pk2(p1[8], p1[9]); w3.y = pk2(p1[10], p1[11]); w3.z = pk2(p1[12], p1[13]); w3.w = pk2(p1[14], p1[15]);
            pv_step(o, lacc, vb0 + buf * AL_VB, __builtin_bit_cast(bf16x8, w0), __builtin_bit_cast(bf16x8, w1), __builtin_bit_cast(bf16x8, w2), __builtin_bit_cast(bf16x8, w3));
        }
    };
    for (int t = t_lo;;) {
        issue(t + 2, sA);
        tile(t, 0);
        if (t < t_hi) commit(1, t + 1, sB);
        lds_barrier();
        if (++t > t_hi) break;
        issue(t + 2, sB);
        tile(t, 1);
        if (t < t_hi) commit(0, t + 1, sA);
        lds_barrier();
        if (++t > t_hi) break;
    }
    unsigned nxt = 0u;
    if (tid == 0) nxt = atomicAdd(qctr, 1u);
    if (active) {
        float rl[16];
#pragma unroll
        for (int r = 0; r < 16; ++r) rl[r] = __builtin_amdgcn_rcpf(lacc[r]);
        LAS bf16_t* stg = (LAS bf16_t*)(lds + AL_K + wid * 4096);
#pragma unroll
        for (int r = 0; r < 16; ++r) { const int orow = crow(r, hi); stg[orow * 64 + r32] = (bf16_t)f2bf(o[0][r] * rl[r]); stg[orow * 64 + 32 + r32] = (bf16_t)f2bf(o[1][r] * rl[r]); }
#pragma unroll
        for (int i = 0; i < 4; ++i) { const int row = i * 8 + (lane >> 3), ch = lane & 7; const u32x4 v = *(const LAS u32x4*)(stg + row * 64 + ch * 8);
            *(u32x4*)(Ob + (size_t)(qrow + row) * HW + h * 64 + ch * 8) = v; }
    }
    if (tid == 0) *qnext = nxt;
}

__device__ __forceinline__ void phase_attention(const Args& a, LAS unsigned char* lds, const int wv) {
    const int tid = wv * 64 + lane_id();
    unsigned* ctr = (unsigned*)(a.ws + WS_CTL);
    LAS unsigned* sidx = (LAS unsigned*)(lds + AL_MISC + 64);
    __syncthreads();
    if (tid == 0) *sidx = atomicAdd(ctr, 1u);
    for (;;) {
        lds_barrier();
        const int i = (int)*sidx;
        if (i >= N_ATT_UNITS + N_TR_UNITS) break;
        if (i >= N_ATT_UNITS) {
            const int it = TI_IN + (i - N_ATT_UNITS) * 8 + wv;
            __syncthreads();
            int l2 = lane_id(); asm volatile("" : "+v"(l2));
            if (it < TI_ALL) transpose_item(a, it, (LAS float*)(lds + wv * 8448), l2);
            __syncthreads();
            if (tid == 0) *sidx = atomicAdd(ctr, 1u);
            continue;
        }
        if (i < 128) attn_unit<1>(a, lds, i >> 3, i & 7, 0, 1, wv, ctr, sidx);
        else if (i < 448) { const int j = i - 128; attn_unit<1>(a, lds, (j & 63) >> 3, j & 7, 7 - (j >> 6), 0, wv, ctr, sidx); }
        else if (i < 832) { const int j = i - 448; attn_unit<0>(a, lds, (j & 63) >> 3, j & 7, 7 - (j >> 6), 0, wv, ctr, sidx); }
        else if (i < 896) { const int j = i - 832; attn_unit<1>(a, lds, j >> 3, j & 7, 2, 0, wv, ctr, sidx); }
        else if (i < 1024) { const int j = i - 896; attn_unit<0>(a, lds, j >> 3, j & 7, 0, 1, wv, ctr, sidx); }
        else if (i < 1088) { const int j = i - 1024; attn_unit<0>(a, lds, j >> 3, j & 7, 1, 0, wv, ctr, sidx); }
        else if (i < 1152) { const int j = i - 1088; attn_unit<1>(a, lds, j >> 3, j & 7, 1, 0, wv, ctr, sidx); }
        else if (i < 1216) { const int j = i - 1152; attn_unit<1>(a, lds, j >> 3, j & 7, 0, 0, wv, ctr, sidx); }
        else { const int j = i - 1216; attn_unit<0>(a, lds, j >> 3, j & 7, 0, 0, wv, ctr, sidx); }
    }
}

#define XB_TMO      128
#define XB_XCNT(j)  (256  + 64 * (j))
#define XB_XSUB(j)  (1280 + 64 * (j))
#define XB_XGEN(j)  (2304 + 64 * (j))
#define XB_TOP      3328
#define XB_TOPGEN   3392
#define XCD_BAR_WORDS 3456
#define XB_SPIN_CAP (1u << 18)

__device__ __forceinline__ unsigned xb_ld(unsigned* p)              { return __hip_atomic_load(p, __ATOMIC_RELAXED, __HIP_MEMORY_SCOPE_AGENT); }
__device__ __forceinline__ unsigned xb_add(unsigned* p, unsigned v) { return __hip_atomic_fetch_add(p, v, __ATOMIC_RELAXED, __HIP_MEMORY_SCOPE_AGENT); }
__device__ __forceinline__ unsigned xb_xcc_id() { return (unsigned)__builtin_amdgcn_s_getreg((3 << 11) | 20) & 0xFu; }
#define XB_SPIN(cond, bar) do { unsigned _sp = 0; while (cond) { __builtin_amdgcn_s_sleep(1); \
    if ((++_sp & 255u) == 0u) { if (xb_ld(&(bar)[XB_TMO])) break; if (_sp > XB_SPIN_CAP) { atomicAdd(&(bar)[XB_TMO], 1u); break; } } } } while (0)

struct XcdBarrier {
    unsigned* bar; unsigned x; bool leader;
    volatile LAS unsigned* st;
};

__device__ __forceinline__ XcdBarrier xcd_barrier_post(unsigned* bar, volatile LAS unsigned* st, const bool leader) {
    XcdBarrier b; b.bar = bar; b.x = xb_xcc_id(); b.st = st; b.leader = leader;
    if (leader) (void)xb_add(&bar[XB_XCNT(b.x)], 1u);
    return b;
}
__device__ __forceinline__ void xcd_barrier_complete(unsigned* bar, unsigned x, unsigned& nloc, unsigned& nx) {
    const unsigned G = gridDim.x * gridDim.y * gridDim.z;
    unsigned sum, cnt, mine, sp = 0u;
    for (;;) {
        sum = 0u; cnt = 0u; mine = 0u;
#pragma unroll
        for (unsigned j = 0; j < 16; ++j) { const unsigned c = xb_ld(&bar[XB_XCNT(j)]); sum += c; cnt += (c > 0u) ? 1u : 0u; mine = (j == x) ? c : mine; }
        if (sum == G) break;
        __builtin_amdgcn_s_sleep(1);
        if ((++sp & 255u) == 0u) { if (xb_ld(&bar[XB_TMO])) break; if (sp > XB_SPIN_CAP) { atomicAdd(&bar[XB_TMO], 1u); break; } }
    }
    nloc = mine > 0u ? mine : 1u; nx = cnt > 0u ? cnt : 1u;
}

__device__ __forceinline__ void xcd_barrier(const XcdBarrier& b, const bool leader_now) {
    asm volatile("s_waitcnt vmcnt(0)" ::: "memory");
    __syncthreads();
    if (leader_now) {
        unsigned* bar = b.bar;
        __builtin_amdgcn_s_waitcnt(0);
        unsigned nloc = b.st[0], nx = b.st[1];
        if (nloc == 0u) { xcd_barrier_complete(bar, b.x, nloc, nx); b.st[0] = nloc; b.st[1] = nx; }
        const unsigned old = xb_add(&bar[XB_XSUB(b.x)], 1u);
        const unsigned gen = old / nloc;
        if (old + 1u == (gen + 1u) * nloc) {
            __builtin_amdgcn_fence(__ATOMIC_RELEASE, "agent");
            asm volatile("s_waitcnt vmcnt(0)" ::: "memory");
            const unsigned og = xb_add(&bar[XB_TOP], 1u);
            const unsigned tg = og / nx;
            if (og + 1u == (tg + 1u) * nx) xb_add(&bar[XB_TOPGEN], 1u);
            else XB_SPIN(xb_ld(&bar[XB_TOPGEN]) == tg, bar);
            __builtin_amdgcn_fence(__ATOMIC_ACQUIRE, "agent");
            xb_add(&bar[XB_XGEN(b.x)], 1u);
            asm volatile("s_waitcnt vmcnt(0)" ::: "memory");
        } else {
            XB_SPIN(xb_ld(&bar[XB_XGEN(b.x)]) == gen, bar);
            __builtin_amdgcn_fence(__ATOMIC_ACQUIRE, "agent");
            asm volatile("s_waitcnt vmcnt(0)" ::: "memory");
        }
    }
    __syncthreads();
}

constexpr int N_PHASES = 7;
__device__ __forceinline__ void grid_bar(unsigned* bar, unsigned& epoch, const int wv, const unsigned nblocks) {
    __syncthreads();
    epoch += 1;
    if (wv == 0 && lane_id() == 0) {
        __builtin_amdgcn_fence(__ATOMIC_RELEASE, "agent");
        asm volatile("s_waitcnt vmcnt(0)" ::: "memory");
        __hip_atomic_fetch_add(bar, 1u, __ATOMIC_RELAXED, __HIP_MEMORY_SCOPE_AGENT);
        const unsigned target = epoch * nblocks;
        while (__hip_atomic_load(bar, __ATOMIC_RELAXED, __HIP_MEMORY_SCOPE_AGENT) < target) __builtin_amdgcn_s_sleep(2);
        __builtin_amdgcn_fence(__ATOMIC_ACQUIRE, "agent");
        asm volatile("s_waitcnt vmcnt(0)" ::: "memory");
    }
    __syncthreads();
}
__global__ void __launch_bounds__(512, 2) mega_fwd(Args a) {
    extern __shared__ __attribute__((aligned(16))) unsigned char lds_raw[];
    LAS unsigned char* lds = (LAS unsigned char*)lds_raw;
    unsigned char* ws = a.ws;
    const int lo = a.ph_lo, hi = a.ph_hi, G = gridDim.x, c = (int)blockIdx.x;
    const int wv = __builtin_amdgcn_readfirstlane((int)threadIdx.x >> 6);
    volatile LAS unsigned* bst = (volatile LAS unsigned*)(lds + RING_BYTES + 12288);
    if (threadIdx.x < 2) bst[threadIdx.x] = 0u;
    __syncthreads();
    XcdBarrier xbar; xbar.bar = (unsigned*)(ws + WS_CTL) + 1024; xbar.x = 0; xbar.st = bst; xbar.leader = false;
    if (a.coop == 2) cg::this_grid().sync();
    if (a.coop) xbar = xcd_barrier_post((unsigned*)(ws + WS_CTL) + 1024, bst, wv == 0 && lane_id() == 0);
#define IN(k) (lo <= (k) && (k) < hi)
#define SEAM(k) do { if (IN(k) && IN((k) + 1)) { if (a.coop) { xcd_barrier(xbar, wv == 0 && lane_id() == 0); } } } while (0)
    if (IN(0)) phase_prologue(a, lds, wv);
    SEAM(0);
    if (IN(1)) {
        pg8::Gemm g{(const bf16_t*)(ws + WS_H), (const bf16_t*)(ws + WS_WIN), MP, NIN, DM}; pg8::StaticOrder S; S.init(MP, NIN, G, c);
        EpiIn E{ws, a.out};
        pg8::gemm_phase<EpiIn, pg8::StaticOrder, true, true>(lds, g, S, E, wv);
        small_gemm_a4<EpiIn>(lds, g.A, g.Bt, NIN, E, wv);
    }
    SEAM(1);
    if (IN(2)) phase_attention(a, lds, wv);
    SEAM(2);
    if (IN(3)) {
        { pg8::Gemm g{(const bf16_t*)(ws + WS_OA), (const bf16_t*)(ws + WS_WPA), MP, DM, HW}; pg8::StaticOrder S; S.init(MP, DM, G, c);
          EpiProjA E{(const bf16_t*)(ws + WS_GA), (bf16_t*)(ws + WS_T)};
          pg8::gemm_phase<EpiProjA, pg8::StaticOrder, true, true>(lds, g, S, E, wv);
          small_gemm<EpiProjA>(lds, g.A, g.Bt, HW, DM, E, wv); }
        { pg8::Gemm g{(const bf16_t*)(ws + WS_OB), (const bf16_t*)(ws + WS_WPB), MP, DM, HW}; pg8::StaticOrder S; S.init(MP, DM, G, c);
          EpiProjB E{(const bf16_t*)(ws + WS_GB), (const bf16_t*)(ws + WS_T), (bf16_t*)(ws + WS_MG)};
          pg8::gemm_phase<EpiProjB, pg8::StaticOrder, true, true>(lds, g, S, E, wv);
          small_gemm<EpiProjB>(lds, g.A, g.Bt, HW, DM, E, wv); }
    }
    SEAM(3);
    if (IN(4)) {
        pg8::Gemm g{(const bf16_t*)(ws + WS_MG), (const bf16_t*)(ws + WS_WOUT), MP, DM, DM}; pg8::StaticOrder S; S.init(MP, DM, G, c);
        EpiOutNorm EN{a.in[I_XP], (bf16_t*)(ws + WS_X1), (bf16_t*)(ws + WS_H), a.in[I_G2], a.in[I_G3], RowStat{(float*)(ws + WS_XB1), (unsigned*)(ws + WS_CTL) + CW_CNT1}, RowStat{(float*)(ws + WS_XB2), (unsigned*)(ws + WS_CTL) + CW_CNT2}};
        pg8::gemm_phase<EpiOutNorm, pg8::StaticOrder, false, true>(lds, g, S, EN, wv);
        __syncthreads();
        small_gemm_norm<0>(lds, g.A, g.Bt, DM, a.in[I_XS], a.out + O_Y, (bf16_t*)(ws + WS_X1), (bf16_t*)(ws + WS_H), a.in[I_G2], a.in[I_G3],
                           TailStat{(float*)(ws + WS_XT1), (unsigned*)(ws + WS_CTL) + CW_TC1}, TailStat{(float*)(ws + WS_XT2), (unsigned*)(ws + WS_CTL) + CW_TC2}, wv);
    }
    SEAM(4);
    if (IN(5)) {
        pg8::Gemm g{(const bf16_t*)(ws + WS_H), (const bf16_t*)(ws + WS_WUP), MTOK, NUP, DM}; pg8::StaticOrder S; S.init(MTOK, NUP, G, c);
        EpiUpFused E{(bf16_t*)(ws + WS_A2), a.out, a.in[I_CW], a.in[I_CB], a.in[I_CONV], (float*)(ws + WS_HEAD), (float*)(ws + WS_TAIL), (LAS float*)(lds + RING_BYTES)};
        pg8::gemm_phase<EpiUpFused, pg8::StaticOrder, true, true>(lds, g, S, E, wv);
    }
    SEAM(5);
    if (IN(6)) {
        pg8::Gemm g{(const bf16_t*)(ws + WS_A2), (const bf16_t*)(ws + WS_WDN), MP, DM, DFF}; pg8::StaticOrder S; S.init(MP, DM, G, c);
        { Unit fu; for (int i = 0; S.next(i, fu); ++i) ffn_fixup(a, fu.pm, wv * 64 + lane_id()); }
        __syncthreads();
        EpiDownNorm EN{(const bf16_t*)(ws + WS_X1), a.out + O_Y, a.in[I_G4], RowStat{(float*)(ws + WS_XB3), (unsigned*)(ws + WS_CTL) + CW_CNT3}};
        pg8::gemm_phase<EpiDownNorm, pg8::StaticOrder, false, true>(lds, g, S, EN, wv);
        __syncthreads();
        small_gemm_norm<1>(lds, g.A, g.Bt, DFF, nullptr, a.out + O_Y, (bf16_t*)(ws + WS_X1), nullptr, a.in[I_G4], nullptr,
                           TailStat{(float*)(ws + WS_XT3), (unsigned*)(ws + WS_CTL) + CW_TC3}, TailStat{nullptr, nullptr}, wv);
    }
#undef IN
#undef SEAM
}

#ifndef MK_N_LAUNCHES
#define MK_N_LAUNCHES 1
#endif
extern "C" void kernel_launch(void* const* d_in, const int* in_sizes, int n_in, void* d_out, int out_size, void* d_ws, size_t ws_size, hipStream_t stream) {
    static int grid = 0;
    if (grid == 0) {
        if (n_in != 22 || (size_t)out_size != O_END || ws_size < WS_END) { fprintf(stderr, "kernel_launch: unexpected sizes n_in %d out %d ws %zu\n", n_in, out_size, ws_size); grid = -1; return; }
        int dev = 0, cus = 0, per_cu = 0;
        hipGetDevice(&dev);
        hipDeviceGetAttribute(&cus, hipDeviceAttributeMultiprocessorCount, dev);
        hipFuncSetAttribute((const void*)mega_fwd, hipFuncAttributeMaxDynamicSharedMemorySize, LDS_BYTES);
        hipOccupancyMaxActiveBlocksPerMultiprocessor(&per_cu, (const void*)mega_fwd, 512, LDS_BYTES);
        if (per_cu < 1) { fprintf(stderr, "kernel_launch: occupancy query says %d blocks/CU\n", per_cu); per_cu = 1; }
        (void)hipGetLastError();
        grid = cus;
        if (grid != 256) { fprintf(stderr, "kernel_launch: built for 256 CUs (one 256x256 unit per workgroup in the fused-norm GEMMs), device has %d\n", grid); grid = -1; return; }
    }
    if (grid < 0) return;
    hipMemsetAsync((char*)d_ws + WS_CTL, 0, CTL_BYTES, stream);
    Args a{};
    for (int i = 0; i < 22; ++i) a.in[i] = (const float*)d_in[i];
    a.out = (float*)d_out; a.ws = (unsigned char*)d_ws;
#if MK_N_LAUNCHES == 1
    a.ph_lo = 0; a.ph_hi = N_PHASES; a.coop = 1; a.pad = 0;
    void* args[] = {&a};
    hipError_t e = hipLaunchCooperativeKernel((const void*)mega_fwd, dim3(grid), dim3(512), args, LDS_BYTES, stream);
    if (e != hipSuccess) fprintf(stderr, "cooperative launch failed: %s (grid %d)\n", hipGetErrorString(e), grid);
#else
    for (int p = 0; p < N_PHASES; ++p) {
        a.ph_lo = p; a.ph_hi = p + 1; a.coop = 0; a.pad = 0;
        hipLaunchKernelGGL(mega_fwd, dim3(grid), dim3(512), LDS_BYTES, stream, a);
    }
#endif
}
```

```cpp
#include <hip/hip_runtime.h>
#include <hip/hip_cooperative_groups.h>
#include <cstdio>
#include <cstdint>
namespace cg = cooperative_groups;
namespace pg8 {
#define PG8_LAS __attribute__((address_space(3)))
typedef unsigned short bf16_t;
typedef short bf16x8 __attribute__((ext_vector_type(8)));
typedef float f32x4 __attribute__((ext_vector_type(4)));
typedef unsigned u32x4 __attribute__((ext_vector_type(4)));
constexpr int BM = 256, BK = 64, HALF = 128, HTB = HALF * BK * 2  , STAGE_BYTES = 8 * HTB, NXCD = 8, WGM = 8;

__host__ __device__ __forceinline__ int lds_byte(int r, int c) { const int st = (r >> 4) * 2 + (c >> 5), rr = r & 15, cc = c & 31, ob = rr * 64 + cc * 2; return st * 1024 + (ob ^ (((ob >> 9) & 1) << 5)); }
__host__ __device__ __forceinline__ void stage_rc(int b, int& R, int& C) { const int st = b / 1024, sb = b % 1024, swz = sb ^ (((sb >> 9) & 1) << 5); R = (st >> 1) * 16 + swz / 64; C = (st & 1) * 32 + (swz % 64) / 2; }
__host__ __device__ __forceinline__ int perm32(int rho) { const int n = rho >> 4, i = rho & 15; return 8 * (i >> 2) + 4 * n + (i & 3); }

struct Unit { int pm, pn; };
struct Gemm { const bf16_t* A; const bf16_t* Bt; int M, N, K; };

struct StaticOrder {
    int nM, nN, nwg, G, c;
    __host__ __device__ void init(int M, int N, int G_, int c_) { nM = M / BM; nN = N / BM; nwg = nM * nN; G = G_; c = c_; }
    __host__ __device__ __forceinline__ bool next(int i, Unit& u) const {
        const long L = (long)i * G + c; if (L >= nwg) return false;
        int wgid = (int)L; { const int q = nwg / NXCD, r = nwg % NXCD, xcd = wgid % NXCD, off = wgid / NXCD; wgid = (xcd < r ? xcd * (q + 1) : r * (q + 1) + (xcd - r) * q) + off; }
        const int nig = WGM * nN, gid = wgid / nig, fm = gid * WGM, gsz = (nM - fm) < WGM ? (nM - fm) : WGM;
        u.pm = fm + ((wgid % nig) % gsz); u.pn = (wgid % nig) / gsz; return true;
    }
    __device__ __forceinline__ void a_ready(const Unit&) const {}
    __device__ __forceinline__ void done(const Unit&) const {}
};

__device__ __forceinline__ unsigned cvt_pk_bf16(float lo, float hi) { unsigned r; asm volatile("v_cvt_pk_bf16_f32 %0, %1, %2" : "=v"(r) : "v"(lo), "v"(hi)); return r; }
typedef float f32x2 __attribute__((ext_vector_type(2)));
template <class Epi, class Sched, bool ALIGN_EPI = false, bool SP2 = false>
__device__ __forceinline__ void gemm_phase(PG8_LAS unsigned char* lds, const Gemm g, const Sched& S, const Epi& E, const int wv) {
    const int wid = wv, lane = (int)__builtin_amdgcn_mbcnt_hi(~0u, __builtin_amdgcn_mbcnt_lo(~0u, 0u)), tid = wid * 64 + lane, wr = wid >> 2, wc = wid & 3, fr = lane & 15, fq = lane >> 4;
    const int K = g.K, nt = K / BK;
    unsigned voffA[2], voffB[2];
#pragma unroll
    for (int i = 0; i < 2; ++i) { int R, C; stage_rc(tid * 16 + i * 8192, R, C); const int Rb = Epi::PERM ? ((R & ~31) + perm32(R & 31)) : R;
        voffA[i] = (unsigned)(R * K + C) * 2u; voffB[i] = (unsigned)(Rb * K + C) * 2u; }
    const size_t kstep = (size_t)(BK * 2);
    const size_t hstep = (size_t)HALF * K * 2;
    const size_t tstep = 2 * hstep;
    const unsigned ldsw = (unsigned)wid * 1024u;
    const int aoff = lds_byte(wr * 64 + fr, fq * 8), boff = lds_byte(wc * 32 + fr, fq * 8);
#define PG8_SA(b, h) (((b) * 2 + (h)) * HTB)
#define PG8_SB(b, h) ((4 + (b) * 2 + (h)) * HTB)
#define PG8_STAGE(bufoff, gbase, voff) do { _Pragma("unroll") for (int _i = 0; _i < 2; ++_i) \
        __builtin_amdgcn_global_load_lds((const unsigned*)((const char*)(gbase) + (voff)[_i]), (PG8_LAS unsigned*)(lds + (bufoff) + ldsw + _i * 8192), 16, 0, 0); } while (0)
#define PG8_LDA(dst, b, h) do { _Pragma("unroll") for (int m = 0; m < 4; ++m) _Pragma("unroll") for (int k = 0; k < 2; ++k) dst[m][k] = *(const PG8_LAS bf16x8*)(lds + PG8_SA(b, h) + aoff + m * 2048 + k * 1024); } while (0)
#define PG8_LDB(dst, b, h) do { _Pragma("unroll") for (int n = 0; n < 2; ++n) _Pragma("unroll") for (int k = 0; k < 2; ++k) dst[n][k] = *(const PG8_LAS bf16x8*)(lds + PG8_SB(b, h) + boff + n * 2048 + k * 1024); } while (0)
#define PG8_MMA(ai, bj, At, Bt) do { __builtin_amdgcn_s_setprio(1); _Pragma("unroll") for (int m = 0; m < 4; ++m) _Pragma("unroll") for (int n = 0; n < 2; ++n) _Pragma("unroll") for (int k = 0; k < 2; ++k) \
        acc[ai][bj][m][n] = __builtin_amdgcn_mfma_f32_16x16x32_bf16(Bt[n][k], At[m][k], acc[ai][bj][m][n], 0, 0, 0); __builtin_amdgcn_s_setprio(0); } while (0)
#define PG8_WAIT_V(n) asm volatile("s_waitcnt vmcnt(" #n ")" ::: "memory")
#define PG8_WAIT_L(n) asm volatile("s_waitcnt lgkmcnt(" #n ")" ::: "memory")
#define PG8_BAR __builtin_amdgcn_s_barrier()
#define PG8_SCHED __builtin_amdgcn_sched_barrier(0)
    Unit cur, nxt; int ui = 0;
    if (!S.next(0, cur)) return;
    f32x4 acc[2][2][4][2];
#pragma unroll
    for (int a = 0; a < 2; ++a)
#pragma unroll
        for (int b = 0; b < 2; ++b)
#pragma unroll
            for (int m = 0; m < 4; ++m)
#pragma unroll
                for (int n = 0; n < 2; ++n) acc[a][b][m][n] = (f32x4){0.f, 0.f, 0.f, 0.f};
    bf16x8 At[4][2], B0[2][2], B1[2][2];
    const char* cA = (const char*)g.A + (size_t)cur.pm * tstep; const char* cB = (const char*)g.Bt + (size_t)cur.pn * tstep;
    S.a_ready(cur);
    if constexpr (SP2) {
        PG8_STAGE(PG8_SB(0, 0), cB, voffB); PG8_STAGE(PG8_SB(0, 1), cB + hstep, voffB); PG8_STAGE(PG8_SA(0, 0), cA, voffA); PG8_STAGE(PG8_SA(0, 1), cA + hstep, voffA);
        if (wr == 1) PG8_BAR;
        PG8_WAIT_V(2); PG8_BAR;
        PG8_STAGE(PG8_SB(1, 0), cB + kstep, voffB); PG8_STAGE(PG8_SA(1, 0), cA + kstep, voffA); PG8_STAGE(PG8_SB(1, 1), cB + hstep + kstep, voffB);
        PG8_WAIT_V(6); PG8_BAR;
    } else {
        PG8_STAGE(PG8_SB(0, 0), cB, voffB); PG8_STAGE(PG8_SA(0, 0), cA, voffA); PG8_STAGE(PG8_SB(0, 1), cB + hstep, voffB); PG8_STAGE(PG8_SA(0, 1), cA + hstep, voffA);
        if (wr == 1) PG8_BAR;
        PG8_WAIT_V(4); PG8_BAR;
        PG8_STAGE(PG8_SB(1, 0), cB + kstep, voffB); PG8_STAGE(PG8_SA(1, 0), cA + kstep, voffA); PG8_STAGE(PG8_SB(1, 1), cB + hstep + kstep, voffB);
        PG8_WAIT_V(6); PG8_BAR;
    }
    for (;;) {
        const bool has_next = S.next(ui + 1, nxt);
        const char* nA = has_next ? (const char*)g.A + (size_t)nxt.pm * tstep : cA; const char* nB = has_next ? (const char*)g.Bt + (size_t)nxt.pn * tstep : cB;
        for (int t = 0; t < nt; t += 2) {
            const bool last = (t == nt - 2);
            const char* a1 = cA + (size_t)(t + 1) * kstep;
            const char* a2 = last ? nA : cA + (size_t)(t + 2) * kstep; const char* b2 = last ? nB : cB + (size_t)(t + 2) * kstep;
            const char* a3 = a2 + kstep; const char* b3 = b2 + kstep;
            if (last && has_next) S.a_ready(nxt);
            if constexpr (SP2) {
            PG8_LDB(B0, 0, 0); PG8_LDB(B1, 0, 1); PG8_SCHED; PG8_LDA(At, 0, 0); PG8_STAGE(PG8_SA(1, 1), a1 + hstep, voffA);
            PG8_WAIT_V(8); PG8_WAIT_L(0); PG8_BAR; PG8_MMA(0, 0, At, B0); PG8_MMA(0, 1, At, B1); PG8_BAR; PG8_SCHED;
            PG8_LDA(At, 0, 1); PG8_STAGE(PG8_SB(0, 0), b2, voffB); PG8_STAGE(PG8_SB(0, 1), b2 + hstep, voffB); PG8_STAGE(PG8_SA(0, 0), a2, voffA);
            PG8_WAIT_V(8); PG8_WAIT_L(0); PG8_BAR; PG8_MMA(1, 0, At, B0); PG8_MMA(1, 1, At, B1); PG8_BAR; PG8_SCHED;
            PG8_LDB(B0, 1, 0); PG8_LDB(B1, 1, 1); PG8_SCHED; PG8_LDA(At, 1, 0); PG8_STAGE(PG8_SA(0, 1), a2 + hstep, voffA);
            PG8_WAIT_V(8); PG8_WAIT_L(0); PG8_BAR; PG8_MMA(0, 0, At, B0); PG8_MMA(0, 1, At, B1); PG8_BAR; PG8_SCHED;
            PG8_LDA(At, 1, 1); PG8_STAGE(PG8_SB(1, 0), b3, voffB); PG8_STAGE(PG8_SB(1, 1), b3 + hstep, voffB); PG8_STAGE(PG8_SA(1, 0), a3, voffA);
            PG8_WAIT_V(8); PG8_WAIT_L(0); PG8_BAR; PG8_MMA(1, 0, At, B0); PG8_MMA(1, 1, At, B1); PG8_BAR; PG8_SCHED;
            } else {
            PG8_LDB(B0, 0, 0); PG8_SCHED; PG8_LDA(At, 0, 0); PG8_STAGE(PG8_SA(1, 1), a1 + hstep, voffA);
            PG8_WAIT_L(8); PG8_BAR; PG8_WAIT_L(0); PG8_MMA(0, 0, At, B0); PG8_BAR; PG8_SCHED;
            PG8_LDB(B1, 0, 1); PG8_STAGE(PG8_SB(0, 0), b2, voffB);
            PG8_BAR; PG8_WAIT_L(0); PG8_MMA(0, 1, At, B1); PG8_BAR;
            PG8_LDA(At, 0, 1); PG8_STAGE(PG8_SA(0, 0), a2, voffA);
            PG8_BAR; PG8_WAIT_L(0); PG8_MMA(1, 0, At, B0); PG8_BAR; PG8_SCHED;
            PG8_STAGE(PG8_SB(0, 1), b2 + hstep, voffB);
            PG8_WAIT_V(6); PG8_BAR; PG8_MMA(1, 1, At, B1); PG8_BAR;
            PG8_LDB(B0, 1, 0); PG8_SCHED; PG8_LDA(At, 1, 0); PG8_STAGE(PG8_SA(0, 1), a2 + hstep, voffA);
            PG8_WAIT_L(8); PG8_BAR; PG8_WAIT_L(0); PG8_MMA(0, 0, At, B0); PG8_BAR; PG8_SCHED;
            PG8_LDB(B1, 1, 1); PG8_STAGE(PG8_SB(1, 0), b3, voffB);
            PG8_BAR; PG8_WAIT_L(0); PG8_MMA(0, 1, At, B1); PG8_BAR;
            PG8_LDA(At, 1, 1); PG8_STAGE(PG8_SA(1, 0), a3, voffA);
            PG8_BAR; PG8_WAIT_L(0); PG8_MMA(1, 0, At, B0); PG8_BAR; PG8_SCHED;
            PG8_STAGE(PG8_SB(1, 1), b3 + hstep, voffB);
            PG8_WAIT_V(6); PG8_BAR; PG8_MMA(1, 1, At, B1); PG8_BAR;
            }
        }
        if constexpr (ALIGN_EPI) { if (wr == 0) PG8_BAR; }
        if constexpr (!Epi::AFTER_DRAIN) { E(acc, cur, wr, wc, fr, fq); S.done(cur); }
        if (!has_next) break;
#pragma unroll
        for (int a = 0; a < 2; ++a)
#pragma unroll
            for (int b = 0; b < 2; ++b)
#pragma unroll
                for (int m = 0; m < 4; ++m)
#pragma unroll
                    for (int n = 0; n < 2; ++n) acc[a][b][m][n] = (f32x4){0.f, 0.f, 0.f, 0.f};
        cur = nxt; cA = nA; cB = nB; ++ui;
        if constexpr (ALIGN_EPI) { if (wr == 1) PG8_BAR; }
    }
    PG8_WAIT_V(0);
    if constexpr (!ALIGN_EPI) { if (wr == 0) PG8_BAR; }
    PG8_BAR;
    if constexpr (Epi::AFTER_DRAIN) { E.fused(acc, cur, wr, wc, fr, fq, lds, wid, lane); S.done(cur); }
#undef PG8_SA
#undef PG8_SB
#undef PG8_STAGE
#undef PG8_LDA
#undef PG8_LDB
#undef PG8_MMA
#undef PG8_WAIT_V
#undef PG8_WAIT_L
#undef PG8_BAR
#undef PG8_SCHED
}
}

#define LAS __attribute__((address_space(3)))
using pg8::bf16_t; using pg8::bf16x8; using pg8::f32x4; using pg8::u32x4; using pg8::Unit;
typedef float f32x16 __attribute__((ext_vector_type(16)));
typedef short s16x4 __attribute__((ext_vector_type(4)));
typedef unsigned u32x2 __attribute__((ext_vector_type(2)));

constexpr int DM = 1024, NBAT = 8, SEQ = 2048, DBAT = 16, DSEQ = 64, PAST = 2048, ALEN = 512;
constexpr int MP = NBAT * SEQ, MS = DBAT * DSEQ, MTOK = MP + MS;
constexpr int HW = 512;
constexpr int NIN = 5120;
constexpr int DFF = 2816, NUP = 2 * DFF;
constexpr float EPS = 1e-6f, LOG2E = 1.4426950408889634f, QSCALE = 0.125f * LOG2E;

constexpr size_t O_Y = 0;
constexpr size_t O_KA_P = (size_t)MTOK * DM;
constexpr size_t O_VA_P = O_KA_P + (size_t)NBAT * ALEN * HW;
constexpr size_t O_KB_P = O_VA_P + (size_t)NBAT * ALEN * HW;
constexpr size_t O_VB_P = O_KB_P + (size_t)NBAT * SEQ * HW;
constexpr size_t O_LF_P = O_VB_P + (size_t)NBAT * SEQ * HW;
constexpr size_t O_CV_P = O_LF_P + (size_t)NBAT * SEQ * 8;
constexpr size_t O_KA_S = O_CV_P + (size_t)NBAT * 2 * NUP;
constexpr size_t O_VA_S = O_KA_S + (size_t)MS * HW;
constexpr size_t O_KB_S = O_VA_S + (size_t)MS * HW;
constexpr size_t O_VB_S = O_KB_S + (size_t)MS * HW;
constexpr size_t O_LF_S = O_VB_S + (size_t)MS * HW;
constexpr size_t O_CV_S = O_LF_S + (size_t)MS * 8;
constexpr size_t O_END = O_CV_S + (size_t)DBAT * 2 * NUP;
static_assert(O_END == 41304064, "output size");

constexpr size_t MiB = 1u << 20;
constexpr size_t WS_CTL = 0, CTL_BYTES = 131072;
constexpr int CW_CNT1 = 8192, CW_CNT2 = 12288, CW_CNT3 = 16384, CW_TC1 = 20480, CW_TC2 = 21504, CW_TC3 = 22528;
constexpr size_t WS_WIN = 1 * MiB, WS_WUP = 11 * MiB, WS_WDN = 22 * MiB, WS_WOUT = 28 * MiB, WS_WPA = 30 * MiB, WS_WPB = 31 * MiB;
constexpr size_t WS_H = 32 * MiB;
constexpr size_t WS_OA = 32 * MiB, WS_OB = 236 * MiB;
constexpr size_t WS_QKV = 66 * MiB;
constexpr size_t QKV_STRIDE = (size_t)MTOK * HW;
constexpr size_t WS_GA = 168 * MiB, WS_GB = 202 * MiB;
constexpr size_t WS_T = 66 * MiB;
constexpr size_t WS_X1 = 100 * MiB;
constexpr size_t WS_MG = 134 * MiB;
constexpr size_t WS_U = 66 * MiB;
constexpr size_t WS_A2 = 160 * MiB;
constexpr size_t WS_HEAD = 254 * MiB, WS_TAIL = 258 * MiB;
constexpr size_t WS_XB1 = 262 * MiB, WS_XB2 = WS_XB1 + 262144, WS_XB3 = WS_XB2 + 262144;
constexpr size_t WS_XT1 = WS_XB3 + 262144, WS_XT2 = WS_XT1 + 65536, WS_XT3 = WS_XT2 + 65536;
constexpr size_t WS_RS2 = WS_XT3 + 65536;
constexpr size_t WS_END = 264 * MiB;
static_assert(WS_A2 + (size_t)MTOK * DFF * 2 <= WS_END && WS_U + (size_t)MTOK * DFF * 2 <= WS_A2, "ws map");

constexpr int RING_BYTES = 131072, LDS_BYTES = 147456;

struct Args { const float* in[22]; float* out; unsigned char* ws; int ph_lo, ph_hi, coop, pad; };
enum { I_XP = 0, I_XS, I_CKA, I_CVA, I_CKB, I_CVB, I_CLF, I_CONV, I_G1, I_G2, I_G3, I_G4, I_WIN, I_BF, I_REL, I_WPA, I_WPB, I_WOUT, I_WUP, I_CW, I_CB, I_WDN };

__device__ __forceinline__ void lds_barrier() { asm volatile("s_waitcnt lgkmcnt(0)" ::: "memory"); __builtin_amdgcn_s_barrier(); asm volatile("" ::: "memory"); }
__device__ __forceinline__ int lane_id() { return (int)__builtin_amdgcn_mbcnt_hi(~0u, __builtin_amdgcn_mbcnt_lo(~0u, 0u)); }
__device__ __forceinline__ unsigned f2bf(float f) { unsigned u = __builtin_bit_cast(unsigned, f); return (u + 0x7fffu + ((u >> 16) & 1u)) >> 16; }
__device__ __forceinline__ unsigned pk2(float lo, float hi) { return pg8::cvt_pk_bf16(lo, hi); }
__device__ __forceinline__ float bflo(unsigned w) { return __uint_as_float(w << 16); }
__device__ __forceinline__ float bfhi(unsigned w) { return __uint_as_float(w & 0xffff0000u); }
__device__ __forceinline__ float wave_sum(float v) {
#pragma unroll
    for (int o = 1; o < 64; o <<= 1) v += __shfl_xor(v, o);
    return v;
}
__device__ __forceinline__ float sigmoidf_(float x) { return __builtin_amdgcn_rcpf(1.0f + __builtin_amdgcn_exp2f(-x * LOG2E)); }
__device__ __forceinline__ const float* xrow_ptr(const Args& a, int m) { return m < MP ? a.in[I_XP] + (size_t)m * DM : a.in[I_XS] + (size_t)(m - MP) * DM; }

#define EPI_MAIN_CALL \
    __device__ __forceinline__ void operator()(const f32x4 (&acc)[2][2][4][2], const Unit& u, int wr, int wc, int fr, int fq) const { \
        _Pragma("unroll") for (int ai = 0; ai < 2; ++ai) _Pragma("unroll") for (int m = 0; m < 4; ++m) { \
            const int row = u.pm * 256 + ai * 128 + wr * 64 + m * 16 + fr; \
            _Pragma("unroll") for (int bj = 0; bj < 2; ++bj) store8(row, u.pn * 256 + bj * 128 + wc * 32 + 8 * fq, acc[ai][bj][m][0], acc[ai][bj][m][1]); } }
struct EpiIn {
    static constexpr bool PERM = true, AFTER_DRAIN = false;
    unsigned char* ws; float* out;
    __device__ __forceinline__ void store8(int row, int col, f32x4 v0, f32x4 v1) const {
        const int pn = col >> 8, seg = pn >> 1;
        bf16_t* bdst; int pitch, cl; float sc = 1.f; const bool sig = pn >= 12;
        if (!sig) { bdst = (bf16_t*)(ws + WS_QKV) + (size_t)seg * QKV_STRIDE; pitch = HW; cl = col & 511; if (seg == 0 || seg == 3) sc = QSCALE; }
        else { bdst = (bf16_t*)(ws + (pn < 16 ? WS_GA : WS_GB)); pitch = DM; cl = (col - 3072) & 1023; }
        if (sig) {
#pragma unroll
            for (int e = 0; e < 4; ++e) { v0[e] = sigmoidf_(v0[e]); v1[e] = sigmoidf_(v1[e]); }
        } else { v0 = v0 * sc; v1 = v1 * sc; }
        u32x4 w; w.x = pk2(v0[0], v0[1]); w.y = pk2(v0[2], v0[3]); w.z = pk2(v1[0], v1[1]); w.w = pk2(v1[2], v1[3]);
        *(u32x4*)(bdst + (size_t)row * pitch + cl) = w;
    }
    EPI_MAIN_CALL
};
struct EpiProjA {
    static constexpr bool PERM = true, AFTER_DRAIN = false;
    const bf16_t* G; bf16_t* T;
    __device__ __forceinline__ void store8(int row, int c, f32x4 v0, f32x4 v1) const {
        const u32x4 g = *(const u32x4*)(G + (size_t)row * DM + c);
        v0[0] *= bflo(g.x); v0[1] *= bfhi(g.x); v0[2] *= bflo(g.y); v0[3] *= bfhi(g.y);
        v1[0] *= bflo(g.z); v1[1] *= bfhi(g.z); v1[2] *= bflo(g.w); v1[3] *= bfhi(g.w);
        u32x4 w; w.x = pk2(v0[0], v0[1]); w.y = pk2(v0[2], v0[3]); w.z = pk2(v1[0], v1[1]); w.w = pk2(v1[2], v1[3]);
        *(u32x4*)(T + (size_t)row * DM + c) = w;
    }
    EPI_MAIN_CALL
};
struct EpiProjB {
    static constexpr bool PERM = true, AFTER_DRAIN = false;
    const bf16_t* G; const bf16_t* T; bf16_t* MG;
    __device__ __forceinline__ void store8(int row, int c, f32x4 v0, f32x4 v1) const {
        const u32x4 g = *(const u32x4*)(G + (size_t)row * DM + c);
        const u32x4 tw = *(const u32x4*)(T + (size_t)row * DM + c);
        const f32x4 t0 = {bflo(tw.x), bfhi(tw.x), bflo(tw.y), bfhi(tw.y)}, t1 = {bflo(tw.z), bfhi(tw.z), bflo(tw.w), bfhi(tw.w)};
        v0[0] = t0[0] + v0[0] * bflo(g.x); v0[1] = t0[1] + v0[1] * bfhi(g.x); v0[2] = t0[2] + v0[2] * bflo(g.y); v0[3] = t0[3] + v0[3] * bfhi(g.y);
        v1[0] = t1[0] + v1[0] * bflo(g.z); v1[1] = t1[1] + v1[1] * bfhi(g.z); v1[2] = t1[2] + v1[2] * bflo(g.w); v1[3] = t1[3] + v1[3] * bfhi(g.w);
        u32x4 w; w.x = pk2(v0[0], v0[1]); w.y = pk2(v0[2], v0[3]); w.z = pk2(v1[0], v1[1]); w.w = pk2(v1[2], v1[3]);
        *(u32x4*)(MG + (size_t)row * DM + c) = w;
    }
    EPI_MAIN_CALL
};
struct EpiF32 {
    static constexpr bool PERM = true, AFTER_DRAIN = false;
    bf16_t* T;
    __device__ __forceinline__ void store8(int row, int c, f32x4 v0, f32x4 v1) const {
        u32x4 w; w.x = pk2(v0[0], v0[1]); w.y = pk2(v0[2], v0[3]); w.z = pk2(v1[0], v1[1]); w.w = pk2(v1[2], v1[3]);
        *(u32x4*)(T + (size_t)row * DM + c) = w;
    }
    EPI_MAIN_CALL
};

__device__ __forceinline__ bf16x8 frag_perm(const u32x4 v, const int paddr) {
    u32x4 r; r.x = (unsigned)__builtin_amdgcn_ds_bpermute(paddr, (int)v.x); r.y = (unsigned)__builtin_amdgcn_ds_bpermute(paddr, (int)v.y);
    r.z = (unsigned)__builtin_amdgcn_ds_bpermute(paddr, (int)v.z); r.w = (unsigned)__builtin_amdgcn_ds_bpermute(paddr, (int)v.w);
    return __builtin_bit_cast(bf16x8, r);
}
template <class Epi>
__device__ __forceinline__ void small_gemm_range(LAS unsigned char* lds, const bf16_t* A, const bf16_t* Bt, const int K, const int ubeg, const int uend, const int ustride, const Epi& E, const int wv) {
    int lane_ = lane_id(); asm volatile("" : "+v"(lane_));
    const int lane = lane_, fr = lane & 15, fq = lane >> 4, tid = wv * 64 + lane;
    const int kw = K >> 3;
    LAS float* red = (LAS float*)lds;
    for (int u = ubeg; u < uend; u += ustride) {
        const int rc = u & 15, cc = u >> 4;
        const bf16_t* Ap = A + (size_t)(MP + rc * 64 + (lane >> 2)) * K + wv * kw + 8 * (lane & 3);
        const bf16_t* Bp = Bt + (size_t)(cc * 64 + (lane >> 2)) * K + wv * kw + 8 * (lane & 3);
        const int paddr = ((lane & 15) * 4 + (lane >> 4)) * 4;
        f32x4 acc[4][4];
#pragma unroll
        for (int m = 0; m < 4; ++m)
#pragma unroll
            for (int n = 0; n < 4; ++n) acc[m][n] = (f32x4){0.f, 0.f, 0.f, 0.f};
#pragma unroll 4
        for (int ks = 0; ks < kw; ks += 32) {
            u32x4 ar[4], br[4]; bf16x8 af[4], bfr[4];
#pragma unroll
            for (int m = 0; m < 4; ++m) { ar[m] = *(const u32x4*)(Ap + (size_t)(m * 16) * K + ks); br[m] = *(const u32x4*)(Bp + (size_t)(m * 16) * K + ks); }
#pragma unroll
            for (int m = 0; m < 4; ++m) { af[m] = frag_perm(ar[m], paddr); bfr[m] = frag_perm(br[m], paddr); }
#pragma unroll
            for (int m = 0; m < 4; ++m)
#pragma unroll
                for (int n = 0; n < 4; ++n) acc[m][n] = __builtin_amdgcn_mfma_f32_16x16x32_bf16(bfr[n], af[m], acc[m][n], 0, 0, 0);
        }
#pragma unroll
        for (int m = 0; m < 4; ++m)
#pragma unroll
            for (int n = 0; n < 4; ++n) *(LAS f32x4*)(red + (wv * 64 + 16 * m + fr) * 68 + 16 * n + 4 * fq) = acc[m][n];
        __syncthreads();
        const int r = tid >> 3, c8 = (tid & 7) * 8;
        f32x4 s0 = {0.f, 0.f, 0.f, 0.f}, s1 = {0.f, 0.f, 0.f, 0.f};
#pragma unroll
        for (int w = 0; w < 8; ++w) { s0 += *(const LAS f32x4*)(red + (w * 64 + r) * 68 + c8); s1 += *(const LAS f32x4*)(red + (w * 64 + r) * 68 + c8 + 4); }
        E.store8(MP + rc * 64 + r, cc * 64 + c8, s0, s1);
        __syncthreads();
    }
}
template <class Epi>
__device__ __forceinline__ void small_gemm(LAS unsigned char* lds, const bf16_t* A, const bf16_t* Bt, const int K, const int N, const Epi& E, const int wv) {
    small_gemm_range<Epi>(lds, A, Bt, K, (int)blockIdx.x, 16 * (N >> 6), (int)gridDim.x, E, wv);
}
struct TailStat { float* xs; unsigned* cnt; };
__device__ __forceinline__ float tail_row_stat(const TailStat& st, const float part8, const int rc, const int cc, const int r, const int tid) {
    float p = part8; p += __shfl_xor(p, 1); p += __shfl_xor(p, 2); p += __shfl_xor(p, 4);
    if ((tid & 7) == 0) __hip_atomic_store(st.xs + (size_t)(rc * 64 + r) * 16 + cc, p, __ATOMIC_RELAXED, __HIP_MEMORY_SCOPE_AGENT);
    asm volatile("s_waitcnt vmcnt(0)" ::: "memory"); __syncthreads();
    if (tid == 0) {
        __hip_atomic_fetch_add(st.cnt + 64 * rc, 1u, __ATOMIC_RELAXED, __HIP_MEMORY_SCOPE_AGENT);
        while (__hip_atomic_load(st.cnt + 64 * rc, __ATOMIC_RELAXED, __HIP_MEMORY_SCOPE_AGENT) < 16u) __builtin_amdgcn_s_sleep(1);
        __builtin_amdgcn_fence(__ATOMIC_ACQUIRE, "agent");
    }
    __syncthreads();
    float q = 0.f;
#pragma unroll
    for (int j = 0; j < 16; ++j) q += __hip_atomic_load(st.xs + (size_t)(rc * 64 + r) * 16 + j, __ATOMIC_RELAXED, __HIP_MEMORY_SCOPE_AGENT);
    return 1.0f / sqrtf(q * (1.0f / DM) + EPS);
}
template <int MODE>
__device__ __forceinline__ void small_gemm_norm(LAS unsigned char* lds, const bf16_t* A, const bf16_t* Bt, const int K, const float* xin, float* y, float* RS2, bf16_t* H, const float* ga,
                                                const TailStat st1, const TailStat st2, const int wv) {
    int lane_ = lane_id(); asm volatile("" : "+v"(lane_));
    const int lane = lane_, fr = lane & 15, fq = lane >> 4, tid = wv * 64 + lane;
    const int kw = K >> 3, u = blockIdx.x, rc = u & 15, cc = u >> 4;
    LAS float* red = (LAS float*)lds;
    const bf16_t* Ap = A + (size_t)(MP + rc * 64 + (lane >> 2)) * K + wv * kw + 8 * (lane & 3);
    const bf16_t* Bp = Bt + (size_t)(cc * 64 + (lane >> 2)) * K + wv * kw + 8 * (lane & 3);
    const int paddr = ((lane & 15) * 4 + (lane >> 4)) * 4;
    f32x4 acc[4][4];
#pragma unroll
    for (int m = 0; m < 4; ++m)
#pragma unroll
        for (int n = 0; n < 4; ++n) acc[m][n] = (f32x4){0.f, 0.f, 0.f, 0.f};
#pragma unroll 4
    for (int ks = 0; ks < kw; ks += 32) {
        u32x4 ar[4], br[4]; bf16x8 af[4], bfr[4];
#pragma unroll
        for (int m = 0; m < 4; ++m) { ar[m] = *(const u32x4*)(Ap + (size_t)(m * 16) * K + ks); br[m] = *(const u32x4*)(Bp + (size_t)(m * 16) * K + ks); }
#pragma unroll
        for (int m = 0; m < 4; ++m) { af[m] = frag_perm(ar[m], paddr); bfr[m] = frag_perm(br[m], paddr); }
#pragma unroll
        for (int m = 0; m < 4; ++m)
#pragma unroll
            for (int n = 0; n < 4; ++n) acc[m][n] = __builtin_amdgcn_mfma_f32_16x16x32_bf16(bfr[n], af[m], acc[m][n], 0, 0, 0);
    }
#pragma unroll
    for (int m = 0; m < 4; ++m)
#pragma unroll
        for (int n = 0; n < 4; ++n) *(LAS f32x4*)(red + (wv * 64 + 16 * m + fr) * 68 + 16 * n + 4 * fq) = acc[m][n];
    __syncthreads();
    const int r = tid >> 3, c8 = (tid & 7) * 8;
    f32x4 s0 = {0.f, 0.f, 0.f, 0.f}, s1 = {0.f, 0.f, 0.f, 0.f};
#pragma unroll
    for (int w = 0; w < 8; ++w) { s0 += *(const LAS f32x4*)(red + (w * 64 + r) * 68 + c8); s1 += *(const LAS f32x4*)(red + (w * 64 + r) * 68 + c8 + 4); }
    const int row = rc * 64 + r, col = cc * 64 + c8;
    const float rs1 = tail_row_stat(st1, (s0[0] * s0[0] + s0[1] * s0[1]) + (s0[2] * s0[2] + s0[3] * s0[3]) + (s1[0] * s1[0] + s1[1] * s1[1]) + (s1[2] * s1[2] + s1[3] * s1[3]), rc, cc, r, tid);
    const f32x4 ga0 = *(const f32x4*)(ga + col), ga1 = *(const f32x4*)(ga + col + 4);
    float* yp = y + (size_t)(MP + row) * DM + col;
    if (MODE == 1) {
        const u32x4 xw = *(const u32x4*)(H + (size_t)(MP + row) * DM + col); const float ir2 = 1.0f / RS2[MP + row];
        const f32x4 y0 = (f32x4){bflo(xw.x), bfhi(xw.x), bflo(xw.y), bfhi(xw.y)} * ir2, y1 = (f32x4){bflo(xw.z), bfhi(xw.z), bflo(xw.w), bfhi(xw.w)} * ir2;
        *(f32x4*)yp = y0 + s0 * rs1 * ga0; *(f32x4*)(yp + 4) = y1 + s1 * rs1 * ga1;
    } else {
        const float* xp = xin + (size_t)row * DM + col;
        const f32x4 x0 = *(const f32x4*)xp + s0 * rs1 * ga0, x1 = *(const f32x4*)(xp + 4) + s1 * rs1 * ga1;
        const float rs2 = tail_row_stat(st2, (x0[0] * x0[0] + x0[1] * x0[1]) + (x0[2] * x0[2] + x0[3] * x0[3]) + (x1[0] * x1[0] + x1[1] * x1[1]) + (x1[2] * x1[2] + x1[3] * x1[3]), rc, cc, r, tid);
        if (cc == 0 && (tid & 7) == 0) RS2[MP + row] = rs2;
        const f32x4 h0 = x0 * rs2, h1 = x1 * rs2;
        u32x4 w; w.x = pk2(h0[0], h0[1]); w.y = pk2(h0[2], h0[3]); w.z = pk2(h1[0], h1[1]); w.w = pk2(h1[2], h1[3]);
        *(u32x4*)(H + (size_t)(MP + row) * DM + col) = w;
    }
    __syncthreads();
}
template <class Epi>
__device__ __forceinline__ void small_gemm_a4(LAS unsigned char* lds, const bf16_t* A, const bf16_t* Bt, const int N, const Epi& E, const int wv) {
    constexpr int K = 1024, kw = 128;
    int lane_ = lane_id(); asm volatile("" : "+v"(lane_));
    const int lane = lane_, fr = lane & 15, fq = lane >> 4, tid = wv * 64 + lane;
    const int nunits = 16 * (N >> 6), G = gridDim.x;
    LAS float* red = (LAS float*)lds;
    const int lrow = lane >> 2, lch = 8 * (lane & 3), paddr = ((lane & 15) * 4 + (lane >> 4)) * 4;
    const int rc = blockIdx.x & 15;
    bf16x8 pa[4][4];
    {   const bf16_t* Ap = A + (size_t)(MP + rc * 64 + lrow) * K + wv * kw + lch;
        u32x4 ar[4][4];
#pragma unroll
        for (int ks = 0; ks < 4; ++ks)
#pragma unroll
            for (int m = 0; m < 4; ++m) ar[ks][m] = *(const u32x4*)(Ap + (size_t)(m * 16) * K + ks * 32);
#pragma unroll
        for (int ks = 0; ks < 4; ++ks)
#pragma unroll
            for (int m = 0; m < 4; ++m) pa[ks][m] = frag_perm(ar[ks][m], paddr); }
    u32x4 br[4][4];
    if ((int)blockIdx.x < nunits) { const bf16_t* Bp = Bt + (size_t)((blockIdx.x >> 4) * 64 + lrow) * K + wv * kw + lch;
#pragma unroll
        for (int ks = 0; ks < 4; ++ks)
#pragma unroll
            for (int n = 0; n < 4; ++n) br[ks][n] = *(const u32x4*)(Bp + (size_t)(n * 16) * K + ks * 32); }
    for (int u = blockIdx.x; u < nunits; u += G) {
        const int cc = u >> 4;
        f32x4 acc[4][4];
#pragma unroll
        for (int m = 0; m < 4; ++m)
#pragma unroll
            for (int n = 0; n < 4; ++n) acc[m][n] = (f32x4){0.f, 0.f, 0.f, 0.f};
#pragma unroll
        for (int ks = 0; ks < 4; ++ks) {
            bf16x8 pb[4];
#pragma unroll
            for (int n = 0; n < 4; ++n) pb[n] = frag_perm(br[ks][n], paddr);
#pragma unroll
            for (int m = 0; m < 4; ++m)
#pragma unroll
                for (int n = 0; n < 4; ++n) acc[m][n] = __builtin_amdgcn_mfma_f32_16x16x32_bf16(pb[n], pa[ks][m], acc[m][n], 0, 0, 0);
        }
        { const int un = u + G < nunits ? u + G : u;
          const bf16_t* Bp = Bt + (size_t)((un >> 4) * 64 + lrow) * K + wv * kw + lch;
#pragma unroll
          for (int ks = 0; ks < 4; ++ks)
#pragma unroll
              for (int n = 0; n < 4; ++n) br[ks][n] = *(const u32x4*)(Bp + (size_t)(n * 16) * K + ks * 32); }
#pragma unroll
        for (int m = 0; m < 4; ++m)
#pragma unroll
            for (int n = 0; n < 4; ++n) *(LAS f32x4*)(red + (wv * 64 + 16 * m + fr) * 68 + 16 * n + 4 * fq) = acc[m][n];
        lds_barrier();
        const int r = tid >> 3, c8 = (tid & 7) * 8;
        f32x4 s0 = {0.f, 0.f, 0.f, 0.f}, s1 = {0.f, 0.f, 0.f, 0.f};
#pragma unroll
        for (int w = 0; w < 8; ++w) { s0 += *(const LAS f32x4*)(red + (w * 64 + r) * 68 + c8); s1 += *(const LAS f32x4*)(red + (w * 64 + r) * 68 + c8 + 4); }
        E.store8(MP + rc * 64 + r, cc * 64 + c8, s0, s1);
        lds_barrier();
    }
}
template <class Epi>
__device__ __forceinline__ void small_gemm_k1024(LAS unsigned char* lds, const bf16_t* A, const bf16_t* Bt, const int N, const Epi& E, const int wv) {
    constexpr int K = 1024, kw = 128;
    const int lane = lane_id(), fr = lane & 15, fq = lane >> 4, tid = wv * 64 + lane;
    const int nunits = 16 * (N >> 6), G = gridDim.x;
    LAS float* red = (LAS float*)lds;
    int u = blockIdx.x;
    if (u >= nunits) return;
    u32x4 fa[4][4], fb[4][4];
    const int lrow = lane >> 2, lch = 8 * (lane & 3), paddr = ((lane & 15) * 4 + (lane >> 4)) * 4;
    {   const bf16_t* Ap = A + (size_t)(MP + (u & 15) * 64 + lrow) * K + wv * kw + lch; const bf16_t* Bp = Bt + (size_t)((u >> 4) * 64 + lrow) * K + wv * kw + lch;
#pragma unroll
        for (int ks = 0; ks < 4; ++ks)
#pragma unroll
            for (int m = 0; m < 4; ++m) { fa[ks][m] = *(const u32x4*)(Ap + (size_t)(m * 16) * K + ks * 32); fb[ks][m] = *(const u32x4*)(Bp + (size_t)(m * 16) * K + ks * 32); } }
    for (; u < nunits; u += G) {
        const int rc = u & 15, cc = u >> 4, nu = u + G; const bool has_next = nu < nunits;
        const bf16_t* Ap = A + (size_t)(MP + (nu & 15) * 64 + lrow) * K + wv * kw + lch; const bf16_t* Bp = Bt + (size_t)((nu >> 4) * 64 + lrow) * K + wv * kw + lch;
        f32x4 acc[4][4];
#pragma unroll
        for (int m = 0; m < 4; ++m)
#pragma unroll
            for (int n = 0; n < 4; ++n) acc[m][n] = (f32x4){0.f, 0.f, 0.f, 0.f};
#pragma unroll
        for (int ks = 0; ks < 4; ++ks) {
            bf16x8 pa[4], pb[4];
#pragma unroll
            for (int m = 0; m < 4; ++m) { pa[m] = frag_perm(fa[ks][m], paddr); pb[m] = frag_perm(fb[ks][m], paddr); }
            if (has_next) {
#pragma unroll
                for (int m = 0; m < 4; ++m) { fa[ks][m] = *(const u32x4*)(Ap + (size_t)(m * 16) * K + ks * 32); fb[ks][m] = *(const u32x4*)(Bp + (size_t)(m * 16) * K + ks * 32); }
            }
#pragma unroll
            for (int m = 0; m < 4; ++m)
#pragma unroll
                for (int n = 0; n < 4; ++n) acc[m][n] = __builtin_amdgcn_mfma_f32_16x16x32_bf16(pb[n], pa[m], acc[m][n], 0, 0, 0);
        }
#pragma unroll
        for (int m = 0; m < 4; ++m)
#pragma unroll
            for (int n = 0; n < 4; ++n) *(LAS f32x4*)(red + (wv * 64 + 16 * m + fr) * 68 + 16 * n + 4 * fq) = acc[m][n];
        __syncthreads();
        const int r = tid >> 3, c8 = (tid & 7) * 8;
        f32x4 s0 = {0.f, 0.f, 0.f, 0.f}, s1 = {0.f, 0.f, 0.f, 0.f};
#pragma unroll
        for (int w = 0; w < 8; ++w) { s0 += *(const LAS f32x4*)(red + (w * 64 + r) * 68 + c8); s1 += *(const LAS f32x4*)(red + (w * 64 + r) * 68 + c8 + 4); }
        E.store8(MP + rc * 64 + r, cc * 64 + c8, s0, s1);
        __syncthreads();
    }
}
template <int CTRL> __device__ __forceinline__ float dppf(float old, float src) {
    return __builtin_bit_cast(float, __builtin_amdgcn_update_dpp(__builtin_bit_cast(int, old), __builtin_bit_cast(int, src), CTRL, 0xf, 0xf, false));
}
__device__ __forceinline__ float gelu_tanh(float x) {
    const float u = 1.5957691216057308f * (x + 0.044715f * x * x * x);
    return x * __builtin_amdgcn_rcpf(1.0f + __builtin_amdgcn_exp2f(-u * LOG2E));
}
struct EpiUpFused {
    static constexpr bool PERM = true, AFTER_DRAIN = false;
    bf16_t* A2; float* out; const float* cw; const float* cb; const float* st; float* head; float* tail; LAS float* halo;
    __device__ __forceinline__ void operator()(const f32x4 (&acc)[2][2][4][2], const Unit& u, int wr, int wc, int fr, int fq) const {
        const int pm = u.pm, gt = u.pn; const bool samp = pm >= 64;
        const int colq = wc * 32 + 8 * fq, oc = gt * 128 + colq;
#pragma unroll
        for (int ai = 0; ai < 2; ++ai) {
            const int g = ai * 2 + wr;
            if (fr >= 14) {
                const int r = fr - 14;
                float* cdst = nullptr;
                if (samp) cdst = out + O_CV_S + ((size_t)((pm - 64) * 4 + g) * 2 + r) * NUP;
                else if (g == 3) cdst = ((pm & 7) == 7) ? out + O_CV_P + ((size_t)(pm >> 3) * 2 + r) * NUP : tail + ((size_t)pm * 2 + r) * NUP;
#pragma unroll
                for (int bj = 0; bj < 2; ++bj) {
                    const f32x4 v0 = acc[ai][bj][3][0], v1 = acc[ai][bj][3][1];
                    LAS float* hp = halo + ((g * 2 + r) * 2 + bj) * 128 + colq;
                    *(LAS f32x4*)hp = v0; *(LAS f32x4*)(hp + 4) = v1;
                    if (cdst) { *(f32x4*)(cdst + bj * DFF + oc) = v0; *(f32x4*)(cdst + bj * DFF + oc + 4) = v1; }
                }
            }
        }
        const bool defer = !samp && (pm & 7) != 0;
        if (defer && wr == 0 && fr < 2) {
            float* hd = head + ((size_t)pm * 2 + fr) * NUP;
#pragma unroll
            for (int bj = 0; bj < 2; ++bj) { *(f32x4*)(hd + bj * DFF + oc) = acc[0][bj][0][0]; *(f32x4*)(hd + bj * DFF + oc + 4) = acc[0][bj][0][1]; }
        }
        f32x4 wg[3], wq[3], bg, bq;
#pragma unroll
        for (int k = 0; k < 3; ++k) { wg[k] = *(const f32x4*)(cw + (size_t)k * NUP + oc); wq[k] = *(const f32x4*)(cw + (size_t)k * NUP + DFF + oc); }
        bg = *(const f32x4*)(cb + oc); bq = *(const f32x4*)(cb + DFF + oc);
        asm volatile("s_waitcnt lgkmcnt(0)" ::: "memory"); __builtin_amdgcn_s_barrier(); asm volatile("" ::: "memory");
        u32x2 keep[2][4];
#pragma unroll
        for (int n = 0; n < 2; ++n) {
            if (n == 1) {
#pragma unroll
                for (int k = 0; k < 3; ++k) { wg[k] = *(const f32x4*)(cw + (size_t)k * NUP + oc + 4); wq[k] = *(const f32x4*)(cw + (size_t)k * NUP + DFF + oc + 4); }
                bg = *(const f32x4*)(cb + oc + 4); bq = *(const f32x4*)(cb + DFF + oc + 4);
            }
#pragma unroll
            for (int ai = 0; ai < 2; ++ai) {
                const int g = ai * 2 + wr;
                f32x4 xm1[2];
                xm1[0] = (f32x4){0.f, 0.f, 0.f, 0.f}; xm1[1] = (f32x4){0.f, 0.f, 0.f, 0.f};
                if (fr >= 14) {
                    const int r = fr - 14;
                    if (samp) { const float* sp = st + ((size_t)((pm - 64) * 4 + g) * 2 + r) * NUP; xm1[0] = *(const f32x4*)(sp + oc + 4 * n); xm1[1] = *(const f32x4*)(sp + DFF + oc + 4 * n); }
                    else if (g > 0) { const LAS float* hp = halo + (((g - 1) * 2 + r) * 2) * 128 + colq + 4 * n; xm1[0] = *(const LAS f32x4*)hp; xm1[1] = *(const LAS f32x4*)(hp + 128); }
                }
#pragma unroll
                for (int m = 0; m < 4; ++m) {
                    const size_t row = (size_t)pm * 256 + g * 64 + m * 16 + fr;
                    float res[4];
#pragma unroll
                    for (int e = 0; e < 4; ++e) {
                        const float xg = acc[ai][0][m][n][e], xgp = (m == 0) ? xm1[0][e] : acc[ai][0][m > 0 ? m - 1 : 0][n][e];
                        const float xv = acc[ai][1][m][n][e], xvp = (m == 0) ? xm1[1][e] : acc[ai][1][m > 0 ? m - 1 : 0][n][e];
                        const float g1 = dppf<0x111>(dppf<0x121>(0.f, xgp), xg), g2 = dppf<0x112>(dppf<0x122>(0.f, xgp), xg);
                        const float v1 = dppf<0x111>(dppf<0x121>(0.f, xvp), xv), v2 = dppf<0x112>(dppf<0x122>(0.f, xvp), xv);
                        const float yg = bg[e] + wg[0][e] * g2 + wg[1][e] * g1 + wg[2][e] * xg;
                        const float yv = bq[e] + wq[0][e] * v2 + wq[1][e] * v1 + wq[2][e] * xv;
                        res[e] = gelu_tanh(yg) * yv;
                    }
                    u32x2 w; w.x = pk2(res[0], res[1]); w.y = pk2(res[2], res[3]);
                    if (n == 0) keep[ai][m] = w;
                    else if (!(defer && g == 0 && m == 0 && fr < 2)) { u32x4 ww; ww.x = keep[ai][m].x; ww.y = keep[ai][m].y; ww.z = w.x; ww.w = w.y; *(u32x4*)(A2 + row * DFF + oc) = ww; }
                    asm volatile("" ::: "memory");
                }
            }
        }
    }
};
__device__ __forceinline__ void ffn_fixup(const Args& a, const int pm, const int tid) {
    if (pm >= 64 || (pm & 7) == 0) return;
    const float* head = (const float*)(a.ws + WS_HEAD) + (size_t)pm * 2 * NUP; const float* tail = (const float*)(a.ws + WS_TAIL) + (size_t)(pm - 1) * 2 * NUP;
    const float* cw = a.in[I_CW]; const float* cb = a.in[I_CB]; bf16_t* A2 = (bf16_t*)(a.ws + WS_A2);
    for (int it = tid; it < 704; it += 512) {
        const int r = it >= 352 ? 1 : 0, oc = (it - r * 352) * 8;
        const float* x0 = r == 0 ? tail : tail + NUP; const float* x1 = r == 0 ? tail + NUP : head; const float* x2 = r == 0 ? head : head + NUP;
        float y[2][8];
#pragma unroll
        for (int hh = 0; hh < 2; ++hh) { const int c = hh * DFF + oc;
#pragma unroll
            for (int q = 0; q < 2; ++q) {
                const f32x4 bb = *(const f32x4*)(cb + c + 4 * q), w0 = *(const f32x4*)(cw + c + 4 * q), w1 = *(const f32x4*)(cw + NUP + c + 4 * q), w2 = *(const f32x4*)(cw + 2 * NUP + c + 4 * q);
                const f32x4 a0 = *(const f32x4*)(x0 + c + 4 * q), a1 = *(const f32x4*)(x1 + c + 4 * q), a2 = *(const f32x4*)(x2 + c + 4 * q);
#pragma unroll
                for (int e = 0; e < 4; ++e) y[hh][4 * q + e] = bb[e] + w0[e] * a0[e] + w1[e] * a1[e] + w2[e] * a2[e];
            } }
        float res[8];
#pragma unroll
        for (int e = 0; e < 8; ++e) res[e] = gelu_tanh(y[0][e]) * y[1][e];
        u32x4 w; w.x = pk2(res[0], res[1]); w.y = pk2(res[2], res[3]); w.z = pk2(res[4], res[5]); w.w = pk2(res[6], res[7]);
        *(u32x4*)(A2 + ((size_t)pm * 256 + r) * DFF + oc) = w;
    }
}

struct RowStat {
    float* xbuf; unsigned* cnt;
    __device__ __forceinline__ void run(const f32x4 (&v)[2][2][4][2], const Unit& u, int wr, int wc, int fr, int fq, LAS unsigned char* lds, int wid, int lane) const {
        LAS float* P = (LAS float*)lds; LAS float* S = (LAS float*)(lds + 4096);
#pragma unroll
        for (int ai = 0; ai < 2; ++ai)
#pragma unroll
            for (int m = 0; m < 4; ++m) { float s = 0.f;
#pragma unroll
                for (int bj = 0; bj < 2; ++bj)
#pragma unroll
                    for (int n = 0; n < 2; ++n) { const f32x4 x = v[ai][bj][m][n]; s += (x[0] * x[0] + x[1] * x[1]) + (x[2] * x[2] + x[3] * x[3]); }
                s += __shfl_xor(s, 16); s += __shfl_xor(s, 32);
                if (fq == 0) P[(ai * 128 + wr * 64 + m * 16 + fr) * 4 + wc] = s; }
        asm volatile("s_waitcnt lgkmcnt(0)" ::: "memory"); __builtin_amdgcn_s_barrier(); asm volatile("" ::: "memory");
        const int tid = wid * 64 + lane;
        if (tid < 256) { const f32x4 p = *(const LAS f32x4*)(P + tid * 4);
            __hip_atomic_store(xbuf + ((size_t)u.pm * 256 + tid) * 4 + u.pn, (p[0] + p[1]) + (p[2] + p[3]), __ATOMIC_RELAXED, __HIP_MEMORY_SCOPE_AGENT); }
        asm volatile("s_waitcnt vmcnt(0)" ::: "memory"); __builtin_amdgcn_s_barrier(); asm volatile("" ::: "memory");
        if (tid == 0) {
            __hip_atomic_fetch_add(cnt + 64 * u.pm, 1u, __ATOMIC_RELAXED, __HIP_MEMORY_SCOPE_AGENT);
            while (__hip_atomic_load(cnt + 64 * u.pm, __ATOMIC_RELAXED, __HIP_MEMORY_SCOPE_AGENT) < 4u) __builtin_amdgcn_s_sleep(1);
            __builtin_amdgcn_fence(__ATOMIC_ACQUIRE, "agent");
        }
        asm volatile("s_waitcnt vmcnt(0) lgkmcnt(0)" ::: "memory"); __builtin_amdgcn_s_barrier(); asm volatile("" ::: "memory");
        if (tid < 256) { const float* slot = xbuf + ((size_t)u.pm * 256 + tid) * 4; float q = 0.f;
#pragma unroll
            for (int t = 0; t < 4; ++t) q += __hip_atomic_load(slot + t, __ATOMIC_RELAXED, __HIP_MEMORY_SCOPE_AGENT);
            S[tid] = 1.0f / sqrtf(q * (1.0f / DM) + EPS); }
        asm volatile("s_waitcnt vmcnt(0) lgkmcnt(0)" ::: "memory"); __builtin_amdgcn_s_barrier(); asm volatile("" ::: "memory");
    }
};
struct EpiOutNorm {
    static constexpr bool PERM = true, AFTER_DRAIN = true;
    const float* x; float* RS2; bf16_t* H; const float* g2; RowStat st1, st2;
    __device__ __forceinline__ void fused(f32x4 (&acc)[2][2][4][2], const Unit& u, int wr, int wc, int fr, int fq, LAS unsigned char* lds, int wid, int lane) const {
        st1.run(acc, u, wr, wc, fr, fq, lds, wid, lane);
        const LAS float* S = (const LAS float*)(lds + 4096);
        const int c0 = u.pn * 256 + wc * 32 + 8 * fq;
#pragma unroll
        for (int ai = 0; ai < 2; ++ai)
#pragma unroll
            for (int m = 0; m < 4; ++m) { const int rl = ai * 128 + wr * 64 + m * 16 + fr; const size_t row = (size_t)u.pm * 256 + rl; const float rs = S[rl];
#pragma unroll
                for (int bj = 0; bj < 2; ++bj) { const int c = c0 + bj * 128;
                    const f32x4 xa = *(const f32x4*)(x + row * DM + c) + acc[ai][bj][m][0] * rs * *(const f32x4*)(g2 + c);
                    const f32x4 xb = *(const f32x4*)(x + row * DM + c + 4) + acc[ai][bj][m][1] * rs * *(const f32x4*)(g2 + c + 4);
                    acc[ai][bj][m][0] = xa; acc[ai][bj][m][1] = xb; }
                asm volatile("" : "+v"(acc[ai][0][m][0]), "+v"(acc[ai][0][m][1]), "+v"(acc[ai][1][m][0]), "+v"(acc[ai][1][m][1]));
                asm volatile("" ::: "memory"); }
        st2.run(acc, u, wr, wc, fr, fq, lds, wid, lane);
#pragma unroll
        for (int ai = 0; ai < 2; ++ai)
#pragma unroll
            for (int m = 0; m < 4; ++m) { const int rl = ai * 128 + wr * 64 + m * 16 + fr; const size_t row = (size_t)u.pm * 256 + rl; const float rs = S[rl];
                if (u.pn == 0 && wc == 0 && fq == 0) RS2[row] = rs;
#pragma unroll
                for (int bj = 0; bj < 2; ++bj) { const int c = c0 + bj * 128;
                    const f32x4 v0 = acc[ai][bj][m][0] * rs, v1 = acc[ai][bj][m][1] * rs;
                    u32x4 w; w.x = pk2(v0[0], v0[1]); w.y = pk2(v0[2], v0[3]); w.z = pk2(v1[0], v1[1]); w.w = pk2(v1[2], v1[3]);
                    *(u32x4*)(H + row * DM + c) = w; } }
    }
};
struct EpiDownNorm {
    static constexpr bool PERM = true, AFTER_DRAIN = true;
    const bf16_t* H; const float* RS2; float* y; const float* g4; RowStat st;
    __device__ __forceinline__ void fused(f32x4 (&acc)[2][2][4][2], const Unit& u, int wr, int wc, int fr, int fq, LAS unsigned char* lds, int wid, int lane) const {
        st.run(acc, u, wr, wc, fr, fq, lds, wid, lane);
        const LAS float* S = (const LAS float*)(lds + 4096);
        const int c0 = u.pn * 256 + wc * 32 + 8 * fq;
#pragma unroll
        for (int ai = 0; ai < 2; ++ai)
#pragma unroll
            for (int m = 0; m < 4; ++m) { const int rl = ai * 128 + wr * 64 + m * 16 + fr; const size_t row = (size_t)u.pm * 256 + rl; const float rs = S[rl]; const float ir2 = 1.0f / RS2[row];
#pragma unroll
                for (int bj = 0; bj < 2; ++bj) { const int c = c0 + bj * 128;
                    const u32x4 xw = *(const u32x4*)(H + row * DM + c);
                    const f32x4 xa = (f32x4){bflo(xw.x), bfhi(xw.x), bflo(xw.y), bfhi(xw.y)} * ir2, xb = (f32x4){bflo(xw.z), bfhi(xw.z), bflo(xw.w), bfhi(xw.w)} * ir2;
                    *(f32x4*)(y + row * DM + c) = xa + acc[ai][bj][m][0] * rs * *(const f32x4*)(g4 + c);
                    *(f32x4*)(y + row * DM + c + 4) = xb + acc[ai][bj][m][1] * rs * *(const f32x4*)(g4 + c + 4); }
                asm volatile("" ::: "memory"); }
    }
};

__device__ __forceinline__ void p0_transpose_item(const float* W, int N, int K, bf16_t* WT, int k0, int src_n0, int dst_n0, LAS float* scr, int lane, const float* kscale = nullptr) {
    float tv[32];
#pragma unroll
    for (int i = 0; i < 32; ++i) tv[i] = W[(size_t)(k0 + 2 * i + (lane >> 5)) * N + src_n0 + (lane & 31)];
    if (kscale) {
#pragma unroll
        for (int i = 0; i < 32; ++i) tv[i] *= kscale[k0 + 2 * i + (lane >> 5)];
    }
#pragma unroll
    for (int i = 0; i < 32; ++i) scr[(2 * i + (lane >> 5)) * 33 + (lane & 31)] = tv[i];
    asm volatile("s_waitcnt lgkmcnt(0)" ::: "memory");
    const int c = lane & 7;
#pragma unroll
    for (int j = 0; j < 4; ++j) { const int n = (lane >> 3) + 8 * j; const LAS float* s = scr + (8 * c) * 33 + n;
        u32x4 o; o.x = pk2(s[0 * 33], s[1 * 33]); o.y = pk2(s[2 * 33], s[3 * 33]); o.z = pk2(s[4 * 33], s[5 * 33]); o.w = pk2(s[6 * 33], s[7 * 33]);
        *(u32x4*)(WT + (size_t)(dst_n0 + n) * K + k0 + 8 * c) = o; }
    asm volatile("s_waitcnt lgkmcnt(0)" ::: "memory");
}

constexpr int TI_IN = 16 * 160, TI_PA = 8 * 32, TI_PB = 8 * 32, TI_OUT = 16 * 32, TI_UP = 16 * 176, TI_DN = 44 * 32;
constexpr int TI_ALL = TI_IN + TI_PA + TI_PB + TI_OUT + TI_UP + TI_DN;
__device__ __forceinline__ void transpose_item(const Args& a, const int it, LAS float* scr, const int lane) {
    unsigned char* ws = a.ws; int r = it;
    if (r < TI_IN) { const int kb = r / 160, nb = r % 160, d0 = nb * 32; p0_transpose_item(a.in[I_WIN], 5128, DM, (bf16_t*)(ws + WS_WIN), kb * 64, d0 + (d0 >= 3072 ? 8 : 0), d0, scr, lane); return; } r -= TI_IN;
    if (r < TI_PA) { const int kb = r / 32, nb = r % 32; p0_transpose_item(a.in[I_WPA], DM, HW, (bf16_t*)(ws + WS_WPA), kb * 64, nb * 32, nb * 32, scr, lane); return; } r -= TI_PA;
    if (r < TI_PB) { const int kb = r / 32, nb = r % 32; p0_transpose_item(a.in[I_WPB], DM, HW, (bf16_t*)(ws + WS_WPB), kb * 64, nb * 32, nb * 32, scr, lane); return; } r -= TI_PB;
    if (r < TI_OUT) { const int kb = r / 32, nb = r % 32; p0_transpose_item(a.in[I_WOUT], DM, DM, (bf16_t*)(ws + WS_WOUT), kb * 64, nb * 32, nb * 32, scr, lane); return; } r -= TI_OUT;
    if (r < TI_UP) { const int kb = r / 176, nb = r % 176, d0 = nb * 32, tile = d0 >> 8, w = d0 & 255; const int s0 = (w < 128) ? tile * 128 + w : DFF + tile * 128 + (w - 128);
        p0_transpose_item(a.in[I_WUP], NUP, DM, (bf16_t*)(ws + WS_WUP), kb * 64, s0, d0, scr, lane, a.in[I_G3]); return; } r -= TI_UP;
    { const int kb = r / 32, nb = r % 32; p0_transpose_item(a.in[I_WDN], DM, DFF, (bf16_t*)(ws + WS_WDN), kb * 64, nb * 32, nb * 32, scr, lane); }
}
__device__ __forceinline__ void phase_prologue(const Args& a, LAS unsigned char* lds, const int wv) {
    const int lane = lane_id(), wave = wv, tid = wv * 64 + lane;
    const int G = gridDim.x, gw = blockIdx.x * 8 + wave, NGW = G * 8;
    unsigned char* ws = a.ws;
    LAS float* scr = (LAS float*)(lds + wave * 8448);
    LAS float* wfg = (LAS float*)(lds + 69632);
    {
        const float* win = a.in[I_WIN]; const float* g1 = a.in[I_G1];
        for (int k = tid; k < DM; k += 512) {
            const f32x4 w0 = *(const f32x4*)(win + (size_t)k * 5128 + 3072), w1 = *(const f32x4*)(win + (size_t)k * 5128 + 3076); const float g = g1[k];
            wfg[0 * DM + k] = w0[0] * g; wfg[1 * DM + k] = w0[1] * g; wfg[2 * DM + k] = w0[2] * g; wfg[3 * DM + k] = w0[3] * g;
            wfg[4 * DM + k] = w1[0] * g; wfg[5 * DM + k] = w1[1] * g; wfg[6 * DM + k] = w1[2] * g; wfg[7 * DM + k] = w1[3] * g;
        }
    }
    __syncthreads();
    for (int it = gw; it < TI_IN; it += NGW) transpose_item(a, it, scr, lane);
    const float* g1 = a.in[I_G1]; const float* bfp = a.in[I_BF];
    f32x4 gv[4];
#pragma unroll
    for (int j = 0; j < 4; ++j) gv[j] = *(const f32x4*)(g1 + 4 * lane + 256 * j);
    bf16_t* H = (bf16_t*)(ws + WS_H);
    constexpr int RB = 4;
    for (int mb = (NGW - 1 - gw) * RB; mb < MTOK; mb += NGW * RB) {
        f32x4 v[RB][4]; float ss[RB], z[RB][8];
#pragma unroll
        for (int i = 0; i < RB; ++i) { const float* xr = xrow_ptr(a, mb + i);
#pragma unroll
            for (int j = 0; j < 4; ++j) v[i][j] = *(const f32x4*)(xr + 4 * lane + 256 * j); }
#pragma unroll
        for (int i = 0; i < RB; ++i) { ss[i] = 0.f;
#pragma unroll
            for (int j = 0; j < 4; ++j) ss[i] += (v[i][j][0] * v[i][j][0] + v[i][j][1] * v[i][j][1]) + (v[i][j][2] * v[i][j][2] + v[i][j][3] * v[i][j][3]); }
#pragma unroll
        for (int q = 0; q < 8; ++q) {
            f32x4 w[4];
#pragma unroll
            for (int j = 0; j < 4; ++j) w[j] = *(const LAS f32x4*)(wfg + q * DM + 4 * lane + 256 * j);
#pragma unroll
            for (int i = 0; i < RB; ++i) { float s = 0.f;
#pragma unroll
                for (int j = 0; j < 4; ++j) s += (v[i][j][0] * w[j][0] + v[i][j][1] * w[j][1]) + (v[i][j][2] * w[j][2] + v[i][j][3] * w[j][3]);
                z[i][q] = s; }
        }
#pragma unroll
        for (int i = 0; i < RB; ++i) {
            const int m = mb + i;
            const float sst = wave_sum(ss[i]);
#pragma unroll
            for (int q = 0; q < 8; ++q) z[i][q] = wave_sum(z[i][q]);
            const float rs = 1.0f / sqrtf(sst * (1.0f / DM) + EPS);
#pragma unroll
            for (int j = 0; j < 4; ++j) {
                u32x2 o; o.x = pk2(v[i][j][0] * rs * gv[j][0], v[i][j][1] * rs * gv[j][1]); o.y = pk2(v[i][j][2] * rs * gv[j][2], v[i][j][3] * rs * gv[j][3]);
                *(u32x2*)(H + (size_t)m * DM + 4 * lane + 256 * j) = o;
            }
            float zz = z[i][0];
#pragma unroll
            for (int q = 1; q < 8; ++q) zz = (lane == q) ? z[i][q] : zz;
            if (lane < 8) {
                const float t = zz * rs + bfp[lane];
                const float lf = fminf(t, 0.f) - log1pf(expf(-fabsf(t)));
                float* dst = m < MP ? a.out + O_LF_P + (size_t)m * 8 : a.out + O_LF_S + (size_t)(m - MP) * 8;
                dst[lane] = lf;
            }
        }
    }
}

__device__ __forceinline__ void phase_rows1(const Args& a, const int wv) {
    const int lane = lane_id(), wave = wv; const int gw = blockIdx.x * 8 + wave, NGW = gridDim.x * 8;
    const bf16_t* T = (const bf16_t*)(a.ws + WS_T); bf16_t* H = (bf16_t*)(a.ws + WS_H);
    f32x4 g2[4], g3[4];
#pragma unroll
    for (int j = 0; j < 4; ++j) { g2[j] = *(const f32x4*)(a.in[I_G2] + 4 * lane + 256 * j); g3[j] = *(const f32x4*)(a.in[I_G3] + 4 * lane + 256 * j); }
    constexpr int RB = 2;
    for (int mb = MP + gw * RB; mb < MTOK; mb += NGW * RB) {
        f32x4 t[RB][4], x[RB][4];
#pragma unroll
        for (int i = 0; i < RB; ++i) { const float* xr = xrow_ptr(a, mb + i); const bf16_t* tr = T + (size_t)(mb + i) * DM;
#pragma unroll
            for (int j = 0; j < 4; ++j) { const u32x2 tw = *(const u32x2*)(tr + 4 * lane + 256 * j); t[i][j] = (f32x4){bflo(tw.x), bfhi(tw.x), bflo(tw.y), bfhi(tw.y)}; x[i][j] = *(const f32x4*)(xr + 4 * lane + 256 * j); } }
#pragma unroll
        for (int i = 0; i < RB; ++i) {
            const int m = mb + i; float ss = 0.f;
#pragma unroll
            for (int j = 0; j < 4; ++j) ss += (t[i][j][0] * t[i][j][0] + t[i][j][1] * t[i][j][1]) + (t[i][j][2] * t[i][j][2] + t[i][j][3] * t[i][j][3]);
            const float rs = 1.0f / sqrtf(wave_sum(ss) * (1.0f / DM) + EPS);
            float s2 = 0.f;
#pragma unroll
            for (int j = 0; j < 4; ++j) { x[i][j] = x[i][j] + t[i][j] * rs * g2[j]; s2 += (x[i][j][0] * x[i][j][0] + x[i][j][1] * x[i][j][1]) + (x[i][j][2] * x[i][j][2] + x[i][j][3] * x[i][j][3]);
                *(f32x4*)(a.out + O_Y + (size_t)m * DM + 4 * lane + 256 * j) = x[i][j]; }
            const float r2 = 1.0f / sqrtf(wave_sum(s2) * (1.0f / DM) + EPS);
#pragma unroll
            for (int j = 0; j < 4; ++j) { u32x2 o; o.x = pk2(x[i][j][0] * r2 * g3[j][0], x[i][j][1] * r2 * g3[j][1]); o.y = pk2(x[i][j][2] * r2 * g3[j][2], x[i][j][3] * r2 * g3[j][3]);
                *(u32x2*)(H + (size_t)m * DM + 4 * lane + 256 * j) = o; }
        }
    }
}
__device__ __forceinline__ void phase_rows2(const Args& a, const int wv) {
    const int lane = lane_id(), wave = wv; const int gw = blockIdx.x * 8 + wave, NGW = gridDim.x * 8;
    const bf16_t* T = (const bf16_t*)(a.ws + WS_T);
    f32x4 g4[4];
#pragma unroll
    for (int j = 0; j < 4; ++j) g4[j] = *(const f32x4*)(a.in[I_G4] + 4 * lane + 256 * j);
    constexpr int RB = 2;
    for (int mb = MP + gw * RB; mb < MTOK; mb += NGW * RB) {
        f32x4 t[RB][4], x[RB][4];
#pragma unroll
        for (int i = 0; i < RB; ++i) { const bf16_t* tr = T + (size_t)(mb + i) * DM; const float* yr = a.out + O_Y + (size_t)(mb + i) * DM;
#pragma unroll
            for (int j = 0; j < 4; ++j) { const u32x2 tw = *(const u32x2*)(tr + 4 * lane + 256 * j); t[i][j] = (f32x4){bflo(tw.x), bfhi(tw.x), bflo(tw.y), bfhi(tw.y)}; x[i][j] = *(const f32x4*)(yr + 4 * lane + 256 * j); } }
#pragma unroll
        for (int i = 0; i < RB; ++i) {
            float* yr = a.out + O_Y + (size_t)(mb + i) * DM; float ss = 0.f;
#pragma unroll
            for (int j = 0; j < 4; ++j) ss += (t[i][j][0] * t[i][j][0] + t[i][j][1] * t[i][j][1]) + (t[i][j][2] * t[i][j][2] + t[i][j][3] * t[i][j][3]);
            const float rs = 1.0f / sqrtf(wave_sum(ss) * (1.0f / DM) + EPS);
#pragma unroll
            for (int j = 0; j < 4; ++j) *(f32x4*)(yr + 4 * lane + 256 * j) = x[i][j] + t[i][j] * rs * g4[j];
        }
    }
}


constexpr int AL_K = 0, AL_KB = 64 * 144, AL_V = 2 * AL_KB, AL_VB = 8192, AL_WS = AL_V + 2 * AL_VB, AL_CS = AL_WS + 8 * 256, AL_TAB = AL_CS + 2112 * 4, AL_MISC = AL_TAB + 260 * 4;
constexpr int N_ATT_UNITS = 1280, N_TR_UNITS = (TI_ALL - TI_IN + 7) / 8;
__device__ __forceinline__ int crow(int r, int hi) { return (r & 3) + 8 * (r >> 2) + 4 * hi; }
__device__ __forceinline__ float halfswap_max(float m) { auto rr = __builtin_amdgcn_permlane32_swap(__float_as_uint(m), __float_as_uint(m), false, false); return fmaxf(__uint_as_float(rr[0]), __uint_as_float(rr[1])); }
__device__ __forceinline__ float halfswap_sum(float m) { auto rr = __builtin_amdgcn_permlane32_swap(__float_as_uint(m), __float_as_uint(m), false, false); return __uint_as_float(rr[0]) + __uint_as_float(rr[1]); }

__device__ __forceinline__ void pv_step(f32x16* o, f32x16& lacc, unsigned vb, bf16x8 pa0, bf16x8 pa1, bf16x8 pa2, bf16x8 pa3) {
#pragma unroll
    for (int d0 = 0; d0 < 2; ++d0) { s16x4 lo[4], hh[4];
#pragma unroll
        for (int ks = 0; ks < 4; ++ks) {
            asm volatile("ds_read_b64_tr_b16 %0,%1 offset:%c2" : "=&v"(lo[ks]) : "v"(vb), "i"(d0 * 4096 + ks * 1024) : "memory");
            asm volatile("ds_read_b64_tr_b16 %0,%1 offset:%c2" : "=&v"(hh[ks]) : "v"(vb), "i"(d0 * 4096 + ks * 1024 + 512) : "memory"); }
        if (d0 == 0) {
            __builtin_amdgcn_sched_barrier(0);
            const u32x4 one4 = {0x3F803F80u, 0x3F803F80u, 0x3F803F80u, 0x3F803F80u}; const bf16x8 ones = __builtin_bit_cast(bf16x8, one4);
            lacc = __builtin_amdgcn_mfma_f32_32x32x16_bf16(pa0, ones, lacc, 0, 0, 0); lacc = __builtin_amdgcn_mfma_f32_32x32x16_bf16(pa1, ones, lacc, 0, 0, 0);
            lacc = __builtin_amdgcn_mfma_f32_32x32x16_bf16(pa2, ones, lacc, 0, 0, 0); lacc = __builtin_amdgcn_mfma_f32_32x32x16_bf16(pa3, ones, lacc, 0, 0, 0);
            __builtin_amdgcn_sched_barrier(0);
        }
        asm volatile("s_waitcnt lgkmcnt(0)" ::: "memory"); __builtin_amdgcn_sched_barrier(0);
#define PK_(k) (bf16x8){lo[k][0], lo[k][1], lo[k][2], lo[k][3], hh[k][0], hh[k][1], hh[k][2], hh[k][3]}
        o[d0] = __builtin_amdgcn_mfma_f32_32x32x16_bf16(pa0, PK_(0), o[d0], 0, 0, 0);
        o[d0] = __builtin_amdgcn_mfma_f32_32x32x16_bf16(pa1, PK_(1), o[d0], 0, 0, 0);
        o[d0] = __builtin_amdgcn_mfma_f32_32x32x16_bf16(pa2, PK_(2), o[d0], 0, 0, 0);
        o[d0] = __builtin_amdgcn_mfma_f32_32x32x16_bf16(pa3, PK_(3), o[d0], 0, 0, 0);
#undef PK_
    }
}

template <int KIND>
__device__ __forceinline__ void attn_unit(const Args& a, LAS unsigned char* lds, int b, int h, int blk, int samp, const int wv, unsigned* qctr, LAS unsigned* qnext) {
    int lane_ = lane_id(); asm volatile("" : "+v"(lane_));
    const int lane = lane_, r32 = lane & 31, hi = lane >> 5, wid = wv, tid = wv * 64 + lane;
    const bf16_t* QKV = (const bf16_t*)(a.ws + WS_QKV);
    const bf16_t* Qb = QKV + (size_t)(KIND == 0 ? 0 : 3) * QKV_STRIDE; const bf16_t* Kb = Qb + QKV_STRIDE; const bf16_t* Vb = Kb + QKV_STRIDE;
    bf16_t* Ob = (bf16_t*)(a.ws + (KIND == 0 ? WS_OA : WS_OB));
    const float* Kc = a.in[KIND == 0 ? I_CKA : I_CKB]; const float* Vc = a.in[KIND == 0 ? I_CVA : I_CVB];
    constexpr int CT = (KIND == 0) ? 8 : 32;
    int t_lo, t_hi, w_lo, w_hi, qrow, cch = 0, qpos = 0;
    if (KIND == 0) {
        if (!samp) { const int c0 = 4 * blk; cch = c0 + (wid >> 1); t_lo = c0 - 8 < 0 ? 0 : c0 - 8; t_hi = c0 + 3; w_lo = cch - 8 < 0 ? 0 : cch - 8; w_hi = cch; qrow = b * SEQ + 64 * cch + 32 * (wid & 1); qpos = 32 * (wid & 1) + r32; }
        else { cch = 8; t_lo = 0; t_hi = 8; w_lo = 0; w_hi = wid < 2 ? 8 : -1; qrow = MP + b * DSEQ + 32 * (wid & 1); qpos = 32 * (wid & 1) + r32; }
    } else {
        if (!samp) { t_lo = 0; t_hi = 4 * blk + 3; w_lo = 0; w_hi = 4 * blk + (wid >> 1); qrow = b * SEQ + 256 * blk + 32 * wid; qpos = 256 * blk + 32 * wid + r32; }
        else { t_lo = 0; t_hi = 32; w_lo = 0; w_hi = wid < 2 ? 32 : -1; qrow = MP + b * DSEQ + 32 * (wid & 1); qpos = PAST + 32 * (wid & 1) + r32; }
    }
    const bool active = w_hi >= w_lo;
    LAS float* wsf = (LAS float*)(lds + AL_WS) + wid * 64;
    LAS float* cs = (LAS float*)(lds + AL_CS);
    LAS float* tab = (LAS float*)(lds + AL_TAB);
    LAS float* misc = (LAS float*)(lds + AL_MISC);
    lds_barrier();
    bf16x8 qr[4];
#pragma unroll
    for (int dk = 0; dk < 4; ++dk) qr[dk] = active ? *(const bf16x8*)(Qb + (size_t)(qrow + r32) * HW + h * 64 + dk * 16 + hi * 8) : (bf16x8){0, 0, 0, 0, 0, 0, 0, 0};
    const int srow = tid >> 3, sch = tid & 7;
    const unsigned kst = AL_K + srow * 144 + sch * 16, vst = AL_V + (sch >> 2) * 4096 + srow * 64 + (sch & 3) * 16;
    struct Stage { u32x4 k, v; f32x4 kf0, kf1, vf0, vf1; bool f; };
    Stage sA, sB; sA.f = false; sB.f = false;
    auto issue = [&](int tq, Stage& s) {
        const int t = tq > t_hi ? t_hi : tq;
        if (samp && t < CT) { const unsigned off = ((unsigned)(b * (64 * CT) + 64 * t + srow) * 8u + h) * 64u + sch * 8;
            s.kf0 = *(const f32x4*)(Kc + off); s.kf1 = *(const f32x4*)(Kc + off + 4); s.vf0 = *(const f32x4*)(Vc + off); s.vf1 = *(const f32x4*)(Vc + off + 4); s.f = true; }
        else { const unsigned row = samp ? (unsigned)(MP + b * DSEQ + srow) : (unsigned)(b * SEQ + 64 * t + srow); const unsigned off = row * HW + h * 64 + sch * 8;
            s.k = *(const u32x4*)(Kb + off); s.v = *(const u32x4*)(Vb + off); s.f = false; }
    };
    auto commit = [&](int buf, int t, Stage& s) {
        u32x4 kreg = s.k, vreg = s.v;
        if (s.f) { kreg.x = pk2(s.kf0[0], s.kf0[1]); kreg.y = pk2(s.kf0[2], s.kf0[3]); kreg.z = pk2(s.kf1[0], s.kf1[1]); kreg.w = pk2(s.kf1[2], s.kf1[3]);
                   vreg.x = pk2(s.vf0[0], s.vf0[1]); vreg.y = pk2(s.vf0[2], s.vf0[3]); vreg.z = pk2(s.vf1[0], s.vf1[1]); vreg.w = pk2(s.vf1[2], s.vf1[3]); }
        *(LAS u32x4*)(lds + kst + buf * AL_KB) = kreg; *(LAS u32x4*)(lds + vst + buf * AL_VB) = vreg;
        float* kd = nullptr; float* vd = nullptr;
        if (samp) { if (t == CT) { const unsigned o = (unsigned)(b * DSEQ + srow) * HW + h * 64 + sch * 8; kd = a.out + (KIND == 0 ? O_KA_S : O_KB_S) + o; vd = a.out + (KIND == 0 ? O_VA_S : O_VB_S) + o; } }
        else if (KIND == 1) { if (t >= 4 * blk) { const unsigned o = (unsigned)(b * SEQ + 64 * t + srow) * HW + h * 64 + sch * 8; kd = a.out + O_KB_P + o; vd = a.out + O_VB_P + o; } }
        else { if (t >= 4 * blk && t >= 24) { const unsigned o = (unsigned)(b * ALEN + 64 * (t - 24) + srow) * HW + h * 64 + sch * 8; kd = a.out + O_KA_P + o; vd = a.out + O_VA_P + o; } }
        if (kd) {
            *(f32x4*)kd = (f32x4){bflo(kreg.x), bfhi(kreg.x), bflo(kreg.y), bfhi(kreg.y)}; *(f32x4*)(kd + 4) = (f32x4){bflo(kreg.z), bfhi(kreg.z), bflo(kreg.w), bfhi(kreg.w)};
            *(f32x4*)vd = (f32x4){bflo(vreg.x), bfhi(vreg.x), bflo(vreg.y), bfhi(vreg.y)}; *(f32x4*)(vd + 4) = (f32x4){bflo(vreg.z), bfhi(vreg.z), bflo(vreg.w), bfhi(vreg.w)};
        }
    };
    issue(t_lo, sA); issue(t_lo + 1, sB);
    if (KIND == 0) {
        for (int i = tid; i < 257; i += 512) tab[i] = a.in[I_REL][h * 257 + i] * LOG2E;
    } else {
        const int n0 = samp ? PAST : 256 * (blk + 1);
        const float* src = samp ? a.in[I_CLF] + (size_t)b * PAST * 8 + h : a.out + O_LF_P + (size_t)b * SEQ * 8 + h;
        float v[4];
#pragma unroll
        for (int j = 0; j < 4; ++j) { const int idx = 4 * tid + j; v[j] = idx < n0 ? src[(size_t)idx * 8] : 0.f; }
        v[1] += v[0]; v[2] += v[1]; v[3] += v[2];
        float inc = v[3];
#pragma unroll
        for (int o = 1; o < 64; o <<= 1) { const float t = __shfl_up(inc, o); if (lane >= o) inc += t; }
        if (lane == 63) misc[wid] = inc;
        __syncthreads();
        float off = inc - v[3];
#pragma unroll
        for (int w = 0; w < 8; ++w) if (w < wid) off += misc[w];
        if (4 * tid < n0) { f32x4 o4 = {(off + v[0]) * LOG2E, (off + v[1]) * LOG2E, (off + v[2]) * LOG2E, (off + v[3]) * LOG2E}; *(LAS f32x4*)(cs + 4 * tid) = o4; }
        if (samp) {
            __syncthreads();
            if (wid == 0) {
                float x = a.out[O_LF_S + (size_t)(b * DSEQ + lane) * 8 + h];
#pragma unroll
                for (int o = 1; o < 64; o <<= 1) { const float t = __shfl_up(x, o); if (lane >= o) x += t; }
                cs[PAST + lane] = cs[PAST - 1] + x * LOG2E;
            }
        }
    }
    commit(0, t_lo, sA);
    __syncthreads();
    f32x16 o[2];
#pragma unroll
    for (int r = 0; r < 16; ++r) { o[0][r] = 0.f; o[1][r] = 0.f; }
    float mhat = (KIND == 1 && active) ? -cs[qpos] : 0.f;
    f32x16 lacc;
#pragma unroll
    for (int r = 0; r < 16; ++r) lacc[r] = 0.f;
    const unsigned lds0 = (unsigned)(uintptr_t)lds;
    const unsigned vb0 = lds0 + AL_V + ((lane >> 4) & 1) * 32 + (lane & 3) * 8 + (4 * hi + ((lane & 15) >> 2)) * 64;
    auto tile = [&](const int t, const int buf) {
        if (active && t >= w_lo && t <= w_hi) {
            const LAS unsigned char* Kt = lds + AL_K + buf * AL_KB + r32 * 144 + hi * 16;
            f32x16 p0, p1; const float nmh = -mhat;
            if (KIND == 0) {
                const int delta = cch - t;
                if (delta >= 3) { const float bb = tab[256] + nmh;
#pragma unroll
                    for (int r = 0; r < 16; ++r) { p0[r] = bb; p1[r] = bb; } }
                else { int base = 64 * delta + qpos - 4 * hi + 128; asm volatile("" : "+v"(base));
#pragma unroll
                    for (int r = 0; r < 16; ++r) { const int kv = (r & 3) + 8 * (r >> 2); int i0 = base - kv, i1 = base - kv - 32;
                        i0 = i0 < 0 ? 0 : (i0 > 256 ? 256 : i0); i1 = i1 < 0 ? 0 : (i1 > 256 ? 256 : i1); p0[r] = tab[i0] + nmh; p1[r] = tab[i1] + nmh; } }
            } else {
                const LAS float* ct = cs + 64 * t + 4 * hi;
#pragma unroll
                for (int g = 0; g < 4; ++g) { const f32x4 c0 = *(const LAS f32x4*)(ct + 8 * g), c1 = *(const LAS f32x4*)(ct + 32 + 8 * g);
#pragma unroll
                    for (int e = 0; e < 4; ++e) { p0[4 * g + e] = nmh - c0[e]; p1[4 * g + e] = nmh - c1[e]; } }
            }
#pragma unroll
            for (int dk = 0; dk < 4; ++dk) {
                const bf16x8 a0 = *(const LAS bf16x8*)(Kt + dk * 32), a1 = *(const LAS bf16x8*)(Kt + 32 * 144 + dk * 32);
                p0 = __builtin_amdgcn_mfma_f32_32x32x16_bf16(a0, qr[dk], p0, 0, 0, 0);
                p1 = __builtin_amdgcn_mfma_f32_32x32x16_bf16(a1, qr[dk], p1, 0, 0, 0);
            }
            if (KIND == 1) {
                if (t == w_hi) { int kb = 64 * t + 4 * hi - qpos; asm volatile("" : "+v"(kb));
#pragma unroll
                    for (int r = 0; r < 16; ++r) { const int kv = kb + (r & 3) + 8 * (r >> 2); if (kv > 0) p0[r] = -INFINITY; if (kv + 32 > 0) p1[r] = -INFINITY; } }
            }
            float mxa = fmaxf(p0[0], p1[0]), mxb = fmaxf(p0[1], p1[1]), mxc = fmaxf(p0[2], p1[2]), mxd = fmaxf(p0[3], p1[3]);
#pragma unroll
            for (int r = 4; r < 16; r += 4) { mxa = fmaxf(mxa, fmaxf(p0[r], p1[r])); mxb = fmaxf(mxb, fmaxf(p0[r + 1], p1[r + 1])); mxc = fmaxf(mxc, fmaxf(p0[r + 2], p1[r + 2])); mxd = fmaxf(mxd, fmaxf(p0[r + 3], p1[r + 3])); }
            float mx = halfswap_max(fmaxf(fmaxf(mxa, mxb), fmaxf(mxc, mxd)));
            if (__any(mx > 8.0f)) {
                const float dl = fmaxf(mx, 0.f); const float al = __builtin_amdgcn_exp2f(-dl); mhat += dl;
#pragma unroll
                for (int r = 0; r < 16; ++r) { p0[r] -= dl; p1[r] -= dl; }
                if (hi == 0) wsf[r32] = al;
#pragma unroll
                for (int g = 0; g < 4; ++g) { const f32x4 f = *(const LAS f32x4*)(wsf + 8 * g + 4 * hi);
#pragma unroll
                    for (int e = 0; e < 4; ++e) { o[0][4 * g + e] *= f[e]; o[1][4 * g + e] *= f[e]; lacc[4 * g + e] *= f[e]; } }
            }
#pragma unroll
            for (int r = 0; r < 16; ++r) { p0[r] = __builtin_amdgcn_exp2f(p0[r]); p1[r] = __builtin_amdgcn_exp2f(p1[r]); }
            u32x4 w0, w1, w2, w3;
            w0.x = pk2(p0[0], p0[1]); w0.y = pk2(p0[2], p0[3]); w0.z = pk2(p0[4], p0[5]); w0.w = pk2(p0[6], p0[7]);
            w1.x = pk2(p0[8], p0[9]); w1.y = pk2(p0[10], p0[11]); w1.z = pk2(p0[12], p0[13]); w1.w = pk2(p0[14], p0[15]);
            w2.x = pk2(p1[0], p1[1]); w2.y = pk2(p1[2], p1[3]); w2.z = pk2(p1[4], p1[5]); w2.w = pk2(p1[6], p1[7]);
            w3.x = pk2(p1[8], p1[9]); w3.y = pk2(p1[10], p1[11]); w3.z = pk2(p1[12], p1[13]); w3.w = pk2(p1[14], p1[15]);
            pv_step(o, lacc, vb0 + buf * AL_VB, __builtin_bit_cast(bf16x8, w0), __builtin_bit_cast(bf16x8, w1), __builtin_bit_cast(bf16x8, w2), __builtin_bit_cast(bf16x8, w3));
        }
    };
    for (int t = t_lo;;) {
        issue(t + 2, sA);
        tile(t, 0);
        if (t < t_hi) commit(1, t + 1, sB);
        lds_barrier();
        if (++t > t_hi) break;
        issue(t + 2, sB);
        tile(t, 1);
        if (t < t_hi) commit(0, t + 1, sA);
        lds_barrier();
        if (++t > t_hi) break;
    }
    unsigned nxt = 0u;
    if (tid == 0) nxt = atomicAdd(qctr, 1u);
    if (active) {
        float rl[16];
#pragma unroll
        for (int r = 0; r < 16; ++r) rl[r] = __builtin_amdgcn_rcpf(lacc[r]);
        LAS bf16_t* stg = (LAS bf16_t*)(lds + AL_K + wid * 4096);
#pragma unroll
        for (int r = 0; r < 16; ++r) { const int orow = crow(r, hi); stg[orow * 64 + r32] = (bf16_t)f2bf(o[0][r] * rl[r]); stg[orow * 64 + 32 + r32] = (bf16_t)f2bf(o[1][r] * rl[r]); }
#pragma unroll
        for (int i = 0; i < 4; ++i) { const int row = i * 8 + (lane >> 3), ch = lane & 7; const u32x4 v = *(const LAS u32x4*)(stg + row * 64 + ch * 8);
            *(u32x4*)(Ob + (size_t)(qrow + row) * HW + h * 64 + ch * 8) = v; }
    }
    if (tid == 0) *qnext = nxt;
}

__device__ __forceinline__ void phase_attention(const Args& a, LAS unsigned char* lds, const int wv) {
    const int tid = wv * 64 + lane_id();
    unsigned* ctr = (unsigned*)(a.ws + WS_CTL);
    LAS unsigned* sidx = (LAS unsigned*)(lds + AL_MISC + 64);
    __syncthreads();
    if (tid == 0) *sidx = atomicAdd(ctr, 1u);
    for (;;) {
        lds_barrier();
        const int i = (int)*sidx;
        if (i >= N_ATT_UNITS + N_TR_UNITS) break;
        if (i >= N_ATT_UNITS) {
            const int it = TI_IN + (i - N_ATT_UNITS) * 8 + wv;
            __syncthreads();
            int l2 = lane_id(); asm volatile("" : "+v"(l2));
            if (it < TI_ALL) transpose_item(a, it, (LAS float*)(lds + wv * 8448), l2);
            __syncthreads();
            if (tid == 0) *sidx = atomicAdd(ctr, 1u);
            continue;
        }
        if (i < 128) attn_unit<1>(a, lds, i >> 3, i & 7, 0, 1, wv, ctr, sidx);
        else if (i < 448) { const int j = i - 128; attn_unit<1>(a, lds, (j & 63) >> 3, j & 7, 7 - (j >> 6), 0, wv, ctr, sidx); }
        else if (i < 832) { const int j = i - 448; attn_unit<0>(a, lds, (j & 63) >> 3, j & 7, 7 - (j >> 6), 0, wv, ctr, sidx); }
        else if (i < 896) { const int j = i - 832; attn_unit<1>(a, lds, j >> 3, j & 7, 2, 0, wv, ctr, sidx); }
        else if (i < 1024) { const int j = i - 896; attn_unit<0>(a, lds, j >> 3, j & 7, 0, 1, wv, ctr, sidx); }
        else if (i < 1088) { const int j = i - 1024; attn_unit<0>(a, lds, j >> 3, j & 7, 1, 0, wv, ctr, sidx); }
        else if (i < 1152) { const int j = i - 1088; attn_unit<1>(a, lds, j >> 3, j & 7, 1, 0, wv, ctr, sidx); }
        else if (i < 1216) { const int j = i - 1152; attn_unit<1>(a, lds, j >> 3, j & 7, 0, 0, wv, ctr, sidx); }
        else { const int j = i - 1216; attn_unit<0>(a, lds, j >> 3, j & 7, 0, 0, wv, ctr, sidx); }
    }
}

#define XB_TMO      128
#define XB_XCNT(j)  (256  + 64 * (j))
#define XB_XSUB(j)  (1280 + 64 * (j))
#define XB_XGEN(j)  (2304 + 64 * (j))
#define XB_TOP      3328
#define XB_TOPGEN   3392
#define XCD_BAR_WORDS 3456
#define XB_SPIN_CAP (1u << 18)

__device__ __forceinline__ unsigned xb_ld(unsigned* p)              { return __hip_atomic_load(p, __ATOMIC_RELAXED, __HIP_MEMORY_SCOPE_AGENT); }
__device__ __forceinline__ unsigned xb_add(unsigned* p, unsigned v) { return __hip_atomic_fetch_add(p, v, __ATOMIC_RELAXED, __HIP_MEMORY_SCOPE_AGENT); }
__device__ __forceinline__ unsigned xb_xcc_id() { return (unsigned)__builtin_amdgcn_s_getreg((3 << 11) | 20) & 0xFu; }
#define XB_SPIN(cond, bar) do { unsigned _sp = 0; while (cond) { __builtin_amdgcn_s_sleep(1); \
    if ((++_sp & 255u) == 0u) { if (xb_ld(&(bar)[XB_TMO])) break; if (_sp > XB_SPIN_CAP) { atomicAdd(&(bar)[XB_TMO], 1u); break; } } } } while (0)

struct XcdBarrier {
    unsigned* bar; unsigned x; bool leader;
    volatile LAS unsigned* st;
};

__device__ __forceinline__ XcdBarrier xcd_barrier_post(unsigned* bar, volatile LAS unsigned* st, const bool leader) {
    XcdBarrier b; b.bar = bar; b.x = xb_xcc_id(); b.st = st; b.leader = leader;
    if (leader) (void)xb_add(&bar[XB_XCNT(b.x)], 1u);
    return b;
}
__device__ __forceinline__ void xcd_barrier_complete(unsigned* bar, unsigned x, unsigned& nloc, unsigned& nx) {
    const unsigned G = gridDim.x * gridDim.y * gridDim.z;
    unsigned sum, cnt, mine, sp = 0u;
    for (;;) {
        sum = 0u; cnt = 0u; mine = 0u;
#pragma unroll
        for (unsigned j = 0; j < 16; ++j) { const unsigned c = xb_ld(&bar[XB_XCNT(j)]); sum += c; cnt += (c > 0u) ? 1u : 0u; mine = (j == x) ? c : mine; }
        if (sum == G) break;
        __builtin_amdgcn_s_sleep(1);
        if ((++sp & 255u) == 0u) { if (xb_ld(&bar[XB_TMO])) break; if (sp > XB_SPIN_CAP) { atomicAdd(&bar[XB_TMO], 1u); break; } }
    }
    nloc = mine > 0u ? mine : 1u; nx = cnt > 0u ? cnt : 1u;
}

__device__ __forceinline__ void xcd_barrier(const XcdBarrier& b, const bool leader_now) {
    asm volatile("s_waitcnt vmcnt(0)" ::: "memory");
    __syncthreads();
    if (leader_now) {
        unsigned* bar = b.bar;
        __builtin_amdgcn_s_waitcnt(0);
        unsigned nloc = b.st[0], nx = b.st[1];
        if (nloc == 0u) { xcd_barrier_complete(bar, b.x, nloc, nx); b.st[0] = nloc; b.st[1] = nx; }
        const unsigned old = xb_add(&bar[XB_XSUB(b.x)], 1u);
        const unsigned gen = old / nloc;
        if (old + 1u == (gen + 1u) * nloc) {
            __builtin_amdgcn_fence(__ATOMIC_RELEASE, "agent");
            asm volatile("s_waitcnt vmcnt(0)" ::: "memory");
            const unsigned og = xb_add(&bar[XB_TOP], 1u);
            const unsigned tg = og / nx;
            if (og + 1u == (tg + 1u) * nx) xb_add(&bar[XB_TOPGEN], 1u);
            else XB_SPIN(xb_ld(&bar[XB_TOPGEN]) == tg, bar);
            __builtin_amdgcn_fence(__ATOMIC_ACQUIRE, "agent");
            xb_add(&bar[XB_XGEN(b.x)], 1u);
            asm volatile("s_waitcnt vmcnt(0)" ::: "memory");
        } else {
            XB_SPIN(xb_ld(&bar[XB_XGEN(b.x)]) == gen, bar);
            __builtin_amdgcn_fence(__ATOMIC_ACQUIRE, "agent");
            asm volatile("s_waitcnt vmcnt(0)" ::: "memory");
        }
    }
    __syncthreads();
}

constexpr int N_PHASES = 7;
__device__ __forceinline__ void grid_bar(unsigned* bar, unsigned& epoch, const int wv, const unsigned nblocks) {
    __syncthreads();
    epoch += 1;
    if (wv == 0 && lane_id() == 0) {
        __builtin_amdgcn_fence(__ATOMIC_RELEASE, "agent");
        asm volatile("s_waitcnt vmcnt(0)" ::: "memory");
        __hip_atomic_fetch_add(bar, 1u, __ATOMIC_RELAXED, __HIP_MEMORY_SCOPE_AGENT);
        const unsigned target = epoch * nblocks;
        while (__hip_atomic_load(bar, __ATOMIC_RELAXED, __HIP_MEMORY_SCOPE_AGENT) < target) __builtin_amdgcn_s_sleep(2);
        __builtin_amdgcn_fence(__ATOMIC_ACQUIRE, "agent");
        asm volatile("s_waitcnt vmcnt(0)" ::: "memory");
    }
    __syncthreads();
}
__global__ void __launch_bounds__(512, 2) mega_fwd(Args a) {
    extern __shared__ __attribute__((aligned(16))) unsigned char lds_raw[];
    LAS unsigned char* lds = (LAS unsigned char*)lds_raw;
    unsigned char* ws = a.ws;
    const int lo = a.ph_lo, hi = a.ph_hi, G = gridDim.x, c = (int)blockIdx.x;
    const int wv = __builtin_amdgcn_readfirstlane((int)threadIdx.x >> 6);
    volatile LAS unsigned* bst = (volatile LAS unsigned*)(lds + RING_BYTES + 12288);
    if (threadIdx.x < 2) bst[threadIdx.x] = 0u;
    __syncthreads();
    XcdBarrier xbar; xbar.bar = (unsigned*)(ws + WS_CTL) + 1024; xbar.x = 0; xbar.st = bst; xbar.leader = false;
    if (a.coop == 2) cg::this_grid().sync();
    if (a.coop) xbar = xcd_barrier_post((unsigned*)(ws + WS_CTL) + 1024, bst, wv == 0 && lane_id() == 0);
#define IN(k) (lo <= (k) && (k) < hi)
#define SEAM(k) do { if (IN(k) && IN((k) + 1)) { if (a.coop) { xcd_barrier(xbar, wv == 0 && lane_id() == 0); } } } while (0)
    if (IN(0)) phase_prologue(a, lds, wv);
    SEAM(0);
    if (IN(1)) {
        pg8::Gemm g{(const bf16_t*)(ws + WS_H), (const bf16_t*)(ws + WS_WIN), MP, NIN, DM}; pg8::StaticOrder S; S.init(MP, NIN, G, c);
        EpiIn E{ws, a.out};
        pg8::gemm_phase<EpiIn, pg8::StaticOrder, true, true>(lds, g, S, E, wv);
        small_gemm_a4<EpiIn>(lds, g.A, g.Bt, NIN, E, wv);
    }
    SEAM(1);
    if (IN(2)) phase_attention(a, lds, wv);
    SEAM(2);
    if (IN(3)) {
        { pg8::Gemm g{(const bf16_t*)(ws + WS_OA), (const bf16_t*)(ws + WS_WPA), MP, DM, HW}; pg8::StaticOrder S; S.init(MP, DM, G, c);
          EpiProjA E{(const bf16_t*)(ws + WS_GA), (bf16_t*)(ws + WS_T)};
          pg8::gemm_phase<EpiProjA, pg8::StaticOrder, true, true>(lds, g, S, E, wv);
          small_gemm<EpiProjA>(lds, g.A, g.Bt, HW, DM, E, wv); }
        { pg8::Gemm g{(const bf16_t*)(ws + WS_OB), (const bf16_t*)(ws + WS_WPB), MP, DM, HW}; pg8::StaticOrder S; S.init(MP, DM, G, c);
          EpiProjB E{(const bf16_t*)(ws + WS_GB), (const bf16_t*)(ws + WS_T), (bf16_t*)(ws + WS_MG)};
          pg8::gemm_phase<EpiProjB, pg8::StaticOrder, true, true>(lds, g, S, E, wv);
          small_gemm<EpiProjB>(lds, g.A, g.Bt, HW, DM, E, wv); }
    }
    SEAM(3);
    if (IN(4)) {
        pg8::Gemm g{(const bf16_t*)(ws + WS_MG), (const bf16_t*)(ws + WS_WOUT), MP, DM, DM}; pg8::StaticOrder S; S.init(MP, DM, G, c);
        EpiOutNorm EN{a.in[I_XP], (float*)(ws + WS_RS2), (bf16_t*)(ws + WS_H), a.in[I_G2], RowStat{(float*)(ws + WS_XB1), (unsigned*)(ws + WS_CTL) + CW_CNT1}, RowStat{(float*)(ws + WS_XB2), (unsigned*)(ws + WS_CTL) + CW_CNT2}};
        pg8::gemm_phase<EpiOutNorm, pg8::StaticOrder, false, true>(lds, g, S, EN, wv);
        __syncthreads();
        small_gemm_norm<0>(lds, g.A, g.Bt, DM, a.in[I_XS], a.out + O_Y, (float*)(ws + WS_RS2), (bf16_t*)(ws + WS_H), a.in[I_G2],
                           TailStat{(float*)(ws + WS_XT1), (unsigned*)(ws + WS_CTL) + CW_TC1}, TailStat{(float*)(ws + WS_XT2), (unsigned*)(ws + WS_CTL) + CW_TC2}, wv);
    }
    SEAM(4);
    if (IN(5)) {
        pg8::Gemm g{(const bf16_t*)(ws + WS_H), (const bf16_t*)(ws + WS_WUP), MTOK, NUP, DM}; pg8::StaticOrder S; S.init(MTOK, NUP, G, c);
        EpiUpFused E{(bf16_t*)(ws + WS_A2), a.out, a.in[I_CW], a.in[I_CB], a.in[I_CONV], (float*)(ws + WS_HEAD), (float*)(ws + WS_TAIL), (LAS float*)(lds + RING_BYTES)};
        pg8::gemm_phase<EpiUpFused, pg8::StaticOrder, true, true>(lds, g, S, E, wv);
    }
    SEAM(5);
    if (IN(6)) {
        pg8::Gemm g{(const bf16_t*)(ws + WS_A2), (const bf16_t*)(ws + WS_WDN), MP, DM, DFF}; pg8::StaticOrder S; S.init(MP, DM, G, c);
        { Unit fu; for (int i = 0; S.next(i, fu); ++i) ffn_fixup(a, fu.pm, wv * 64 + lane_id()); }
        __syncthreads();
        EpiDownNorm EN{(const bf16_t*)(ws + WS_H), (const float*)(ws + WS_RS2), a.out + O_Y, a.in[I_G4], RowStat{(float*)(ws + WS_XB3), (unsigned*)(ws + WS_CTL) + CW_CNT3}};
        pg8::gemm_phase<EpiDownNorm, pg8::StaticOrder, false, true>(lds, g, S, EN, wv);
        __syncthreads();
        small_gemm_norm<1>(lds, g.A, g.Bt, DFF, nullptr, a.out + O_Y, (float*)(ws + WS_RS2), (bf16_t*)(ws + WS_H), a.in[I_G4],
                           TailStat{(float*)(ws + WS_XT3), (unsigned*)(ws + WS_CTL) + CW_TC3}, TailStat{nullptr, nullptr}, wv);
    }
#undef IN
#undef SEAM
}

#ifndef MK_N_LAUNCHES
#define MK_N_LAUNCHES 1
#endif
extern "C" void kernel_launch(void* const* d_in, const int* in_sizes, int n_in, void* d_out, int out_size, void* d_ws, size_t ws_size, hipStream_t stream) {
    static int grid = 0;
    if (grid == 0) {
        if (n_in != 22 || (size_t)out_size != O_END || ws_size < WS_END) { fprintf(stderr, "kernel_launch: unexpected sizes n_in %d out %d ws %zu\n", n_in, out_size, ws_size); grid = -1; return; }
        int dev = 0, cus = 0, per_cu = 0;
        hipGetDevice(&dev);
        hipDeviceGetAttribute(&cus, hipDeviceAttributeMultiprocessorCount, dev);
        hipFuncSetAttribute((const void*)mega_fwd, hipFuncAttributeMaxDynamicSharedMemorySize, LDS_BYTES);
        hipOccupancyMaxActiveBlocksPerMultiprocessor(&per_cu, (const void*)mega_fwd, 512, LDS_BYTES);
        if (per_cu < 1) { fprintf(stderr, "kernel_launch: occupancy query says %d blocks/CU\n", per_cu); per_cu = 1; }
        (void)hipGetLastError();
        grid = cus;
        if (grid != 256) { fprintf(stderr, "kernel_launch: built for 256 CUs (one 256x256 unit per workgroup in the fused-norm GEMMs), device has %d\n", grid); grid = -1; return; }
    }
    if (grid < 0) return;
    hipMemsetAsync((char*)d_ws + WS_CTL, 0, CTL_BYTES, stream);
    Args a{};
    for (int i = 0; i < 22; ++i) a.in[i] = (const float*)d_in[i];
    a.out = (float*)d_out; a.ws = (unsigned char*)d_ws;
#if MK_N_LAUNCHES == 1
    a.ph_lo = 0; a.ph_hi = N_PHASES; a.coop = 1; a.pad = 0;
    void* args[] = {&a};
    hipError_t e = hipLaunchCooperativeKernel((const void*)mega_fwd, dim3(grid), dim3(512), args, LDS_BYTES, stream);
    if (e != hipSuccess) fprintf(stderr, "cooperative launch failed: %s (grid %d)\n", hipGetErrorString(e), grid);
#else
    for (int p = 0; p < N_PHASES; ++p) {
        a.ph_lo = p; a.ph_hi = p + 1; a.coop = 0; a.pad = 0;
        hipLaunchKernelGGL(mega_fwd, dim3(grid), dim3(512), LDS_BYTES, stream, a);
    }
#endif
}
```

```cpp
#include <hip/hip_runtime.h>
#include <hip/hip_cooperative_groups.h>
#include <cstdio>
#include <cstdint>
namespace cg = cooperative_groups;
namespace pg8 {
#define PG8_LAS __attribute__((address_space(3)))
typedef unsigned short bf16_t;
typedef short bf16x8 __attribute__((ext_vector_type(8)));
typedef float f32x4 __attribute__((ext_vector_type(4)));
typedef unsigned u32x4 __attribute__((ext_vector_type(4)));
constexpr int BM = 256, BK = 64, HALF = 128, HTB = HALF * BK * 2  , STAGE_BYTES = 8 * HTB, NXCD = 8, WGM = 8;

__host__ __device__ __forceinline__ int lds_byte(int r, int c) { const int st = (r >> 4) * 2 + (c >> 5), rr = r & 15, cc = c & 31, ob = rr * 64 + cc * 2; return st * 1024 + (ob ^ (((ob >> 9) & 1) << 5)); }
__host__ __device__ __forceinline__ void stage_rc(int b, int& R, int& C) { const int st = b / 1024, sb = b % 1024, swz = sb ^ (((sb >> 9) & 1) << 5); R = (st >> 1) * 16 + swz / 64; C = (st & 1) * 32 + (swz % 64) / 2; }
__host__ __device__ __forceinline__ int perm32(int rho) { const int n = rho >> 4, i = rho & 15; return 8 * (i >> 2) + 4 * n + (i & 3); }

struct Unit { int pm, pn; };
struct Gemm { const bf16_t* A; const bf16_t* Bt; int M, N, K; };

struct StaticOrder {
    int nM, nN, nwg, G, c;
    __host__ __device__ void init(int M, int N, int G_, int c_) { nM = M / BM; nN = N / BM; nwg = nM * nN; G = G_; c = c_; }
    __host__ __device__ __forceinline__ bool next(int i, Unit& u) const {
        const long L = (long)i * G + c; if (L >= nwg) return false;
        int wgid = (int)L; { const int q = nwg / NXCD, r = nwg % NXCD, xcd = wgid % NXCD, off = wgid / NXCD; wgid = (xcd < r ? xcd * (q + 1) : r * (q + 1) + (xcd - r) * q) + off; }
        const int nig = WGM * nN, gid = wgid / nig, fm = gid * WGM, gsz = (nM - fm) < WGM ? (nM - fm) : WGM;
        u.pm = fm + ((wgid % nig) % gsz); u.pn = (wgid % nig) / gsz; return true;
    }
    __device__ __forceinline__ void a_ready(const Unit&) const {}
    __device__ __forceinline__ void done(const Unit&) const {}
};

__device__ __forceinline__ unsigned cvt_pk_bf16(float lo, float hi) { unsigned r; asm volatile("v_cvt_pk_bf16_f32 %0, %1, %2" : "=v"(r) : "v"(lo), "v"(hi)); return r; }
typedef float f32x2 __attribute__((ext_vector_type(2)));
template <class Epi, class Sched, bool ALIGN_EPI = false, bool SP2 = false>
__device__ __forceinline__ void gemm_phase(PG8_LAS unsigned char* lds, const Gemm g, const Sched& S, const Epi& E, const int wv) {
    const int wid = wv, lane = (int)__builtin_amdgcn_mbcnt_hi(~0u, __builtin_amdgcn_mbcnt_lo(~0u, 0u)), tid = wid * 64 + lane, wr = wid >> 2, wc = wid & 3, fr = lane & 15, fq = lane >> 4;
    const int K = g.K, nt = K / BK;
    unsigned voffA[2], voffB[2];
#pragma unroll
    for (int i = 0; i < 2; ++i) { int R, C; stage_rc(tid * 16 + i * 8192, R, C); const int Rb = Epi::PERM ? ((R & ~31) + perm32(R & 31)) : R;
        voffA[i] = (unsigned)(R * K + C) * 2u; voffB[i] = (unsigned)(Rb * K + C) * 2u; }
    const size_t kstep = (size_t)(BK * 2);
    const size_t hstep = (size_t)HALF * K * 2;
    const size_t tstep = 2 * hstep;
    const unsigned ldsw = (unsigned)wid * 1024u;
    const int aoff = lds_byte(wr * 64 + fr, fq * 8), boff = lds_byte(wc * 32 + fr, fq * 8);
#define PG8_SA(b, h) (((b) * 2 + (h)) * HTB)
#define PG8_SB(b, h) ((4 + (b) * 2 + (h)) * HTB)
#define PG8_STAGE(bufoff, gbase, voff) do { _Pragma("unroll") for (int _i = 0; _i < 2; ++_i) \
        __builtin_amdgcn_global_load_lds((const unsigned*)((const char*)(gbase) + (voff)[_i]), (PG8_LAS unsigned*)(lds + (bufoff) + ldsw + _i * 8192), 16, 0, 0); } while (0)
#define PG8_LDA(dst, b, h) do { _Pragma("unroll") for (int m = 0; m < 4; ++m) _Pragma("unroll") for (int k = 0; k < 2; ++k) dst[m][k] = *(const PG8_LAS bf16x8*)(lds + PG8_SA(b, h) + aoff + m * 2048 + k * 1024); } while (0)
#define PG8_LDB(dst, b, h) do { _Pragma("unroll") for (int n = 0; n < 2; ++n) _Pragma("unroll") for (int k = 0; k < 2; ++k) dst[n][k] = *(const PG8_LAS bf16x8*)(lds + PG8_SB(b, h) + boff + n * 2048 + k * 1024); } while (0)
#define PG8_MMA(ai, bj, At, Bt) do { __builtin_amdgcn_s_setprio(1); _Pragma("unroll") for (int m = 0; m < 4; ++m) _Pragma("unroll") for (int n = 0; n < 2; ++n) _Pragma("unroll") for (int k = 0; k < 2; ++k) \
        acc[ai][bj][m][n] = __builtin_amdgcn_mfma_f32_16x16x32_bf16(Bt[n][k], At[m][k], acc[ai][bj][m][n], 0, 0, 0); __builtin_amdgcn_s_setprio(0); } while (0)
#define PG8_WAIT_V(n) asm volatile("s_waitcnt vmcnt(" #n ")" ::: "memory")
#define PG8_WAIT_L(n) asm volatile("s_waitcnt lgkmcnt(" #n ")" ::: "memory")
#define PG8_BAR __builtin_amdgcn_s_barrier()
#define PG8_SCHED __builtin_amdgcn_sched_barrier(0)
    Unit cur, nxt; int ui = 0;
    if (!S.next(0, cur)) return;
    f32x4 acc[2][2][4][2];
#pragma unroll
    for (int a = 0; a < 2; ++a)
#pragma unroll
        for (int b = 0; b < 2; ++b)
#pragma unroll
            for (int m = 0; m < 4; ++m)
#pragma unroll
                for (int n = 0; n < 2; ++n) acc[a][b][m][n] = (f32x4){0.f, 0.f, 0.f, 0.f};
    bf16x8 At[4][2], B0[2][2], B1[2][2];
    const char* cA = (const char*)g.A + (size_t)cur.pm * tstep; const char* cB = (const char*)g.Bt + (size_t)cur.pn * tstep;
    S.a_ready(cur);
    if constexpr (SP2) {
        PG8_STAGE(PG8_SB(0, 0), cB, voffB); PG8_STAGE(PG8_SB(0, 1), cB + hstep, voffB); PG8_STAGE(PG8_SA(0, 0), cA, voffA); PG8_STAGE(PG8_SA(0, 1), cA + hstep, voffA);
        if (wr == 1) PG8_BAR;
        PG8_WAIT_V(2); PG8_BAR;
        PG8_STAGE(PG8_SB(1, 0), cB + kstep, voffB); PG8_STAGE(PG8_SA(1, 0), cA + kstep, voffA); PG8_STAGE(PG8_SB(1, 1), cB + hstep + kstep, voffB);
        PG8_WAIT_V(6); PG8_BAR;
    } else {
        PG8_STAGE(PG8_SB(0, 0), cB, voffB); PG8_STAGE(PG8_SA(0, 0), cA, voffA); PG8_STAGE(PG8_SB(0, 1), cB + hstep, voffB); PG8_STAGE(PG8_SA(0, 1), cA + hstep, voffA);
        if (wr == 1) PG8_BAR;
        PG8_WAIT_V(4); PG8_BAR;
        PG8_STAGE(PG8_SB(1, 0), cB + kstep, voffB); PG8_STAGE(PG8_SA(1, 0), cA + kstep, voffA); PG8_STAGE(PG8_SB(1, 1), cB + hstep + kstep, voffB);
        PG8_WAIT_V(6); PG8_BAR;
    }
    for (;;) {
        const bool has_next = S.next(ui + 1, nxt);
        const char* nA = has_next ? (const char*)g.A + (size_t)nxt.pm * tstep : cA; const char* nB = has_next ? (const char*)g.Bt + (size_t)nxt.pn * tstep : cB;
        for (int t = 0; t < nt; t += 2) {
            const bool last = (t == nt - 2);
            const char* a1 = cA + (size_t)(t + 1) * kstep;
            const char* a2 = last ? nA : cA + (size_t)(t + 2) * kstep; const char* b2 = last ? nB : cB + (size_t)(t + 2) * kstep;
            const char* a3 = a2 + kstep; const char* b3 = b2 + kstep;
            if (last && has_next) S.a_ready(nxt);
            if constexpr (SP2) {
            PG8_LDB(B0, 0, 0); PG8_LDB(B1, 0, 1); PG8_SCHED; PG8_LDA(At, 0, 0); PG8_STAGE(PG8_SA(1, 1), a1 + hstep, voffA);
            PG8_WAIT_V(8); PG8_WAIT_L(0); PG8_BAR; PG8_MMA(0, 0, At, B0); PG8_MMA(0, 1, At, B1); PG8_BAR; PG8_SCHED;
            PG8_LDA(At, 0, 1); PG8_STAGE(PG8_SB(0, 0), b2, voffB); PG8_STAGE(PG8_SB(0, 1), b2 + hstep, voffB); PG8_STAGE(PG8_SA(0, 0), a2, voffA);
            PG8_WAIT_V(8); PG8_WAIT_L(0); PG8_BAR; PG8_MMA(1, 0, At, B0); PG8_MMA(1, 1, At, B1); PG8_BAR; PG8_SCHED;
            PG8_LDB(B0, 1, 0); PG8_LDB(B1, 1, 1); PG8_SCHED; PG8_LDA(At, 1, 0); PG8_STAGE(PG8_SA(0, 1), a2 + hstep, voffA);
            PG8_WAIT_V(8); PG8_WAIT_L(0); PG8_BAR; PG8_MMA(0, 0, At, B0); PG8_MMA(0, 1, At, B1); PG8_BAR; PG8_SCHED;
            PG8_LDA(At, 1, 1); PG8_STAGE(PG8_SB(1, 0), b3, voffB); PG8_STAGE(PG8_SB(1, 1), b3 + hstep, voffB); PG8_STAGE(PG8_SA(1, 0), a3, voffA);
            PG8_WAIT_V(8); PG8_WAIT_L(0); PG8_BAR; PG8_MMA(1, 0, At, B0); PG8_MMA(1, 1, At, B1); PG8_BAR; PG8_SCHED;
            } else {
            PG8_LDB(B0, 0, 0); PG8_SCHED; PG8_LDA(At, 0, 0); PG8_STAGE(PG8_SA(1, 1), a1 + hstep, voffA);
            PG8_WAIT_L(8); PG8_BAR; PG8_WAIT_L(0); PG8_MMA(0, 0, At, B0); PG8_BAR; PG8_SCHED;
            PG8_LDB(B1, 0, 1); PG8_STAGE(PG8_SB(0, 0), b2, voffB);
            PG8_BAR; PG8_WAIT_L(0); PG8_MMA(0, 1, At, B1); PG8_BAR;
            PG8_LDA(At, 0, 1); PG8_STAGE(PG8_SA(0, 0), a2, voffA);
            PG8_BAR; PG8_WAIT_L(0); PG8_MMA(1, 0, At, B0); PG8_BAR; PG8_SCHED;
            PG8_STAGE(PG8_SB(0, 1), b2 + hstep, voffB);
            PG8_WAIT_V(6); PG8_BAR; PG8_MMA(1, 1, At, B1); PG8_BAR;
            PG8_LDB(B0, 1, 0); PG8_SCHED; PG8_LDA(At, 1, 0); PG8_STAGE(PG8_SA(0, 1), a2 + hstep, voffA);
            PG8_WAIT_L(8); PG8_BAR; PG8_WAIT_L(0); PG8_MMA(0, 0, At, B0); PG8_BAR; PG8_SCHED;
            PG8_LDB(B1, 1, 1); PG8_STAGE(PG8_SB(1, 0), b3, voffB);
            PG8_BAR; PG8_WAIT_L(0); PG8_MMA(0, 1, At, B1); PG8_BAR;
            PG8_LDA(At, 1, 1); PG8_STAGE(PG8_SA(1, 0), a3, voffA);
            PG8_BAR; PG8_WAIT_L(0); PG8_MMA(1, 0, At, B0); PG8_BAR; PG8_SCHED;
            PG8_STAGE(PG8_SB(1, 1), b3 + hstep, voffB);
            PG8_WAIT_V(6); PG8_BAR; PG8_MMA(1, 1, At, B1); PG8_BAR;
            }
        }
        if constexpr (ALIGN_EPI) { if (wr == 0) PG8_BAR; }
        if constexpr (!Epi::AFTER_DRAIN) { E(acc, cur, wr, wc, fr, fq); S.done(cur); }
        if (!has_next) break;
#pragma unroll
        for (int a = 0; a < 2; ++a)
#pragma unroll
            for (int b = 0; b < 2; ++b)
#pragma unroll
                for (int m = 0; m < 4; ++m)
#pragma unroll
                    for (int n = 0; n < 2; ++n) acc[a][b][m][n] = (f32x4){0.f, 0.f, 0.f, 0.f};
        cur = nxt; cA = nA; cB = nB; ++ui;
        if constexpr (ALIGN_EPI) { if (wr == 1) PG8_BAR; }
    }
    PG8_WAIT_V(0);
    if constexpr (!ALIGN_EPI) { if (wr == 0) PG8_BAR; }
    PG8_BAR;
    if constexpr (Epi::AFTER_DRAIN) { E.fused(acc, cur, wr, wc, fr, fq, lds, wid, lane); S.done(cur); }
#undef PG8_SA
#undef PG8_SB
#undef PG8_STAGE
#undef PG8_LDA
#undef PG8_LDB
#undef PG8_MMA
#undef PG8_WAIT_V
#undef PG8_WAIT_L
#undef PG8_BAR
#undef PG8_SCHED
}
}

#define LAS __attribute__((address_space(3)))
using pg8::bf16_t; using pg8::bf16x8; using pg8::f32x4; using pg8::u32x4; using pg8::Unit;
typedef float f32x16 __attribute__((ext_vector_type(16)));
typedef short s16x4 __attribute__((ext_vector_type(4)));
typedef unsigned u32x2 __attribute__((ext_vector_type(2)));

constexpr int DM = 1024, NBAT = 8, SEQ = 2048, DBAT = 16, DSEQ = 64, PAST = 2048, ALEN = 512;
constexpr int MP = NBAT * SEQ, MS = DBAT * DSEQ, MTOK = MP + MS;
constexpr int HW = 512;
constexpr int NIN = 5120;
constexpr int DFF = 2816, NUP = 2 * DFF;
constexpr float EPS = 1e-6f, LOG2E = 1.4426950408889634f, QSCALE = 0.125f * LOG2E;

constexpr size_t O_Y = 0;
constexpr size_t O_KA_P = (size_t)MTOK * DM;
constexpr size_t O_VA_P = O_KA_P + (size_t)NBAT * ALEN * HW;
constexpr size_t O_KB_P = O_VA_P + (size_t)NBAT * ALEN * HW;
constexpr size_t O_VB_P = O_KB_P + (size_t)NBAT * SEQ * HW;
constexpr size_t O_LF_P = O_VB_P + (size_t)NBAT * SEQ * HW;
constexpr size_t O_CV_P = O_LF_P + (size_t)NBAT * SEQ * 8;
constexpr size_t O_KA_S = O_CV_P + (size_t)NBAT * 2 * NUP;
constexpr size_t O_VA_S = O_KA_S + (size_t)MS * HW;
constexpr size_t O_KB_S = O_VA_S + (size_t)MS * HW;
constexpr size_t O_VB_S = O_KB_S + (size_t)MS * HW;
constexpr size_t O_LF_S = O_VB_S + (size_t)MS * HW;
constexpr size_t O_CV_S = O_LF_S + (size_t)MS * 8;
constexpr size_t O_END = O_CV_S + (size_t)DBAT * 2 * NUP;
static_assert(O_END == 41304064, "output size");

constexpr size_t MiB = 1u << 20;
constexpr size_t WS_CTL = 0, CTL_BYTES = 131072;
constexpr int CW_CNT1 = 8192, CW_CNT2 = 12288, CW_CNT3 = 16384, CW_TC1 = 20480, CW_TC2 = 21504, CW_TC3 = 22528;
constexpr size_t WS_WIN = 1 * MiB, WS_WUP = 11 * MiB, WS_WDN = 22 * MiB, WS_WOUT = 28 * MiB, WS_WPA = 30 * MiB, WS_WPB = 31 * MiB;
constexpr size_t WS_H = 32 * MiB;
constexpr size_t WS_OA = 264 * MiB, WS_OB = 236 * MiB;
constexpr size_t WS_QKV = 66 * MiB;
constexpr size_t QKV_STRIDE = (size_t)MTOK * HW;
constexpr size_t WS_GA = 168 * MiB, WS_GB = 202 * MiB;
constexpr size_t WS_T = 66 * MiB;
constexpr size_t WS_X1 = 100 * MiB;
constexpr size_t WS_MG = 134 * MiB;
constexpr size_t WS_U = 66 * MiB;
constexpr size_t WS_A2 = 160 * MiB;
constexpr size_t WS_HEAD = 254 * MiB, WS_TAIL = 258 * MiB;
constexpr size_t WS_XB1 = 262 * MiB, WS_XB2 = WS_XB1 + 262144, WS_XB3 = WS_XB2 + 262144;
constexpr size_t WS_XT1 = WS_XB3 + 262144, WS_XT2 = WS_XT1 + 65536, WS_XT3 = WS_XT2 + 65536;
constexpr size_t WS_RS2 = WS_XT3 + 65536;
constexpr size_t WS_RS1 = WS_RS2 + 131072;
constexpr size_t WS_END = 281 * MiB;
static_assert(WS_A2 + (size_t)MTOK * DFF * 2 <= WS_END && WS_U + (size_t)MTOK * DFF * 2 <= WS_A2, "ws map");

constexpr int RING_BYTES = 131072, LDS_BYTES = 147456;

struct Args { const float* in[22]; float* out; unsigned char* ws; int ph_lo, ph_hi, coop, pad; };
enum { I_XP = 0, I_XS, I_CKA, I_CVA, I_CKB, I_CVB, I_CLF, I_CONV, I_G1, I_G2, I_G3, I_G4, I_WIN, I_BF, I_REL, I_WPA, I_WPB, I_WOUT, I_WUP, I_CW, I_CB, I_WDN };

__device__ __forceinline__ void lds_barrier() { asm volatile("s_waitcnt lgkmcnt(0)" ::: "memory"); __builtin_amdgcn_s_barrier(); asm volatile("" ::: "memory"); }
__device__ __forceinline__ int lane_id() { return (int)__builtin_amdgcn_mbcnt_hi(~0u, __builtin_amdgcn_mbcnt_lo(~0u, 0u)); }
__device__ __forceinline__ unsigned f2bf(float f) { unsigned u = __builtin_bit_cast(unsigned, f); return (u + 0x7fffu + ((u >> 16) & 1u)) >> 16; }
__device__ __forceinline__ unsigned pk2(float lo, float hi) { return pg8::cvt_pk_bf16(lo, hi); }
__device__ __forceinline__ float bflo(unsigned w) { return __uint_as_float(w << 16); }
__device__ __forceinline__ float bfhi(unsigned w) { return __uint_as_float(w & 0xffff0000u); }
__device__ __forceinline__ float wave_sum(float v) {
#pragma unroll
    for (int o = 1; o < 64; o <<= 1) v += __shfl_xor(v, o);
    return v;
}
__device__ __forceinline__ float sigmoidf_(float x) { return __builtin_amdgcn_rcpf(1.0f + __builtin_amdgcn_exp2f(-x * LOG2E)); }
__device__ __forceinline__ const float* xrow_ptr(const Args& a, int m) { return m < MP ? a.in[I_XP] + (size_t)m * DM : a.in[I_XS] + (size_t)(m - MP) * DM; }

#define EPI_MAIN_CALL \
    __device__ __forceinline__ void operator()(const f32x4 (&acc)[2][2][4][2], const Unit& u, int wr, int wc, int fr, int fq) const { \
        _Pragma("unroll") for (int ai = 0; ai < 2; ++ai) _Pragma("unroll") for (int m = 0; m < 4; ++m) { \
            const int row = u.pm * 256 + ai * 128 + wr * 64 + m * 16 + fr; \
            _Pragma("unroll") for (int bj = 0; bj < 2; ++bj) store8(row, u.pn * 256 + bj * 128 + wc * 32 + 8 * fq, acc[ai][bj][m][0], acc[ai][bj][m][1]); } }
struct EpiIn {
    static constexpr bool PERM = true, AFTER_DRAIN = false;
    unsigned char* ws; float* out;
    __device__ __forceinline__ void store8(int row, int col, f32x4 v0, f32x4 v1) const {
        const int pn = col >> 8, seg = pn >> 1;
        bf16_t* bdst; int pitch, cl; float sc = 1.f; const bool sig = pn >= 12;
        if (!sig) { bdst = (bf16_t*)(ws + WS_QKV) + (size_t)seg * QKV_STRIDE; pitch = HW; cl = col & 511; if (seg == 0 || seg == 3) sc = QSCALE; }
        else { bdst = (bf16_t*)(ws + (pn < 16 ? WS_GA : WS_GB)); pitch = DM; cl = (col - 3072) & 1023; }
        if (sig) {
#pragma unroll
            for (int e = 0; e < 4; ++e) { v0[e] = sigmoidf_(v0[e]); v1[e] = sigmoidf_(v1[e]); }
        } else { v0 = v0 * sc; v1 = v1 * sc; }
        u32x4 w; w.x = pk2(v0[0], v0[1]); w.y = pk2(v0[2], v0[3]); w.z = pk2(v1[0], v1[1]); w.w = pk2(v1[2], v1[3]);
        *(u32x4*)(bdst + (size_t)row * pitch + cl) = w;
    }
    EPI_MAIN_CALL
};
struct EpiProjA {
    static constexpr bool PERM = true, AFTER_DRAIN = false;
    const bf16_t* G; bf16_t* T;
    __device__ __forceinline__ void store8(int row, int c, f32x4 v0, f32x4 v1) const {
        const u32x4 g = *(const u32x4*)(G + (size_t)row * DM + c);
        v0[0] *= bflo(g.x); v0[1] *= bfhi(g.x); v0[2] *= bflo(g.y); v0[3] *= bfhi(g.y);
        v1[0] *= bflo(g.z); v1[1] *= bfhi(g.z); v1[2] *= bflo(g.w); v1[3] *= bfhi(g.w);
        u32x4 w; w.x = pk2(v0[0], v0[1]); w.y = pk2(v0[2], v0[3]); w.z = pk2(v1[0], v1[1]); w.w = pk2(v1[2], v1[3]);
        *(u32x4*)(T + (size_t)row * DM + c) = w;
    }
    EPI_MAIN_CALL
};
struct EpiProjB {
    static constexpr bool PERM = true, AFTER_DRAIN = false;
    const bf16_t* G; const bf16_t* T; bf16_t* MG;
    __device__ __forceinline__ void store8(int row, int c, f32x4 v0, f32x4 v1) const {
        const u32x4 g = *(const u32x4*)(G + (size_t)row * DM + c);
        const u32x4 tw = *(const u32x4*)(T + (size_t)row * DM + c);
        const f32x4 t0 = {bflo(tw.x), bfhi(tw.x), bflo(tw.y), bfhi(tw.y)}, t1 = {bflo(tw.z), bfhi(tw.z), bflo(tw.w), bfhi(tw.w)};
        v0[0] = t0[0] + v0[0] * bflo(g.x); v0[1] = t0[1] + v0[1] * bfhi(g.x); v0[2] = t0[2] + v0[2] * bflo(g.y); v0[3] = t0[3] + v0[3] * bfhi(g.y);
        v1[0] = t1[0] + v1[0] * bflo(g.z); v1[1] = t1[1] + v1[1] * bfhi(g.z); v1[2] = t1[2] + v1[2] * bflo(g.w); v1[3] = t1[3] + v1[3] * bfhi(g.w);
        u32x4 w; w.x = pk2(v0[0], v0[1]); w.y = pk2(v0[2], v0[3]); w.z = pk2(v1[0], v1[1]); w.w = pk2(v1[2], v1[3]);
        *(u32x4*)(MG + (size_t)row * DM + c) = w;
    }
    EPI_MAIN_CALL
};
struct EpiF32 {
    static constexpr bool PERM = true, AFTER_DRAIN = false;
    bf16_t* T;
    __device__ __forceinline__ void store8(int row, int c, f32x4 v0, f32x4 v1) const {
        u32x4 w; w.x = pk2(v0[0], v0[1]); w.y = pk2(v0[2], v0[3]); w.z = pk2(v1[0], v1[1]); w.w = pk2(v1[2], v1[3]);
        *(u32x4*)(T + (size_t)row * DM + c) = w;
    }
    EPI_MAIN_CALL
};

__device__ __forceinline__ bf16x8 frag_perm(const u32x4 v, const int paddr) {
    u32x4 r; r.x = (unsigned)__builtin_amdgcn_ds_bpermute(paddr, (int)v.x); r.y = (unsigned)__builtin_amdgcn_ds_bpermute(paddr, (int)v.y);
    r.z = (unsigned)__builtin_amdgcn_ds_bpermute(paddr, (int)v.z); r.w = (unsigned)__builtin_amdgcn_ds_bpermute(paddr, (int)v.w);
    return __builtin_bit_cast(bf16x8, r);
}
template <class Epi>
__device__ __forceinline__ void small_gemm_range(LAS unsigned char* lds, const bf16_t* A, const bf16_t* Bt, const int K, const int ubeg, const int uend, const int ustride, const Epi& E, const int wv) {
    int lane_ = lane_id(); asm volatile("" : "+v"(lane_));
    const int lane = lane_, fr = lane & 15, fq = lane >> 4, tid = wv * 64 + lane;
    const int kw = K >> 3;
    LAS float* red = (LAS float*)lds;
    for (int u = ubeg; u < uend; u += ustride) {
        const int rc = u & 15, cc = u >> 4;
        const bf16_t* Ap = A + (size_t)(MP + rc * 64 + (lane >> 2)) * K + wv * kw + 8 * (lane & 3);
        const bf16_t* Bp = Bt + (size_t)(cc * 64 + (lane >> 2)) * K + wv * kw + 8 * (lane & 3);
        const int paddr = ((lane & 15) * 4 + (lane >> 4)) * 4;
        f32x4 acc[4][4];
#pragma unroll
        for (int m = 0; m < 4; ++m)
#pragma unroll
            for (int n = 0; n < 4; ++n) acc[m][n] = (f32x4){0.f, 0.f, 0.f, 0.f};
#pragma unroll 4
        for (int ks = 0; ks < kw; ks += 32) {
            u32x4 ar[4], br[4]; bf16x8 af[4], bfr[4];
#pragma unroll
            for (int m = 0; m < 4; ++m) { ar[m] = *(const u32x4*)(Ap + (size_t)(m * 16) * K + ks); br[m] = *(const u32x4*)(Bp + (size_t)(m * 16) * K + ks); }
#pragma unroll
            for (int m = 0; m < 4; ++m) { af[m] = frag_perm(ar[m], paddr); bfr[m] = frag_perm(br[m], paddr); }
#pragma unroll
            for (int m = 0; m < 4; ++m)
#pragma unroll
                for (int n = 0; n < 4; ++n) acc[m][n] = __builtin_amdgcn_mfma_f32_16x16x32_bf16(bfr[n], af[m], acc[m][n], 0, 0, 0);
        }
#pragma unroll
        for (int m = 0; m < 4; ++m)
#pragma unroll
            for (int n = 0; n < 4; ++n) *(LAS f32x4*)(red + (wv * 64 + 16 * m + fr) * 68 + 16 * n + 4 * fq) = acc[m][n];
        __syncthreads();
        const int r = tid >> 3, c8 = (tid & 7) * 8;
        f32x4 s0 = {0.f, 0.f, 0.f, 0.f}, s1 = {0.f, 0.f, 0.f, 0.f};
#pragma unroll
        for (int w = 0; w < 8; ++w) { s0 += *(const LAS f32x4*)(red + (w * 64 + r) * 68 + c8); s1 += *(const LAS f32x4*)(red + (w * 64 + r) * 68 + c8 + 4); }
        E.store8(MP + rc * 64 + r, cc * 64 + c8, s0, s1);
        __syncthreads();
    }
}
template <class Epi>
__device__ __forceinline__ void small_gemm(LAS unsigned char* lds, const bf16_t* A, const bf16_t* Bt, const int K, const int N, const Epi& E, const int wv) {
    small_gemm_range<Epi>(lds, A, Bt, K, (int)blockIdx.x, 16 * (N >> 6), (int)gridDim.x, E, wv);
}
struct TailStat { float* xs; unsigned* cnt; };
__device__ __forceinline__ float tail_row_stat(const TailStat& st, const float part8, const int rc, const int cc, const int r, const int tid) {
    float p = part8; p += __shfl_xor(p, 1); p += __shfl_xor(p, 2); p += __shfl_xor(p, 4);
    if ((tid & 7) == 0) __hip_atomic_store(st.xs + (size_t)(rc * 64 + r) * 16 + cc, p, __ATOMIC_RELAXED, __HIP_MEMORY_SCOPE_AGENT);
    asm volatile("s_waitcnt vmcnt(0)" ::: "memory"); __syncthreads();
    if (tid == 0) {
        __hip_atomic_fetch_add(st.cnt + 64 * rc, 1u, __ATOMIC_RELAXED, __HIP_MEMORY_SCOPE_AGENT);
        while (__hip_atomic_load(st.cnt + 64 * rc, __ATOMIC_RELAXED, __HIP_MEMORY_SCOPE_AGENT) < 16u) __builtin_amdgcn_s_sleep(1);
        __builtin_amdgcn_fence(__ATOMIC_ACQUIRE, "agent");
    }
    __syncthreads();
    float q = 0.f;
#pragma unroll
    for (int j = 0; j < 16; ++j) q += __hip_atomic_load(st.xs + (size_t)(rc * 64 + r) * 16 + j, __ATOMIC_RELAXED, __HIP_MEMORY_SCOPE_AGENT);
    return 1.0f / sqrtf(q * (1.0f / DM) + EPS);
}
template <int MODE>
__device__ __forceinline__ void small_gemm_norm(LAS unsigned char* lds, const bf16_t* A, const bf16_t* Bt, const int K, const float* xin, float* y, float* RS2, bf16_t* H, const float* ga,
                                                const TailStat st1, const TailStat st2, const int wv) {
    int lane_ = lane_id(); asm volatile("" : "+v"(lane_));
    const int lane = lane_, fr = lane & 15, fq = lane >> 4, tid = wv * 64 + lane;
    const int kw = K >> 3, u = blockIdx.x, rc = u & 15, cc = u >> 4;
    LAS float* red = (LAS float*)lds;
    const bf16_t* Ap = A + (size_t)(MP + rc * 64 + (lane >> 2)) * K + wv * kw + 8 * (lane & 3);
    const bf16_t* Bp = Bt + (size_t)(cc * 64 + (lane >> 2)) * K + wv * kw + 8 * (lane & 3);
    const int paddr = ((lane & 15) * 4 + (lane >> 4)) * 4;
    f32x4 acc[4][4];
#pragma unroll
    for (int m = 0; m < 4; ++m)
#pragma unroll
        for (int n = 0; n < 4; ++n) acc[m][n] = (f32x4){0.f, 0.f, 0.f, 0.f};
#pragma unroll 4
    for (int ks = 0; ks < kw; ks += 32) {
        u32x4 ar[4], br[4]; bf16x8 af[4], bfr[4];
#pragma unroll
        for (int m = 0; m < 4; ++m) { ar[m] = *(const u32x4*)(Ap + (size_t)(m * 16) * K + ks); br[m] = *(const u32x4*)(Bp + (size_t)(m * 16) * K + ks); }
#pragma unroll
        for (int m = 0; m < 4; ++m) { af[m] = frag_perm(ar[m], paddr); bfr[m] = frag_perm(br[m], paddr); }
#pragma unroll
        for (int m = 0; m < 4; ++m)
#pragma unroll
            for (int n = 0; n < 4; ++n) acc[m][n] = __builtin_amdgcn_mfma_f32_16x16x32_bf16(bfr[n], af[m], acc[m][n], 0, 0, 0);
    }
#pragma unroll
    for (int m = 0; m < 4; ++m)
#pragma unroll
        for (int n = 0; n < 4; ++n) *(LAS f32x4*)(red + (wv * 64 + 16 * m + fr) * 68 + 16 * n + 4 * fq) = acc[m][n];
    __syncthreads();
    const int r = tid >> 3, c8 = (tid & 7) * 8;
    f32x4 s0 = {0.f, 0.f, 0.f, 0.f}, s1 = {0.f, 0.f, 0.f, 0.f};
#pragma unroll
    for (int w = 0; w < 8; ++w) { s0 += *(const LAS f32x4*)(red + (w * 64 + r) * 68 + c8); s1 += *(const LAS f32x4*)(red + (w * 64 + r) * 68 + c8 + 4); }
    const int row = rc * 64 + r, col = cc * 64 + c8;
    const float rs1 = tail_row_stat(st1, (s0[0] * s0[0] + s0[1] * s0[1]) + (s0[2] * s0[2] + s0[3] * s0[3]) + (s1[0] * s1[0] + s1[1] * s1[1]) + (s1[2] * s1[2] + s1[3] * s1[3]), rc, cc, r, tid);
    const f32x4 ga0 = *(const f32x4*)(ga + col), ga1 = *(const f32x4*)(ga + col + 4);
    float* yp = y + (size_t)(MP + row) * DM + col;
    if (MODE == 1) {
        const u32x4 xw = *(const u32x4*)(H + (size_t)(MP + row) * DM + col); const float ir2 = 1.0f / RS2[MP + row];
        const f32x4 y0 = (f32x4){bflo(xw.x), bfhi(xw.x), bflo(xw.y), bfhi(xw.y)} * ir2, y1 = (f32x4){bflo(xw.z), bfhi(xw.z), bflo(xw.w), bfhi(xw.w)} * ir2;
        *(f32x4*)yp = y0 + s0 * rs1 * ga0; *(f32x4*)(yp + 4) = y1 + s1 * rs1 * ga1;
    } else {
        const float* xp = xin + (size_t)row * DM + col;
        const f32x4 x0 = *(const f32x4*)xp + s0 * rs1 * ga0, x1 = *(const f32x4*)(xp + 4) + s1 * rs1 * ga1;
        const float rs2 = tail_row_stat(st2, (x0[0] * x0[0] + x0[1] * x0[1]) + (x0[2] * x0[2] + x0[3] * x0[3]) + (x1[0] * x1[0] + x1[1] * x1[1]) + (x1[2] * x1[2] + x1[3] * x1[3]), rc, cc, r, tid);
        if (cc == 0 && (tid & 7) == 0) RS2[MP + row] = rs2;
        const f32x4 h0 = x0 * rs2, h1 = x1 * rs2;
        u32x4 w; w.x = pk2(h0[0], h0[1]); w.y = pk2(h0[2], h0[3]); w.z = pk2(h1[0], h1[1]); w.w = pk2(h1[2], h1[3]);
        *(u32x4*)(H + (size_t)(MP + row) * DM + col) = w;
    }
    __syncthreads();
}
template <class Epi>
__device__ __forceinline__ void small_gemm_a4(LAS unsigned char* lds, const bf16_t* A, const bf16_t* Bt, const int N, const Epi& E, const int wv) {
    constexpr int K = 1024, kw = 128;
    int lane_ = lane_id(); asm volatile("" : "+v"(lane_));
    const int lane = lane_, fr = lane & 15, fq = lane >> 4, tid = wv * 64 + lane;
    const int nunits = 16 * (N >> 6), G = gridDim.x;
    LAS float* red = (LAS float*)lds;
    const int lrow = lane >> 2, lch = 8 * (lane & 3), paddr = ((lane & 15) * 4 + (lane >> 4)) * 4;
    const int rc = blockIdx.x & 15;
    bf16x8 pa[4][4];
    {   const bf16_t* Ap = A + (size_t)(MP + rc * 64 + lrow) * K + wv * kw + lch;
        u32x4 ar[4][4];
#pragma unroll
        for (int ks = 0; ks < 4; ++ks)
#pragma unroll
            for (int m = 0; m < 4; ++m) ar[ks][m] = *(const u32x4*)(Ap + (size_t)(m * 16) * K + ks * 32);
#pragma unroll
        for (int ks = 0; ks < 4; ++ks)
#pragma unroll
            for (int m = 0; m < 4; ++m) pa[ks][m] = frag_perm(ar[ks][m], paddr); }
    u32x4 br[4][4];
    if ((int)blockIdx.x < nunits) { const bf16_t* Bp = Bt + (size_t)((blockIdx.x >> 4) * 64 + lrow) * K + wv * kw + lch;
#pragma unroll
        for (int ks = 0; ks < 4; ++ks)
#pragma unroll
            for (int n = 0; n < 4; ++n) br[ks][n] = *(const u32x4*)(Bp + (size_t)(n * 16) * K + ks * 32); }
    for (int u = blockIdx.x; u < nunits; u += G) {
        const int cc = u >> 4;
        f32x4 acc[4][4];
#pragma unroll
        for (int m = 0; m < 4; ++m)
#pragma unroll
            for (int n = 0; n < 4; ++n) acc[m][n] = (f32x4){0.f, 0.f, 0.f, 0.f};
#pragma unroll
        for (int ks = 0; ks < 4; ++ks) {
            bf16x8 pb[4];
#pragma unroll
            for (int n = 0; n < 4; ++n) pb[n] = frag_perm(br[ks][n], paddr);
#pragma unroll
            for (int m = 0; m < 4; ++m)
#pragma unroll
                for (int n = 0; n < 4; ++n) acc[m][n] = __builtin_amdgcn_mfma_f32_16x16x32_bf16(pb[n], pa[ks][m], acc[m][n], 0, 0, 0);
        }
        { const int un = u + G < nunits ? u + G : u;
          const bf16_t* Bp = Bt + (size_t)((un >> 4) * 64 + lrow) * K + wv * kw + lch;
#pragma unroll
          for (int ks = 0; ks < 4; ++ks)
#pragma unroll
              for (int n = 0; n < 4; ++n) br[ks][n] = *(const u32x4*)(Bp + (size_t)(n * 16) * K + ks * 32); }
#pragma unroll
        for (int m = 0; m < 4; ++m)
#pragma unroll
            for (int n = 0; n < 4; ++n) *(LAS f32x4*)(red + (wv * 64 + 16 * m + fr) * 68 + 16 * n + 4 * fq) = acc[m][n];
        lds_barrier();
        const int r = tid >> 3, c8 = (tid & 7) * 8;
        f32x4 s0 = {0.f, 0.f, 0.f, 0.f}, s1 = {0.f, 0.f, 0.f, 0.f};
#pragma unroll
        for (int w = 0; w < 8; ++w) { s0 += *(const LAS f32x4*)(red + (w * 64 + r) * 68 + c8); s1 += *(const LAS f32x4*)(red + (w * 64 + r) * 68 + c8 + 4); }
        E.store8(MP + rc * 64 + r, cc * 64 + c8, s0, s1);
        lds_barrier();
    }
}
template <class Epi>
__device__ __forceinline__ void small_gemm_k1024(LAS unsigned char* lds, const bf16_t* A, const bf16_t* Bt, const int N, const Epi& E, const int wv) {
    constexpr int K = 1024, kw = 128;
    const int lane = lane_id(), fr = lane & 15, fq = lane >> 4, tid = wv * 64 + lane;
    const int nunits = 16 * (N >> 6), G = gridDim.x;
    LAS float* red = (LAS float*)lds;
    int u = blockIdx.x;
    if (u >= nunits) return;
    u32x4 fa[4][4], fb[4][4];
    const int lrow = lane >> 2, lch = 8 * (lane & 3), paddr = ((lane & 15) * 4 + (lane >> 4)) * 4;
    {   const bf16_t* Ap = A + (size_t)(MP + (u & 15) * 64 + lrow) * K + wv * kw + lch; const bf16_t* Bp = Bt + (size_t)((u >> 4) * 64 + lrow) * K + wv * kw + lch;
#pragma unroll
        for (int ks = 0; ks < 4; ++ks)
#pragma unroll
            for (int m = 0; m < 4; ++m) { fa[ks][m] = *(const u32x4*)(Ap + (size_t)(m * 16) * K + ks * 32); fb[ks][m] = *(const u32x4*)(Bp + (size_t)(m * 16) * K + ks * 32); } }
    for (; u < nunits; u += G) {
        const int rc = u & 15, cc = u >> 4, nu = u + G; const bool has_next = nu < nunits;
        const bf16_t* Ap = A + (size_t)(MP + (nu & 15) * 64 + lrow) * K + wv * kw + lch; const bf16_t* Bp = Bt + (size_t)((nu >> 4) * 64 + lrow) * K + wv * kw + lch;
        f32x4 acc[4][4];
#pragma unroll
        for (int m = 0; m < 4; ++m)
#pragma unroll
            for (int n = 0; n < 4; ++n) acc[m][n] = (f32x4){0.f, 0.f, 0.f, 0.f};
#pragma unroll
        for (int ks = 0; ks < 4; ++ks) {
            bf16x8 pa[4], pb[4];
#pragma unroll
            for (int m = 0; m < 4; ++m) { pa[m] = frag_perm(fa[ks][m], paddr); pb[m] = frag_perm(fb[ks][m], paddr); }
            if (has_next) {
#pragma unroll
                for (int m = 0; m < 4; ++m) { fa[ks][m] = *(const u32x4*)(Ap + (size_t)(m * 16) * K + ks * 32); fb[ks][m] = *(const u32x4*)(Bp + (size_t)(m * 16) * K + ks * 32); }
            }
#pragma unroll
            for (int m = 0; m < 4; ++m)
#pragma unroll
                for (int n = 0; n < 4; ++n) acc[m][n] = __builtin_amdgcn_mfma_f32_16x16x32_bf16(pb[n], pa[m], acc[m][n], 0, 0, 0);
        }
#pragma unroll
        for (int m = 0; m < 4; ++m)
#pragma unroll
            for (int n = 0; n < 4; ++n) *(LAS f32x4*)(red + (wv * 64 + 16 * m + fr) * 68 + 16 * n + 4 * fq) = acc[m][n];
        __syncthreads();
        const int r = tid >> 3, c8 = (tid & 7) * 8;
        f32x4 s0 = {0.f, 0.f, 0.f, 0.f}, s1 = {0.f, 0.f, 0.f, 0.f};
#pragma unroll
        for (int w = 0; w < 8; ++w) { s0 += *(const LAS f32x4*)(red + (w * 64 + r) * 68 + c8); s1 += *(const LAS f32x4*)(red + (w * 64 + r) * 68 + c8 + 4); }
        E.store8(MP + rc * 64 + r, cc * 64 + c8, s0, s1);
        __syncthreads();
    }
}
template <int CTRL> __device__ __forceinline__ float dppf(float old, float src) {
    return __builtin_bit_cast(float, __builtin_amdgcn_update_dpp(__builtin_bit_cast(int, old), __builtin_bit_cast(int, src), CTRL, 0xf, 0xf, false));
}
__device__ __forceinline__ float gelu_tanh(float x) {
    const float u = 1.5957691216057308f * (x + 0.044715f * x * x * x);
    return x * __builtin_amdgcn_rcpf(1.0f + __builtin_amdgcn_exp2f(-u * LOG2E));
}
struct EpiUpFused {
    static constexpr bool PERM = true, AFTER_DRAIN = false;
    bf16_t* A2; float* out; const float* cw; const float* cb; const float* st; float* head; float* tail; LAS float* halo;
    __device__ __forceinline__ void operator()(const f32x4 (&acc)[2][2][4][2], const Unit& u, int wr, int wc, int fr, int fq) const {
        const int pm = u.pm, gt = u.pn; const bool samp = pm >= 64;
        const int colq = wc * 32 + 8 * fq, oc = gt * 128 + colq;
#pragma unroll
        for (int ai = 0; ai < 2; ++ai) {
            const int g = ai * 2 + wr;
            if (fr >= 14) {
                const int r = fr - 14;
                float* cdst = nullptr;
                if (samp) cdst = out + O_CV_S + ((size_t)((pm - 64) * 4 + g) * 2 + r) * NUP;
                else if (g == 3) cdst = ((pm & 7) == 7) ? out + O_CV_P + ((size_t)(pm >> 3) * 2 + r) * NUP : tail + ((size_t)pm * 2 + r) * NUP;
#pragma unroll
                for (int bj = 0; bj < 2; ++bj) {
                    const f32x4 v0 = acc[ai][bj][3][0], v1 = acc[ai][bj][3][1];
                    LAS float* hp = halo + ((g * 2 + r) * 2 + bj) * 128 + colq;
                    *(LAS f32x4*)hp = v0; *(LAS f32x4*)(hp + 4) = v1;
                    if (cdst) { *(f32x4*)(cdst + bj * DFF + oc) = v0; *(f32x4*)(cdst + bj * DFF + oc + 4) = v1; }
                }
            }
        }
        const bool defer = !samp && (pm & 7) != 0;
        if (defer && wr == 0 && fr < 2) {
            float* hd = head + ((size_t)pm * 2 + fr) * NUP;
#pragma unroll
            for (int bj = 0; bj < 2; ++bj) { *(f32x4*)(hd + bj * DFF + oc) = acc[0][bj][0][0]; *(f32x4*)(hd + bj * DFF + oc + 4) = acc[0][bj][0][1]; }
        }
        f32x4 wg[3], wq[3], bg, bq;
#pragma unroll
        for (int k = 0; k < 3; ++k) { wg[k] = *(const f32x4*)(cw + (size_t)k * NUP + oc); wq[k] = *(const f32x4*)(cw + (size_t)k * NUP + DFF + oc); }
        bg = *(const f32x4*)(cb + oc); bq = *(const f32x4*)(cb + DFF + oc);
        asm volatile("s_waitcnt lgkmcnt(0)" ::: "memory"); __builtin_amdgcn_s_barrier(); asm volatile("" ::: "memory");
        u32x2 keep[2][4];
#pragma unroll
        for (int n = 0; n < 2; ++n) {
            if (n == 1) {
#pragma unroll
                for (int k = 0; k < 3; ++k) { wg[k] = *(const f32x4*)(cw + (size_t)k * NUP + oc + 4); wq[k] = *(const f32x4*)(cw + (size_t)k * NUP + DFF + oc + 4); }
                bg = *(const f32x4*)(cb + oc + 4); bq = *(const f32x4*)(cb + DFF + oc + 4);
            }
#pragma unroll
            for (int ai = 0; ai < 2; ++ai) {
                const int g = ai * 2 + wr;
                f32x4 xm1[2];
                xm1[0] = (f32x4){0.f, 0.f, 0.f, 0.f}; xm1[1] = (f32x4){0.f, 0.f, 0.f, 0.f};
                if (fr >= 14) {
                    const int r = fr - 14;
                    if (samp) { const float* sp = st + ((size_t)((pm - 64) * 4 + g) * 2 + r) * NUP; xm1[0] = *(const f32x4*)(sp + oc + 4 * n); xm1[1] = *(const f32x4*)(sp + DFF + oc + 4 * n); }
                    else if (g > 0) { const LAS float* hp = halo + (((g - 1) * 2 + r) * 2) * 128 + colq + 4 * n; xm1[0] = *(const LAS f32x4*)hp; xm1[1] = *(const LAS f32x4*)(hp + 128); }
                }
#pragma unroll
                for (int m = 0; m < 4; ++m) {
                    const size_t row = (size_t)pm * 256 + g * 64 + m * 16 + fr;
                    float res[4];
#pragma unroll
                    for (int e = 0; e < 4; ++e) {
                        const float xg = acc[ai][0][m][n][e], xgp = (m == 0) ? xm1[0][e] : acc[ai][0][m > 0 ? m - 1 : 0][n][e];
                        const float xv = acc[ai][1][m][n][e], xvp = (m == 0) ? xm1[1][e] : acc[ai][1][m > 0 ? m - 1 : 0][n][e];
                        const float g1 = dppf<0x111>(dppf<0x121>(0.f, xgp), xg), g2 = dppf<0x112>(dppf<0x122>(0.f, xgp), xg);
                        const float v1 = dppf<0x111>(dppf<0x121>(0.f, xvp), xv), v2 = dppf<0x112>(dppf<0x122>(0.f, xvp), xv);
                        const float yg = bg[e] + wg[0][e] * g2 + wg[1][e] * g1 + wg[2][e] * xg;
                        const float yv = bq[e] + wq[0][e] * v2 + wq[1][e] * v1 + wq[2][e] * xv;
                        res[e] = gelu_tanh(yg) * yv;
                    }
                    u32x2 w; w.x = pk2(res[0], res[1]); w.y = pk2(res[2], res[3]);
                    if (n == 0) keep[ai][m] = w;
                    else if (!(defer && g == 0 && m == 0 && fr < 2)) { u32x4 ww; ww.x = keep[ai][m].x; ww.y = keep[ai][m].y; ww.z = w.x; ww.w = w.y; *(u32x4*)(A2 + row * DFF + oc) = ww; }
                    asm volatile("" ::: "memory");
                }
            }
        }
    }
};
__device__ __forceinline__ void ffn_fixup(const Args& a, const int pm, const int tid) {
    if (pm >= 64 || (pm & 7) == 0) return;
    const float* head = (const float*)(a.ws + WS_HEAD) + (size_t)pm * 2 * NUP; const float* tail = (const float*)(a.ws + WS_TAIL) + (size_t)(pm - 1) * 2 * NUP;
    const float* cw = a.in[I_CW]; const float* cb = a.in[I_CB]; bf16_t* A2 = (bf16_t*)(a.ws + WS_A2);
    for (int it = tid; it < 704; it += 512) {
        const int r = it >= 352 ? 1 : 0, oc = (it - r * 352) * 8;
        const float* x0 = r == 0 ? tail : tail + NUP; const float* x1 = r == 0 ? tail + NUP : head; const float* x2 = r == 0 ? head : head + NUP;
        float y[2][8];
#pragma unroll
        for (int hh = 0; hh < 2; ++hh) { const int c = hh * DFF + oc;
#pragma unroll
            for (int q = 0; q < 2; ++q) {
                const f32x4 bb = *(const f32x4*)(cb + c + 4 * q), w0 = *(const f32x4*)(cw + c + 4 * q), w1 = *(const f32x4*)(cw + NUP + c + 4 * q), w2 = *(const f32x4*)(cw + 2 * NUP + c + 4 * q);
                const f32x4 a0 = *(const f32x4*)(x0 + c + 4 * q), a1 = *(const f32x4*)(x1 + c + 4 * q), a2 = *(const f32x4*)(x2 + c + 4 * q);
#pragma unroll
                for (int e = 0; e < 4; ++e) y[hh][4 * q + e] = bb[e] + w0[e] * a0[e] + w1[e] * a1[e] + w2[e] * a2[e];
            } }
        float res[8];
#pragma unroll
        for (int e = 0; e < 8; ++e) res[e] = gelu_tanh(y[0][e]) * y[1][e];
        u32x4 w; w.x = pk2(res[0], res[1]); w.y = pk2(res[2], res[3]); w.z = pk2(res[4], res[5]); w.w = pk2(res[6], res[7]);
        *(u32x4*)(A2 + ((size_t)pm * 256 + r) * DFF + oc) = w;
    }
}

struct RowStat {
    float* xbuf; unsigned* cnt;
    __device__ __forceinline__ void run(const f32x4 (&v)[2][2][4][2], const Unit& u, int wr, int wc, int fr, int fq, LAS unsigned char* lds, int wid, int lane) const {
        LAS float* P = (LAS float*)lds; LAS float* S = (LAS float*)(lds + 4096);
#pragma unroll
        for (int ai = 0; ai < 2; ++ai)
#pragma unroll
            for (int m = 0; m < 4; ++m) { float s = 0.f;
#pragma unroll
                for (int bj = 0; bj < 2; ++bj)
#pragma unroll
                    for (int n = 0; n < 2; ++n) { const f32x4 x = v[ai][bj][m][n]; s += (x[0] * x[0] + x[1] * x[1]) + (x[2] * x[2] + x[3] * x[3]); }
                s += __shfl_xor(s, 16); s += __shfl_xor(s, 32);
                if (fq == 0) P[(ai * 128 + wr * 64 + m * 16 + fr) * 4 + wc] = s; }
        asm volatile("s_waitcnt lgkmcnt(0)" ::: "memory"); __builtin_amdgcn_s_barrier(); asm volatile("" ::: "memory");
        const int tid = wid * 64 + lane;
        if (tid < 256) { const f32x4 p = *(const LAS f32x4*)(P + tid * 4);
            __hip_atomic_store(xbuf + ((size_t)u.pm * 256 + tid) * 4 + u.pn, (p[0] + p[1]) + (p[2] + p[3]), __ATOMIC_RELAXED, __HIP_MEMORY_SCOPE_AGENT); }
        asm volatile("s_waitcnt vmcnt(0)" ::: "memory"); __builtin_amdgcn_s_barrier(); asm volatile("" ::: "memory");
        if (tid == 0) {
            __hip_atomic_fetch_add(cnt + 64 * u.pm, 1u, __ATOMIC_RELAXED, __HIP_MEMORY_SCOPE_AGENT);
            while (__hip_atomic_load(cnt + 64 * u.pm, __ATOMIC_RELAXED, __HIP_MEMORY_SCOPE_AGENT) < 4u) __builtin_amdgcn_s_sleep(1);
            __builtin_amdgcn_fence(__ATOMIC_ACQUIRE, "agent");
        }
        asm volatile("s_waitcnt vmcnt(0) lgkmcnt(0)" ::: "memory"); __builtin_amdgcn_s_barrier(); asm volatile("" ::: "memory");
        if (tid < 256) { const float* slot = xbuf + ((size_t)u.pm * 256 + tid) * 4; float q = 0.f;
#pragma unroll
            for (int t = 0; t < 4; ++t) q += __hip_atomic_load(slot + t, __ATOMIC_RELAXED, __HIP_MEMORY_SCOPE_AGENT);
            S[tid] = 1.0f / sqrtf(q * (1.0f / DM) + EPS); }
        asm volatile("s_waitcnt vmcnt(0) lgkmcnt(0)" ::: "memory"); __builtin_amdgcn_s_barrier(); asm volatile("" ::: "memory");
    }
};
struct EpiOutNorm {
    static constexpr bool PERM = true, AFTER_DRAIN = true;
    const float* RS1; float* RS2; bf16_t* H; const float* g2; RowStat st1, st2;
    __device__ __forceinline__ void fused(f32x4 (&acc)[2][2][4][2], const Unit& u, int wr, int wc, int fr, int fq, LAS unsigned char* lds, int wid, int lane) const {
        st1.run(acc, u, wr, wc, fr, fq, lds, wid, lane);
        const LAS float* S = (const LAS float*)(lds + 4096);
        const int c0 = u.pn * 256 + wc * 32 + 8 * fq;
#pragma unroll
        for (int ai = 0; ai < 2; ++ai)
#pragma unroll
            for (int m = 0; m < 4; ++m) { const int rl = ai * 128 + wr * 64 + m * 16 + fr; const size_t row = (size_t)u.pm * 256 + rl; const float rs = S[rl]; const float ir1 = 1.0f / RS1[row];
#pragma unroll
                for (int bj = 0; bj < 2; ++bj) { const int c = c0 + bj * 128;
                    const u32x4 hw = *(const u32x4*)(H + row * DM + c);
                    const f32x4 xa = (f32x4){bflo(hw.x), bfhi(hw.x), bflo(hw.y), bfhi(hw.y)} * ir1 + acc[ai][bj][m][0] * rs * *(const f32x4*)(g2 + c);
                    const f32x4 xb = (f32x4){bflo(hw.z), bfhi(hw.z), bflo(hw.w), bfhi(hw.w)} * ir1 + acc[ai][bj][m][1] * rs * *(const f32x4*)(g2 + c + 4);
                    acc[ai][bj][m][0] = xa; acc[ai][bj][m][1] = xb; }
                asm volatile("" : "+v"(acc[ai][0][m][0]), "+v"(acc[ai][0][m][1]), "+v"(acc[ai][1][m][0]), "+v"(acc[ai][1][m][1]));
                asm volatile("" ::: "memory"); }
        st2.run(acc, u, wr, wc, fr, fq, lds, wid, lane);
#pragma unroll
        for (int ai = 0; ai < 2; ++ai)
#pragma unroll
            for (int m = 0; m < 4; ++m) { const int rl = ai * 128 + wr * 64 + m * 16 + fr; const size_t row = (size_t)u.pm * 256 + rl; const float rs = S[rl];
                if (u.pn == 0 && wc == 0 && fq == 0) RS2[row] = rs;
#pragma unroll
                for (int bj = 0; bj < 2; ++bj) { const int c = c0 + bj * 128;
                    const f32x4 v0 = acc[ai][bj][m][0] * rs, v1 = acc[ai][bj][m][1] * rs;
                    u32x4 w; w.x = pk2(v0[0], v0[1]); w.y = pk2(v0[2], v0[3]); w.z = pk2(v1[0], v1[1]); w.w = pk2(v1[2], v1[3]);
                    *(u32x4*)(H + row * DM + c) = w; } }
    }
};
struct EpiDownNorm {
    static constexpr bool PERM = true, AFTER_DRAIN = true;
    const bf16_t* H; const float* RS2; float* y; const float* g4; RowStat st;
    __device__ __forceinline__ void fused(f32x4 (&acc)[2][2][4][2], const Unit& u, int wr, int wc, int fr, int fq, LAS unsigned char* lds, int wid, int lane) const {
        st.run(acc, u, wr, wc, fr, fq, lds, wid, lane);
        const LAS float* S = (const LAS float*)(lds + 4096);
        const int c0 = u.pn * 256 + wc * 32 + 8 * fq;
#pragma unroll
        for (int ai = 0; ai < 2; ++ai)
#pragma unroll
            for (int m = 0; m < 4; ++m) { const int rl = ai * 128 + wr * 64 + m * 16 + fr; const size_t row = (size_t)u.pm * 256 + rl; const float rs = S[rl]; const float ir2 = 1.0f / RS2[row];
#pragma unroll
                for (int bj = 0; bj < 2; ++bj) { const int c = c0 + bj * 128;
                    const u32x4 xw = *(const u32x4*)(H + row * DM + c);
                    const f32x4 xa = (f32x4){bflo(xw.x), bfhi(xw.x), bflo(xw.y), bfhi(xw.y)} * ir2, xb = (f32x4){bflo(xw.z), bfhi(xw.z), bflo(xw.w), bfhi(xw.w)} * ir2;
                    *(f32x4*)(y + row * DM + c) = xa + acc[ai][bj][m][0] * rs * *(const f32x4*)(g4 + c);
                    *(f32x4*)(y + row * DM + c + 4) = xb + acc[ai][bj][m][1] * rs * *(const f32x4*)(g4 + c + 4); }
                asm volatile("" ::: "memory"); }
    }
};

__device__ __forceinline__ void p0_transpose_item(const float* W, int N, int K, bf16_t* WT, int k0, int src_n0, int dst_n0, LAS float* scr, int lane, const float* kscale = nullptr) {
    float tv[32];
#pragma unroll
    for (int i = 0; i < 32; ++i) tv[i] = W[(size_t)(k0 + 2 * i + (lane >> 5)) * N + src_n0 + (lane & 31)];
    if (kscale) {
#pragma unroll
        for (int i = 0; i < 32; ++i) tv[i] *= kscale[k0 + 2 * i + (lane >> 5)];
    }
#pragma unroll
    for (int i = 0; i < 32; ++i) scr[(2 * i + (lane >> 5)) * 33 + (lane & 31)] = tv[i];
    asm volatile("s_waitcnt lgkmcnt(0)" ::: "memory");
    const int c = lane & 7;
#pragma unroll
    for (int j = 0; j < 4; ++j) { const int n = (lane >> 3) + 8 * j; const LAS float* s = scr + (8 * c) * 33 + n;
        u32x4 o; o.x = pk2(s[0 * 33], s[1 * 33]); o.y = pk2(s[2 * 33], s[3 * 33]); o.z = pk2(s[4 * 33], s[5 * 33]); o.w = pk2(s[6 * 33], s[7 * 33]);
        *(u32x4*)(WT + (size_t)(dst_n0 + n) * K + k0 + 8 * c) = o; }
    asm volatile("s_waitcnt lgkmcnt(0)" ::: "memory");
}

constexpr int TI_IN = 16 * 160, TI_PA = 8 * 32, TI_PB = 8 * 32, TI_OUT = 16 * 32, TI_UP = 16 * 176, TI_DN = 44 * 32;
constexpr int TI_ALL = TI_IN + TI_PA + TI_PB + TI_OUT + TI_UP + TI_DN;
__device__ __forceinline__ void transpose_item(const Args& a, const int it, LAS float* scr, const int lane) {
    unsigned char* ws = a.ws; int r = it;
    if (r < TI_IN) { const int kb = r / 160, nb = r % 160, d0 = nb * 32; p0_transpose_item(a.in[I_WIN], 5128, DM, (bf16_t*)(ws + WS_WIN), kb * 64, d0 + (d0 >= 3072 ? 8 : 0), d0, scr, lane, a.in[I_G1]); return; } r -= TI_IN;
    if (r < TI_PA) { const int kb = r / 32, nb = r % 32; p0_transpose_item(a.in[I_WPA], DM, HW, (bf16_t*)(ws + WS_WPA), kb * 64, nb * 32, nb * 32, scr, lane); return; } r -= TI_PA;
    if (r < TI_PB) { const int kb = r / 32, nb = r % 32; p0_transpose_item(a.in[I_WPB], DM, HW, (bf16_t*)(ws + WS_WPB), kb * 64, nb * 32, nb * 32, scr, lane); return; } r -= TI_PB;
    if (r < TI_OUT) { const int kb = r / 32, nb = r % 32; p0_transpose_item(a.in[I_WOUT], DM, DM, (bf16_t*)(ws + WS_WOUT), kb * 64, nb * 32, nb * 32, scr, lane); return; } r -= TI_OUT;
    if (r < TI_UP) { const int kb = r / 176, nb = r % 176, d0 = nb * 32, tile = d0 >> 8, w = d0 & 255; const int s0 = (w < 128) ? tile * 128 + w : DFF + tile * 128 + (w - 128);
        p0_transpose_item(a.in[I_WUP], NUP, DM, (bf16_t*)(ws + WS_WUP), kb * 64, s0, d0, scr, lane, a.in[I_G3]); return; } r -= TI_UP;
    { const int kb = r / 32, nb = r % 32; p0_transpose_item(a.in[I_WDN], DM, DFF, (bf16_t*)(ws + WS_WDN), kb * 64, nb * 32, nb * 32, scr, lane); }
}
__device__ __forceinline__ void phase_prologue(const Args& a, LAS unsigned char* lds, const int wv) {
    const int lane = lane_id(), wave = wv, tid = wv * 64 + lane;
    const int G = gridDim.x, gw = blockIdx.x * 8 + wave, NGW = G * 8;
    unsigned char* ws = a.ws;
    LAS float* scr = (LAS float*)(lds + wave * 8448);
    LAS float* wfg = (LAS float*)(lds + 69632);
    {
        const float* win = a.in[I_WIN]; const float* g1 = a.in[I_G1];
        for (int k = tid; k < DM; k += 512) {
            const f32x4 w0 = *(const f32x4*)(win + (size_t)k * 5128 + 3072), w1 = *(const f32x4*)(win + (size_t)k * 5128 + 3076); const float g = g1[k];
            wfg[0 * DM + k] = w0[0] * g; wfg[1 * DM + k] = w0[1] * g; wfg[2 * DM + k] = w0[2] * g; wfg[3 * DM + k] = w0[3] * g;
            wfg[4 * DM + k] = w1[0] * g; wfg[5 * DM + k] = w1[1] * g; wfg[6 * DM + k] = w1[2] * g; wfg[7 * DM + k] = w1[3] * g;
        }
    }
    __syncthreads();
    for (int it = gw; it < TI_IN; it += NGW) transpose_item(a, it, scr, lane);
    const float* g1 = a.in[I_G1]; const float* bfp = a.in[I_BF];
    f32x4 gv[4];
#pragma unroll
    for (int j = 0; j < 4; ++j) gv[j] = *(const f32x4*)(g1 + 4 * lane + 256 * j);
    bf16_t* H = (bf16_t*)(ws + WS_H);
    constexpr int RB = 4;
    for (int mb = (NGW - 1 - gw) * RB; mb < MTOK; mb += NGW * RB) {
        f32x4 v[RB][4]; float ss[RB], z[RB][8];
#pragma unroll
        for (int i = 0; i < RB; ++i) { const float* xr = xrow_ptr(a, mb + i);
#pragma unroll
            for (int j = 0; j < 4; ++j) v[i][j] = *(const f32x4*)(xr + 4 * lane + 256 * j); }
#pragma unroll
        for (int i = 0; i < RB; ++i) { ss[i] = 0.f;
#pragma unroll
            for (int j = 0; j < 4; ++j) ss[i] += (v[i][j][0] * v[i][j][0] + v[i][j][1] * v[i][j][1]) + (v[i][j][2] * v[i][j][2] + v[i][j][3] * v[i][j][3]); }
#pragma unroll
        for (int q = 0; q < 8; ++q) {
            f32x4 w[4];
#pragma unroll
            for (int j = 0; j < 4; ++j) w[j] = *(const LAS f32x4*)(wfg + q * DM + 4 * lane + 256 * j);
#pragma unroll
            for (int i = 0; i < RB; ++i) { float s = 0.f;
#pragma unroll
                for (int j = 0; j < 4; ++j) s += (v[i][j][0] * w[j][0] + v[i][j][1] * w[j][1]) + (v[i][j][2] * w[j][2] + v[i][j][3] * w[j][3]);
                z[i][q] = s; }
        }
#pragma unroll
        for (int i = 0; i < RB; ++i) {
            const int m = mb + i;
            const float sst = wave_sum(ss[i]);
#pragma unroll
            for (int q = 0; q < 8; ++q) z[i][q] = wave_sum(z[i][q]);
            const float rs = 1.0f / sqrtf(sst * (1.0f / DM) + EPS);
#pragma unroll
            for (int j = 0; j < 4; ++j) {
                u32x2 o; o.x = pk2(v[i][j][0] * rs, v[i][j][1] * rs); o.y = pk2(v[i][j][2] * rs, v[i][j][3] * rs);
                *(u32x2*)(H + (size_t)m * DM + 4 * lane + 256 * j) = o;
            }
            if (lane == 0) ((float*)(ws + WS_RS1))[m] = rs;
            float zz = z[i][0];
#pragma unroll
            for (int q = 1; q < 8; ++q) zz = (lane == q) ? z[i][q] : zz;
            if (lane < 8) {
                const float t = zz * rs + bfp[lane];
                const float lf = fminf(t, 0.f) - log1pf(expf(-fabsf(t)));
                float* dst = m < MP ? a.out + O_LF_P + (size_t)m * 8 : a.out + O_LF_S + (size_t)(m - MP) * 8;
                dst[lane] = lf;
            }
        }
    }
}

__device__ __forceinline__ void phase_rows1(const Args& a, const int wv) {
    const int lane = lane_id(), wave = wv; const int gw = blockIdx.x * 8 + wave, NGW = gridDim.x * 8;
    const bf16_t* T = (const bf16_t*)(a.ws + WS_T); bf16_t* H = (bf16_t*)(a.ws + WS_H);
    f32x4 g2[4], g3[4];
#pragma unroll
    for (int j = 0; j < 4; ++j) { g2[j] = *(const f32x4*)(a.in[I_G2] + 4 * lane + 256 * j); g3[j] = *(const f32x4*)(a.in[I_G3] + 4 * lane + 256 * j); }
    constexpr int RB = 2;
    for (int mb = MP + gw * RB; mb < MTOK; mb += NGW * RB) {
        f32x4 t[RB][4], x[RB][4];
#pragma unroll
        for (int i = 0; i < RB; ++i) { const float* xr = xrow_ptr(a, mb + i); const bf16_t* tr = T + (size_t)(mb + i) * DM;
#pragma unroll
            for (int j = 0; j < 4; ++j) { const u32x2 tw = *(const u32x2*)(tr + 4 * lane + 256 * j); t[i][j] = (f32x4){bflo(tw.x), bfhi(tw.x), bflo(tw.y), bfhi(tw.y)}; x[i][j] = *(const f32x4*)(xr + 4 * lane + 256 * j); } }
#pragma unroll
        for (int i = 0; i < RB; ++i) {
            const int m = mb + i; float ss = 0.f;
#pragma unroll
            for (int j = 0; j < 4; ++j) ss += (t[i][j][0] * t[i][j][0] + t[i][j][1] * t[i][j][1]) + (t[i][j][2] * t[i][j][2] + t[i][j][3] * t[i][j][3]);
            const float rs = 1.0f / sqrtf(wave_sum(ss) * (1.0f / DM) + EPS);
            float s2 = 0.f;
#pragma unroll
            for (int j = 0; j < 4; ++j) { x[i][j] = x[i][j] + t[i][j] * rs * g2[j]; s2 += (x[i][j][0] * x[i][j][0] + x[i][j][1] * x[i][j][1]) + (x[i][j][2] * x[i][j][2] + x[i][j][3] * x[i][j][3]);
                *(f32x4*)(a.out + O_Y + (size_t)m * DM + 4 * lane + 256 * j) = x[i][j]; }
            const float r2 = 1.0f / sqrtf(wave_sum(s2) * (1.0f / DM) + EPS);
#pragma unroll
            for (int j = 0; j < 4; ++j) { u32x2 o; o.x = pk2(x[i][j][0] * r2 * g3[j][0], x[i][j][1] * r2 * g3[j][1]); o.y = pk2(x[i][j][2] * r2 * g3[j][2], x[i][j][3] * r2 * g3[j][3]);
                *(u32x2*)(H + (size_t)m * DM + 4 * lane + 256 * j) = o; }
        }
    }
}
__device__ __forceinline__ void phase_rows2(const Args& a, const int wv) {
    const int lane = lane_id(), wave = wv; const int gw = blockIdx.x * 8 + wave, NGW = gridDim.x * 8;
    const bf16_t* T = (const bf16_t*)(a.ws + WS_T);
    f32x4 g4[4];
#pragma unroll
    for (int j = 0; j < 4; ++j) g4[j] = *(const f32x4*)(a.in[I_G4] + 4 * lane + 256 * j);
    constexpr int RB = 2;
    for (int mb = MP + gw * RB; mb < MTOK; mb += NGW * RB) {
        f32x4 t[RB][4], x[RB][4];
#pragma unroll
        for (int i = 0; i < RB; ++i) { const bf16_t* tr = T + (size_t)(mb + i) * DM; const float* yr = a.out + O_Y + (size_t)(mb + i) * DM;
#pragma unroll
            for (int j = 0; j < 4; ++j) { const u32x2 tw = *(const u32x2*)(tr + 4 * lane + 256 * j); t[i][j] = (f32x4){bflo(tw.x), bfhi(tw.x), bflo(tw.y), bfhi(tw.y)}; x[i][j] = *(const f32x4*)(yr + 4 * lane + 256 * j); } }
#pragma unroll
        for (int i = 0; i < RB; ++i) {
            float* yr = a.out + O_Y + (size_t)(mb + i) * DM; float ss = 0.f;
#pragma unroll
            for (int j = 0; j < 4; ++j) ss += (t[i][j][0] * t[i][j][0] + t[i][j][1] * t[i][j][1]) + (t[i][j][2] * t[i][j][2] + t[i][j][3] * t[i][j][3]);
            const float rs = 1.0f / sqrtf(wave_sum(ss) * (1.0f / DM) + EPS);
#pragma unroll
            for (int j = 0; j < 4; ++j) *(f32x4*)(yr + 4 * lane + 256 * j) = x[i][j] + t[i][j] * rs * g4[j];
        }
    }
}


constexpr int AL_K = 0, AL_KB = 64 * 144, AL_V = 2 * AL_KB, AL_VB = 8192, AL_WS = AL_V + 2 * AL_VB, AL_CS = AL_WS + 8 * 256, AL_TAB = AL_CS + 2112 * 4, AL_MISC = AL_TAB + 260 * 4;
constexpr int N_ATT_UNITS = 1280, N_TR_UNITS = (TI_ALL - TI_IN + 7) / 8;
__device__ __forceinline__ int crow(int r, int hi) { return (r & 3) + 8 * (r >> 2) + 4 * hi; }
__device__ __forceinline__ float halfswap_max(float m) { auto rr = __builtin_amdgcn_permlane32_swap(__float_as_uint(m), __float_as_uint(m), false, false); return fmaxf(__uint_as_float(rr[0]), __uint_as_float(rr[1])); }
__device__ __forceinline__ float halfswap_sum(float m) { auto rr = __builtin_amdgcn_permlane32_swap(__float_as_uint(m), __float_as_uint(m), false, false); return __uint_as_float(rr[0]) + __uint_as_float(rr[1]); }

__device__ __forceinline__ void pv_step(f32x16* o, f32x16& lacc, unsigned vb, bf16x8 pa0, bf16x8 pa1, bf16x8 pa2, bf16x8 pa3) {
#pragma unroll
    for (int d0 = 0; d0 < 2; ++d0) { s16x4 lo[4], hh[4];
#pragma unroll
        for (int ks = 0; ks < 4; ++ks) {
            asm volatile("ds_read_b64_tr_b16 %0,%1 offset:%c2" : "=&v"(lo[ks]) : "v"(vb), "i"(d0 * 4096 + ks * 1024) : "memory");
            asm volatile("ds_read_b64_tr_b16 %0,%1 offset:%c2" : "=&v"(hh[ks]) : "v"(vb), "i"(d0 * 4096 + ks * 1024 + 512) : "memory"); }
        if (d0 == 0) {
            __builtin_amdgcn_sched_barrier(0);
            const u32x4 one4 = {0x3F803F80u, 0x3F803F80u, 0x3F803F80u, 0x3F803F80u}; const bf16x8 ones = __builtin_bit_cast(bf16x8, one4);
            lacc = __builtin_amdgcn_mfma_f32_32x32x16_bf16(pa0, ones, lacc, 0, 0, 0); lacc = __builtin_amdgcn_mfma_f32_32x32x16_bf16(pa1, ones, lacc, 0, 0, 0);
            lacc = __builtin_amdgcn_mfma_f32_32x32x16_bf16(pa2, ones, lacc, 0, 0, 0); lacc = __builtin_amdgcn_mfma_f32_32x32x16_bf16(pa3, ones, lacc, 0, 0, 0);
            __builtin_amdgcn_sched_barrier(0);
        }
        asm volatile("s_waitcnt lgkmcnt(0)" ::: "memory"); __builtin_amdgcn_sched_barrier(0);
#define PK_(k) (bf16x8){lo[k][0], lo[k][1], lo[k][2], lo[k][3], hh[k][0], hh[k][1], hh[k][2], hh[k][3]}
        o[d0] = __builtin_amdgcn_mfma_f32_32x32x16_bf16(pa0, PK_(0), o[d0], 0, 0, 0);
        o[d0] = __builtin_amdgcn_mfma_f32_32x32x16_bf16(pa1, PK_(1), o[d0], 0, 0, 0);
        o[d0] = __builtin_amdgcn_mfma_f32_32x32x16_bf16(pa2, PK_(2), o[d0], 0, 0, 0);
        o[d0] = __builtin_amdgcn_mfma_f32_32x32x16_bf16(pa3, PK_(3), o[d0], 0, 0, 0);
#undef PK_
    }
}

template <int KIND>
__device__ __forceinline__ void attn_unit(const Args& a, LAS unsigned char* lds, int b, int h, int blk, int samp, const int wv, unsigned* qctr, LAS unsigned* qnext) {
    int lane_ = lane_id(); asm volatile("" : "+v"(lane_));
    const int lane = lane_, r32 = lane & 31, hi = lane >> 5, wid = wv, tid = wv * 64 + lane;
    const bf16_t* QKV = (const bf16_t*)(a.ws + WS_QKV);
    const bf16_t* Qb = QKV + (size_t)(KIND == 0 ? 0 : 3) * QKV_STRIDE; const bf16_t* Kb = Qb + QKV_STRIDE; const bf16_t* Vb = Kb + QKV_STRIDE;
    bf16_t* Ob = (bf16_t*)(a.ws + (KIND == 0 ? WS_OA : WS_OB));
    const float* Kc = a.in[KIND == 0 ? I_CKA : I_CKB]; const float* Vc = a.in[KIND == 0 ? I_CVA : I_CVB];
    constexpr int CT = (KIND == 0) ? 8 : 32;
    int t_lo, t_hi, w_lo, w_hi, qrow, cch = 0, qpos = 0;
    if (KIND == 0) {
        if (!samp) { const int c0 = 4 * blk; cch = c0 + (wid >> 1); t_lo = c0 - 8 < 0 ? 0 : c0 - 8; t_hi = c0 + 3; w_lo = cch - 8 < 0 ? 0 : cch - 8; w_hi = cch; qrow = b * SEQ + 64 * cch + 32 * (wid & 1); qpos = 32 * (wid & 1) + r32; }
        else { cch = 8; t_lo = 0; t_hi = 8; w_lo = 0; w_hi = wid < 2 ? 8 : -1; qrow = MP + b * DSEQ + 32 * (wid & 1); qpos = 32 * (wid & 1) + r32; }
    } else {
        if (!samp) { t_lo = 0; t_hi = 4 * blk + 3; w_lo = 0; w_hi = 4 * blk + (wid >> 1); qrow = b * SEQ + 256 * blk + 32 * wid; qpos = 256 * blk + 32 * wid + r32; }
        else { t_lo = 0; t_hi = 32; w_lo = 0; w_hi = wid < 2 ? 32 : -1; qrow = MP + b * DSEQ + 32 * (wid & 1); qpos = PAST + 32 * (wid & 1) + r32; }
    }
    const bool active = w_hi >= w_lo;
    LAS float* wsf = (LAS float*)(lds + AL_WS) + wid * 64;
    LAS float* cs = (LAS float*)(lds + AL_CS);
    LAS float* tab = (LAS float*)(lds + AL_TAB);
    LAS float* misc = (LAS float*)(lds + AL_MISC);
    lds_barrier();
    bf16x8 qr[4];
#pragma unroll
    for (int dk = 0; dk < 4; ++dk) qr[dk] = active ? *(const bf16x8*)(Qb + (size_t)(qrow + r32) * HW + h * 64 + dk * 16 + hi * 8) : (bf16x8){0, 0, 0, 0, 0, 0, 0, 0};
    const int srow = tid >> 3, sch = tid & 7;
    const unsigned kst = AL_K + srow * 144 + sch * 16, vst = AL_V + (sch >> 2) * 4096 + srow * 64 + (sch & 3) * 16;
    struct Stage { u32x4 k, v; f32x4 kf0, kf1, vf0, vf1; bool f; };
    Stage sA, sB; sA.f = false; sB.f = false;
    auto issue = [&](int tq, Stage& s) {
        const int t = tq > t_hi ? t_hi : tq;
        if (samp && t < CT) { const unsigned off = ((unsigned)(b * (64 * CT) + 64 * t + srow) * 8u + h) * 64u + sch * 8;
            s.kf0 = *(const f32x4*)(Kc + off); s.kf1 = *(const f32x4*)(Kc + off + 4); s.vf0 = *(const f32x4*)(Vc + off); s.vf1 = *(const f32x4*)(Vc + off + 4); s.f = true; }
        else { const unsigned row = samp ? (unsigned)(MP + b * DSEQ + srow) : (unsigned)(b * SEQ + 64 * t + srow); const unsigned off = row * HW + h * 64 + sch * 8;
            s.k = *(const u32x4*)(Kb + off); s.v = *(const u32x4*)(Vb + off); s.f = false; }
    };
    auto commit = [&](int buf, int t, Stage& s) {
        u32x4 kreg = s.k, vreg = s.v;
        if (s.f) { kreg.x = pk2(s.kf0[0], s.kf0[1]); kreg.y = pk2(s.kf0[2], s.kf0[3]); kreg.z = pk2(s.kf1[0], s.kf1[1]); kreg.w = pk2(s.kf1[2], s.kf1[3]);
                   vreg.x = pk2(s.vf0[0], s.vf0[1]); vreg.y = pk2(s.vf0[2], s.vf0[3]); vreg.z = pk2(s.vf1[0], s.vf1[1]); vreg.w = pk2(s.vf1[2], s.vf1[3]); }
        *(LAS u32x4*)(lds + kst + buf * AL_KB) = kreg; *(LAS u32x4*)(lds + vst + buf * AL_VB) = vreg;
        float* kd = nullptr; float* vd = nullptr;
        if (samp) { if (t == CT) { const unsigned o = (unsigned)(b * DSEQ + srow) * HW + h * 64 + sch * 8; kd = a.out + (KIND == 0 ? O_KA_S : O_KB_S) + o; vd = a.out + (KIND == 0 ? O_VA_S : O_VB_S) + o; } }
        else if (KIND == 1) { if (t >= 4 * blk) { const unsigned o = (unsigned)(b * SEQ + 64 * t + srow) * HW + h * 64 + sch * 8; kd = a.out + O_KB_P + o; vd = a.out + O_VB_P + o; } }
        else { if (t >= 4 * blk && t >= 24) { const unsigned o = (unsigned)(b * ALEN + 64 * (t - 24) + srow) * HW + h * 64 + sch * 8; kd = a.out + O_KA_P + o; vd = a.out + O_VA_P + o; } }
        if (kd) {
            *(f32x4*)kd = (f32x4){bflo(kreg.x), bfhi(kreg.x), bflo(kreg.y), bfhi(kreg.y)}; *(f32x4*)(kd + 4) = (f32x4){bflo(kreg.z), bfhi(kreg.z), bflo(kreg.w), bfhi(kreg.w)};
            *(f32x4*)vd = (f32x4){bflo(vreg.x), bfhi(vreg.x), bflo(vreg.y), bfhi(vreg.y)}; *(f32x4*)(vd + 4) = (f32x4){bflo(vreg.z), bfhi(vreg.z), bflo(vreg.w), bfhi(vreg.w)};
        }
    };
    issue(t_lo, sA); issue(t_lo + 1, sB);
    if (KIND == 0) {
        for (int i = tid; i < 257; i += 512) tab[i] = a.in[I_REL][h * 257 + i] * LOG2E;
    } else {
        const int n0 = samp ? PAST : 256 * (blk + 1);
        const float* src = samp ? a.in[I_CLF] + (size_t)b * PAST * 8 + h : a.out + O_LF_P + (size_t)b * SEQ * 8 + h;
        float v[4];
#pragma unroll
        for (int j = 0; j < 4; ++j) { const int idx = 4 * tid + j; v[j] = idx < n0 ? src[(size_t)idx * 8] : 0.f; }
        v[1] += v[0]; v[2] += v[1]; v[3] += v[2];
        float inc = v[3];
#pragma unroll
        for (int o = 1; o < 64; o <<= 1) { const float t = __shfl_up(inc, o); if (lane >= o) inc += t; }
        if (lane == 63) misc[wid] = inc;
        __syncthreads();
        float off = inc - v[3];
#pragma unroll
        for (int w = 0; w < 8; ++w) if (w < wid) off += misc[w];
        if (4 * tid < n0) { f32x4 o4 = {(off + v[0]) * LOG2E, (off + v[1]) * LOG2E, (off + v[2]) * LOG2E, (off + v[3]) * LOG2E}; *(LAS f32x4*)(cs + 4 * tid) = o4; }
        if (samp) {
            __syncthreads();
            if (wid == 0) {
                float x = a.out[O_LF_S + (size_t)(b * DSEQ + lane) * 8 + h];
#pragma unroll
                for (int o = 1; o < 64; o <<= 1) { const float t = __shfl_up(x, o); if (lane >= o) x += t; }
                cs[PAST + lane] = cs[PAST - 1] + x * LOG2E;
            }
        }
    }
    commit(0, t_lo, sA);
    __syncthreads();
    f32x16 o[2];
#pragma unroll
    for (int r = 0; r < 16; ++r) { o[0][r] = 0.f; o[1][r] = 0.f; }
    float mhat = (KIND == 1 && active) ? -cs[qpos] : 0.f;
    f32x16 lacc;
#pragma unroll
    for (int r = 0; r < 16; ++r) lacc[r] = 0.f;
    const unsigned lds0 = (unsigned)(uintptr_t)lds;
    const unsigned vb0 = lds0 + AL_V + ((lane >> 4) & 1) * 32 + (lane & 3) * 8 + (4 * hi + ((lane & 15) >> 2)) * 64;
    auto tile = [&](const int t, const int buf) {
        if (active && t >= w_lo && t <= w_hi) {
            const LAS unsigned char* Kt = lds + AL_K + buf * AL_KB + r32 * 144 + hi * 16;
            f32x16 p0, p1; const float nmh = -mhat;
            if (KIND == 0) {
                const int delta = cch - t;
                if (delta >= 3) { const float bb = tab[256] + nmh;
#pragma unroll
                    for (int r = 0; r < 16; ++r) { p0[r] = bb; p1[r] = bb; } }
                else { int base = 64 * delta + qpos - 4 * hi + 128; asm volatile("" : "+v"(base));
#pragma unroll
                    for (int r = 0; r < 16; ++r) { const int kv = (r & 3) + 8 * (r >> 2); int i0 = base - kv, i1 = base - kv - 32;
                        i0 = i0 < 0 ? 0 : (i0 > 256 ? 256 : i0); i1 = i1 < 0 ? 0 : (i1 > 256 ? 256 : i1); p0[r] = tab[i0] + nmh; p1[r] = tab[i1] + nmh; } }
            } else {
                const LAS float* ct = cs + 64 * t + 4 * hi;
#pragma unroll
                for (int g = 0; g < 4; ++g) { const f32x4 c0 = *(const LAS f32x4*)(ct + 8 * g), c1 = *(const LAS f32x4*)(ct + 32 + 8 * g);
#pragma unroll
                    for (int e = 0; e < 4; ++e) { p0[4 * g + e] = nmh - c0[e]; p1[4 * g + e] = nmh - c1[e]; } }
            }
#pragma unroll
            for (int dk = 0; dk < 4; ++dk) {
                const bf16x8 a0 = *(const LAS bf16x8*)(Kt + dk * 32), a1 = *(const LAS bf16x8*)(Kt + 32 * 144 + dk * 32);
                p0 = __builtin_amdgcn_mfma_f32_32x32x16_bf16(a0, qr[dk], p0, 0, 0, 0);
                p1 = __builtin_amdgcn_mfma_f32_32x32x16_bf16(a1, qr[dk], p1, 0, 0, 0);
            }
            if (KIND == 1) {
                if (t == w_hi) { int kb = 64 * t + 4 * hi - qpos; asm volatile("" : "+v"(kb));
#pragma unroll
                    for (int r = 0; r < 16; ++r) { const int kv = kb + (r & 3) + 8 * (r >> 2); if (kv > 0) p0[r] = -INFINITY; if (kv + 32 > 0) p1[r] = -INFINITY; } }
            }
            float mxa = fmaxf(p0[0], p1[0]), mxb = fmaxf(p0[1], p1[1]), mxc = fmaxf(p0[2], p1[2]), mxd = fmaxf(p0[3], p1[3]);
#pragma unroll
            for (int r = 4; r < 16; r += 4) { mxa = fmaxf(mxa, fmaxf(p0[r], p1[r])); mxb = fmaxf(mxb, fmaxf(p0[r + 1], p1[r + 1])); mxc = fmaxf(mxc, fmaxf(p0[r + 2], p1[r + 2])); mxd = fmaxf(mxd, fmaxf(p0[r + 3], p1[r + 3])); }
            float mx = halfswap_max(fmaxf(fmaxf(mxa, mxb), fmaxf(mxc, mxd)));
            if (__any(mx > 8.0f)) {
                const float dl = fmaxf(mx, 0.f); const float al = __builtin_amdgcn_exp2f(-dl); mhat += dl;
#pragma unroll
                for (int r = 0; r < 16; ++r) { p0[r] -= dl; p1[r] -= dl; }
                if (hi == 0) wsf[r32] = al;
#pragma unroll
                for (int g = 0; g < 4; ++g) { const f32x4 f = *(const LAS f32x4*)(wsf + 8 * g + 4 * hi);
#pragma unroll
                    for (int e = 0; e < 4; ++e) { o[0][4 * g + e] *= f[e]; o[1][4 * g + e] *= f[e]; lacc[4 * g + e] *= f[e]; } }
            }
#pragma unroll
            for (int r = 0; r < 16; ++r) { p0[r] = __builtin_amdgcn_exp2f(p0[r]); p1[r] = __builtin_amdgcn_exp2f(p1[r]); }
            u32x4 w0, w1, w2, w3;
            w0.x = pk2(p0[0], p0[1]); w0.y = pk2(p0[2], p0[3]); w0.z = pk2(p0[4], p0[5]); w0.w = pk2(p0[6], p0[7]);
            w1.x = pk2(p0[8], p0[9]); w1.y = pk2(p0[10], p0[11]); w1.z = pk2(p0[12], p0[13]); w1.w = pk2(p0[14], p0[15]);
            w2.x = pk2(p1[0], p1[1]); w2.y = pk2(p1[2], p1[3]); w2.z = pk2(p1[4], p1[5]); w2.w = pk2(p1[6], p1[7]);
            w3.x = pk2(p1[8], p1[9]); w3.y = pk2(p1[10], p1[11]); w3.z = pk2(p1[12], p1[13]); w3.w = pk2(p1[14], p1[15]);
            pv_step(o, lacc, vb0 + buf * AL_VB, __builtin_bit_cast(bf16x8, w0), __builtin_bit_cast(bf16x8, w1), __builtin_bit_cast(bf16x8, w2), __builtin_bit_cast(bf16x8, w3));
        }
    };
    for (int t = t_lo;;) {
        issue(t + 2, sA);
        tile(t, 0);
        if (t < t_hi) commit(1, t + 1, sB);
        lds_barrier();
        if (++t > t_hi) break;
        issue(t + 2, sB);
        tile(t, 1);
        if (t < t_hi) commit(0, t + 1, sA);
        lds_barrier();
        if (++t > t_hi) break;
    }
    unsigned nxt = 0u;
    if (tid == 0) nxt = atomicAdd(qctr, 1u);
    if (active) {
        float rl[16];
#pragma unroll
        for (int r = 0; r < 16; ++r) rl[r] = __builtin_amdgcn_rcpf(lacc[r]);
        LAS bf16_t* stg = (LAS bf16_t*)(lds + AL_K + wid * 4096);
#pragma unroll
        for (int r = 0; r < 16; ++r) { const int orow = crow(r, hi); stg[orow * 64 + r32] = (bf16_t)f2bf(o[0][r] * rl[r]); stg[orow * 64 + 32 + r32] = (bf16_t)f2bf(o[1][r] * rl[r]); }
#pragma unroll
        for (int i = 0; i < 4; ++i) { const int row = i * 8 + (lane >> 3), ch = lane & 7; const u32x4 v = *(const LAS u32x4*)(stg + row * 64 + ch * 8);
            *(u32x4*)(Ob + (size_t)(qrow + row) * HW + h * 64 + ch * 8) = v; }
    }
    if (tid == 0) *qnext = nxt;
}

__device__ __forceinline__ void phase_attention(const Args& a, LAS unsigned char* lds, const int wv) {
    const int tid = wv * 64 + lane_id();
    unsigned* ctr = (unsigned*)(a.ws + WS_CTL);
    LAS unsigned* sidx = (LAS unsigned*)(lds + AL_MISC + 64);
    __syncthreads();
    if (tid == 0) *sidx = atomicAdd(ctr, 1u);
    for (;;) {
        lds_barrier();
        const int i = (int)*sidx;
        if (i >= N_ATT_UNITS + N_TR_UNITS) break;
        if (i >= N_ATT_UNITS) {
            const int it = TI_IN + (i - N_ATT_UNITS) * 8 + wv;
            __syncthreads();
            int l2 = lane_id(); asm volatile("" : "+v"(l2));
            if (it < TI_ALL) transpose_item(a, it, (LAS float*)(lds + wv * 8448), l2);
            __syncthreads();
            if (tid == 0) *sidx = atomicAdd(ctr, 1u);
            continue;
        }
        if (i < 128) attn_unit<1>(a, lds, i >> 3, i & 7, 0, 1, wv, ctr, sidx);
        else if (i < 448) { const int j = i - 128; attn_unit<1>(a, lds, (j & 63) >> 3, j & 7, 7 - (j >> 6), 0, wv, ctr, sidx); }
        else if (i < 832) { const int j = i - 448; attn_unit<0>(a, lds, (j & 63) >> 3, j & 7, 7 - (j >> 6), 0, wv, ctr, sidx); }
        else if (i < 896) { const int j = i - 832; attn_unit<1>(a, lds, j >> 3, j & 7, 2, 0, wv, ctr, sidx); }
        else if (i < 1024) { const int j = i - 896; attn_unit<0>(a, lds, j >> 3, j & 7, 0, 1, wv, ctr, sidx); }
        else if (i < 1088) { const int j = i - 1024; attn_unit<0>(a, lds, j >> 3, j & 7, 1, 0, wv, ctr, sidx); }
        else if (i < 1152) { const int j = i - 1088; attn_unit<1>(a, lds, j >> 3, j & 7, 1, 0, wv, ctr, sidx); }
        else if (i < 1216) { const int j = i - 1152; attn_unit<1>(a, lds, j >> 3, j & 7, 0, 0, wv, ctr, sidx); }
        else { const int j = i - 1216; attn_unit<0>(a, lds, j >> 3, j & 7, 0, 0, wv, ctr, sidx); }
    }
}

#define XB_TMO      128
#define XB_XCNT(j)  (256  + 64 * (j))
#define XB_XSUB(j)  (1280 + 64 * (j))
#define XB_XGEN(j)  (2304 + 64 * (j))
#define XB_TOP      3328
#define XB_TOPGEN   3392
#define XCD_BAR_WORDS 3456
#define XB_SPIN_CAP (1u << 18)

__device__ __forceinline__ unsigned xb_ld(unsigned* p)              { return __hip_atomic_load(p, __ATOMIC_RELAXED, __HIP_MEMORY_SCOPE_AGENT); }
__device__ __forceinline__ unsigned xb_add(unsigned* p, unsigned v) { return __hip_atomic_fetch_add(p, v, __ATOMIC_RELAXED, __HIP_MEMORY_SCOPE_AGENT); }
__device__ __forceinline__ unsigned xb_xcc_id() { return (unsigned)__builtin_amdgcn_s_getreg((3 << 11) | 20) & 0xFu; }
#define XB_SPIN(cond, bar) do { unsigned _sp = 0; while (cond) { __builtin_amdgcn_s_sleep(1); \
    if ((++_sp & 255u) == 0u) { if (xb_ld(&(bar)[XB_TMO])) break; if (_sp > XB_SPIN_CAP) { atomicAdd(&(bar)[XB_TMO], 1u); break; } } } } while (0)

struct XcdBarrier {
    unsigned* bar; unsigned x; bool leader;
    volatile LAS unsigned* st;
};

__device__ __forceinline__ XcdBarrier xcd_barrier_post(unsigned* bar, volatile LAS unsigned* st, const bool leader) {
    XcdBarrier b; b.bar = bar; b.x = xb_xcc_id(); b.st = st; b.leader = leader;
    if (leader) (void)xb_add(&bar[XB_XCNT(b.x)], 1u);
    return b;
}
__device__ __forceinline__ void xcd_barrier_complete(unsigned* bar, unsigned x, unsigned& nloc, unsigned& nx) {
    const unsigned G = gridDim.x * gridDim.y * gridDim.z;
    unsigned sum, cnt, mine, sp = 0u;
    for (;;) {
        sum = 0u; cnt = 0u; mine = 0u;
#pragma unroll
        for (unsigned j = 0; j < 16; ++j) { const unsigned c = xb_ld(&bar[XB_XCNT(j)]); sum += c; cnt += (c > 0u) ? 1u : 0u; mine = (j == x) ? c : mine; }
        if (sum == G) break;
        __builtin_amdgcn_s_sleep(1);
        if ((++sp & 255u) == 0u) { if (xb_ld(&bar[XB_TMO])) break; if (sp > XB_SPIN_CAP) { atomicAdd(&bar[XB_TMO], 1u); break; } }
    }
    nloc = mine > 0u ? mine : 1u; nx = cnt > 0u ? cnt : 1u;
}

__device__ __forceinline__ void xcd_barrier(const XcdBarrier& b, const bool leader_now) {
    asm volatile("s_waitcnt vmcnt(0)" ::: "memory");
    __syncthreads();
    if (leader_now) {
        unsigned* bar = b.bar;
        __builtin_amdgcn_s_waitcnt(0);
        unsigned nloc = b.st[0], nx = b.st[1];
        if (nloc == 0u) { xcd_barrier_complete(bar, b.x, nloc, nx); b.st[0] = nloc; b.st[1] = nx; }
        const unsigned old = xb_add(&bar[XB_XSUB(b.x)], 1u);
        const unsigned gen = old / nloc;
        if (old + 1u == (gen + 1u) * nloc) {
            __builtin_amdgcn_fence(__ATOMIC_RELEASE, "agent");
            asm volatile("s_waitcnt vmcnt(0)" ::: "memory");
            const unsigned og = xb_add(&bar[XB_TOP], 1u);
            const unsigned tg = og / nx;
            if (og + 1u == (tg + 1u) * nx) xb_add(&bar[XB_TOPGEN], 1u);
            else XB_SPIN(xb_ld(&bar[XB_TOPGEN]) == tg, bar);
            __builtin_amdgcn_fence(__ATOMIC_ACQUIRE, "agent");
            xb_add(&bar[XB_XGEN(b.x)], 1u);
            asm volatile("s_waitcnt vmcnt(0)" ::: "memory");
        } else {
            XB_SPIN(xb_ld(&bar[XB_XGEN(b.x)]) == gen, bar);
            __builtin_amdgcn_fence(__ATOMIC_ACQUIRE, "agent");
            asm volatile("s_waitcnt vmcnt(0)" ::: "memory");
        }
    }
    __syncthreads();
}

constexpr int N_PHASES = 7;
__device__ __forceinline__ void grid_bar(unsigned* bar, unsigned& epoch, const int wv, const unsigned nblocks) {
    __syncthreads();
    epoch += 1;
    if (wv == 0 && lane_id() == 0) {
        __builtin_amdgcn_fence(__ATOMIC_RELEASE, "agent");
        asm volatile("s_waitcnt vmcnt(0)" ::: "memory");
        __hip_atomic_fetch_add(bar, 1u, __ATOMIC_RELAXED, __HIP_MEMORY_SCOPE_AGENT);
        const unsigned target = epoch * nblocks;
        while (__hip_atomic_load(bar, __ATOMIC_RELAXED, __HIP_MEMORY_SCOPE_AGENT) < target) __builtin_amdgcn_s_sleep(2);
        __builtin_amdgcn_fence(__ATOMIC_ACQUIRE, "agent");
        asm volatile("s_waitcnt vmcnt(0)" ::: "memory");
    }
    __syncthreads();
}
__global__ void __launch_bounds__(512, 2) mega_fwd(Args a) {
    extern __shared__ __attribute__((aligned(16))) unsigned char lds_raw[];
    LAS unsigned char* lds = (LAS unsigned char*)lds_raw;
    unsigned char* ws = a.ws;
    const int lo = a.ph_lo, hi = a.ph_hi, G = gridDim.x, c = (int)blockIdx.x;
    const int wv = __builtin_amdgcn_readfirstlane((int)threadIdx.x >> 6);
    volatile LAS unsigned* bst = (volatile LAS unsigned*)(lds + RING_BYTES + 12288);
    if (threadIdx.x < 2) bst[threadIdx.x] = 0u;
    __syncthreads();
    XcdBarrier xbar; xbar.bar = (unsigned*)(ws + WS_CTL) + 1024; xbar.x = 0; xbar.st = bst; xbar.leader = false;
    if (a.coop == 2) cg::this_grid().sync();
    if (a.coop) xbar = xcd_barrier_post((unsigned*)(ws + WS_CTL) + 1024, bst, wv == 0 && lane_id() == 0);
#define IN(k) (lo <= (k) && (k) < hi)
#define SEAM(k) do { if (IN(k) && IN((k) + 1)) { if (a.coop) { xcd_barrier(xbar, wv == 0 && lane_id() == 0); } } } while (0)
    if (IN(0)) phase_prologue(a, lds, wv);
    SEAM(0);
    if (IN(1)) {
        pg8::Gemm g{(const bf16_t*)(ws + WS_H), (const bf16_t*)(ws + WS_WIN), MP, NIN, DM}; pg8::StaticOrder S; S.init(MP, NIN, G, c);
        EpiIn E{ws, a.out};
        pg8::gemm_phase<EpiIn, pg8::StaticOrder, true, true>(lds, g, S, E, wv);
        small_gemm_a4<EpiIn>(lds, g.A, g.Bt, NIN, E, wv);
    }
    SEAM(1);
    if (IN(2)) phase_attention(a, lds, wv);
    SEAM(2);
    if (IN(3)) {
        { pg8::Gemm g{(const bf16_t*)(ws + WS_OA), (const bf16_t*)(ws + WS_WPA), MP, DM, HW}; pg8::StaticOrder S; S.init(MP, DM, G, c);
          EpiProjA E{(const bf16_t*)(ws + WS_GA), (bf16_t*)(ws + WS_T)};
          pg8::gemm_phase<EpiProjA, pg8::StaticOrder, true, true>(lds, g, S, E, wv);
          small_gemm<EpiProjA>(lds, g.A, g.Bt, HW, DM, E, wv); }
        { pg8::Gemm g{(const bf16_t*)(ws + WS_OB), (const bf16_t*)(ws + WS_WPB), MP, DM, HW}; pg8::StaticOrder S; S.init(MP, DM, G, c);
          EpiProjB E{(const bf16_t*)(ws + WS_GB), (const bf16_t*)(ws + WS_T), (bf16_t*)(ws + WS_MG)};
          pg8::gemm_phase<EpiProjB, pg8::StaticOrder, true, true>(lds, g, S, E, wv);
          small_gemm<EpiProjB>(lds, g.A, g.Bt, HW, DM, E, wv); }
    }
    SEAM(3);
    if (IN(4)) {
        pg8::Gemm g{(const bf16_t*)(ws + WS_MG), (const bf16_t*)(ws + WS_WOUT), MP, DM, DM}; pg8::StaticOrder S; S.init(MP, DM, G, c);
        EpiOutNorm EN{(const float*)(ws + WS_RS1), (float*)(ws + WS_RS2), (bf16_t*)(ws + WS_H), a.in[I_G2], RowStat{(float*)(ws + WS_XB1), (unsigned*)(ws + WS_CTL) + CW_CNT1}, RowStat{(float*)(ws + WS_XB2), (unsigned*)(ws + WS_CTL) + CW_CNT2}};
        pg8::gemm_phase<EpiOutNorm, pg8::StaticOrder, false, true>(lds, g, S, EN, wv);
        __syncthreads();
        small_gemm_norm<0>(lds, g.A, g.Bt, DM, a.in[I_XS], a.out + O_Y, (float*)(ws + WS_RS2), (bf16_t*)(ws + WS_H), a.in[I_G2],
                           TailStat{(float*)(ws + WS_XT1), (unsigned*)(ws + WS_CTL) + CW_TC1}, TailStat{(float*)(ws + WS_XT2), (unsigned*)(ws + WS_CTL) + CW_TC2}, wv);
    }
    SEAM(4);
    if (IN(5)) {
        pg8::Gemm g{(const bf16_t*)(ws + WS_H), (const bf16_t*)(ws + WS_WUP), MTOK, NUP, DM}; pg8::StaticOrder S; S.init(MTOK, NUP, G, c);
        EpiUpFused E{(bf16_t*)(ws + WS_A2), a.out, a.in[I_CW], a.in[I_CB], a.in[I_CONV], (float*)(ws + WS_HEAD), (float*)(ws + WS_TAIL), (LAS float*)(lds + RING_BYTES)};
        pg8::gemm_phase<EpiUpFused, pg8::StaticOrder, true, true>(lds, g, S, E, wv);
    }
    SEAM(5);
    if (IN(6)) {
        pg8::Gemm g{(const bf16_t*)(ws + WS_A2), (const bf16_t*)(ws + WS_WDN), MP, DM, DFF}; pg8::StaticOrder S; S.init(MP, DM, G, c);
        { Unit fu; for (int i = 0; S.next(i, fu); ++i) ffn_fixup(a, fu.pm, wv * 64 + lane_id()); }
        __syncthreads();
        EpiDownNorm EN{(const bf16_t*)(ws + WS_H), (const float*)(ws + WS_RS2), a.out + O_Y, a.in[I_G4], RowStat{(float*)(ws + WS_XB3), (unsigned*)(ws + WS_CTL) + CW_CNT3}};
        pg8::gemm_phase<EpiDownNorm, pg8::StaticOrder, false, true>(lds, g, S, EN, wv);
        __syncthreads();
        small_gemm_norm<1>(lds, g.A, g.Bt, DFF, nullptr, a.out + O_Y, (float*)(ws + WS_RS2), (bf16_t*)(ws + WS_H), a.in[I_G4],
                           TailStat{(float*)(ws + WS_XT3), (unsigned*)(ws + WS_CTL) + CW_TC3}, TailStat{nullptr, nullptr}, wv);
    }
#undef IN
#undef SEAM
}

#ifndef MK_N_LAUNCHES
#define MK_N_LAUNCHES 1
#endif
extern "C" void kernel_launch(void* const* d_in, const int* in_sizes, int n_in, void* d_out, int out_size, void* d_ws, size_t ws_size, hipStream_t stream) {
    static int grid = 0;
    if (grid == 0) {
        if (n_in != 22 || (size_t)out_size != O_END || ws_size < WS_END) { fprintf(stderr, "kernel_launch: unexpected sizes n_in %d out %d ws %zu\n", n_in, out_size, ws_size); grid = -1; return; }
        int dev = 0, cus = 0, per_cu = 0;
        hipGetDevice(&dev);
        hipDeviceGetAttribute(&cus, hipDeviceAttributeMultiprocessorCount, dev);
        hipFuncSetAttribute((const void*)mega_fwd, hipFuncAttributeMaxDynamicSharedMemorySize, LDS_BYTES);
        hipOccupancyMaxActiveBlocksPerMultiprocessor(&per_cu, (const void*)mega_fwd, 512, LDS_BYTES);
        if (per_cu < 1) { fprintf(stderr, "kernel_launch: occupancy query says %d blocks/CU\n", per_cu); per_cu = 1; }
        (void)hipGetLastError();
        grid = cus;
        if (grid != 256) { fprintf(stderr, "kernel_launch: built for 256 CUs (one 256x256 unit per workgroup in the fused-norm GEMMs), device has %d\n", grid); grid = -1; return; }
    }
    if (grid < 0) return;
    hipMemsetAsync((char*)d_ws + WS_CTL, 0, CTL_BYTES, stream);
    Args a{};
    for (int i = 0; i < 22; ++i) a.in[i] = (const float*)d_in[i];
    a.out = (float*)d_out; a.ws = (unsigned char*)d_ws;
#if MK_N_LAUNCHES == 1
    a.ph_lo = 0; a.ph_hi = N_PHASES; a.coop = 1; a.pad = 0;
    void* args[] = {&a};
    hipError_t e = hipLaunchCooperativeKernel((const void*)mega_fwd, dim3(grid), dim3(512), args, LDS_BYTES, stream);
    if (e != hipSuccess) fprintf(stderr, "cooperative launch failed: %s (grid %d)\n", hipGetErrorString(e), grid);
#else
    for (int p = 0; p < N_PHASES; ++p) {
        a.ph_lo = p; a.ph_hi = p + 1; a.coop = 0; a.pad = 0;
        hipLaunchKernelGGL(mega_fwd, dim3(grid), dim3(512), LDS_BYTES, stream, a);
    }
#endif
}
```

```cpp
#include <hip/hip_runtime.h>
#include <hip/hip_cooperative_groups.h>
#include <cstdio>
#include <cstdint>
namespace cg = cooperative_groups;
namespace pg8 {
#define PG8_LAS __attribute__((address_space(3)))
typedef unsigned short bf16_t;
typedef short bf16x8 __attribute__((ext_vector_type(8)));
typedef float f32x4 __attribute__((ext_vector_type(4)));
typedef unsigned u32x4 __attribute__((ext_vector_type(4)));
constexpr int BM = 256, BK = 64, HALF = 128, HTB = HALF * BK * 2  , STAGE_BYTES = 8 * HTB, NXCD = 8, WGM = 8;

__host__ __device__ __forceinline__ int lds_byte(int r, int c) { const int st = (r >> 4) * 2 + (c >> 5), rr = r & 15, cc = c & 31, ob = rr * 64 + cc * 2; return st * 1024 + (ob ^ (((ob >> 9) & 1) << 5)); }
__host__ __device__ __forceinline__ void stage_rc(int b, int& R, int& C) { const int st = b / 1024, sb = b % 1024, swz = sb ^ (((sb >> 9) & 1) << 5); R = (st >> 1) * 16 + swz / 64; C = (st & 1) * 32 + (swz % 64) / 2; }
__host__ __device__ __forceinline__ int perm32(int rho) { const int n = rho >> 4, i = rho & 15; return 8 * (i >> 2) + 4 * n + (i & 3); }

struct Unit { int pm, pn; };
struct Gemm { const bf16_t* A; const bf16_t* Bt; int M, N, K; };

struct StaticOrder {
    int nM, nN, nwg, G, c;
    __host__ __device__ void init(int M, int N, int G_, int c_) { nM = M / BM; nN = N / BM; nwg = nM * nN; G = G_; c = c_; }
    __host__ __device__ __forceinline__ bool next(int i, Unit& u) const {
        const long L = (long)i * G + c; if (L >= nwg) return false;
        int wgid = (int)L; { const int q = nwg / NXCD, r = nwg % NXCD, xcd = wgid % NXCD, off = wgid / NXCD; wgid = (xcd < r ? xcd * (q + 1) : r * (q + 1) + (xcd - r) * q) + off; }
        const int nig = WGM * nN, gid = wgid / nig, fm = gid * WGM, gsz = (nM - fm) < WGM ? (nM - fm) : WGM;
        u.pm = fm + ((wgid % nig) % gsz); u.pn = (wgid % nig) / gsz; return true;
    }
    __device__ __forceinline__ void a_ready(const Unit&) const {}
    __device__ __forceinline__ void done(const Unit&) const {}
};

__device__ __forceinline__ unsigned cvt_pk_bf16(float lo, float hi) { unsigned r; asm volatile("v_cvt_pk_bf16_f32 %0, %1, %2" : "=v"(r) : "v"(lo), "v"(hi)); return r; }
typedef float f32x2 __attribute__((ext_vector_type(2)));
template <class Epi, class Sched, bool ALIGN_EPI = false, bool SP2 = false>
__device__ __forceinline__ void gemm_phase(PG8_LAS unsigned char* lds, const Gemm g, const Sched& S, const Epi& E, const int wv) {
    const int wid = wv, lane = (int)__builtin_amdgcn_mbcnt_hi(~0u, __builtin_amdgcn_mbcnt_lo(~0u, 0u)), tid = wid * 64 + lane, wr = wid >> 2, wc = wid & 3, fr = lane & 15, fq = lane >> 4;
    const int K = g.K, nt = K / BK;
    unsigned voffA[2], voffB[2];
#pragma unroll
    for (int i = 0; i < 2; ++i) { int R, C; stage_rc(tid * 16 + i * 8192, R, C); const int Rb = Epi::PERM ? ((R & ~31) + perm32(R & 31)) : R;
        voffA[i] = (unsigned)(R * K + C) * 2u; voffB[i] = (unsigned)(Rb * K + C) * 2u; }
    const size_t kstep = (size_t)(BK * 2);
    const size_t hstep = (size_t)HALF * K * 2;
    const size_t tstep = 2 * hstep;
    const unsigned ldsw = (unsigned)wid * 1024u;
    const int aoff = lds_byte(wr * 64 + fr, fq * 8), boff = lds_byte(wc * 32 + fr, fq * 8);
#define PG8_SA(b, h) (((b) * 2 + (h)) * HTB)
#define PG8_SB(b, h) ((4 + (b) * 2 + (h)) * HTB)
#define PG8_STAGE(bufoff, gbase, voff) do { _Pragma("unroll") for (int _i = 0; _i < 2; ++_i) \
        __builtin_amdgcn_global_load_lds((const unsigned*)((const char*)(gbase) + (voff)[_i]), (PG8_LAS unsigned*)(lds + (bufoff) + ldsw + _i * 8192), 16, 0, 0); } while (0)
#define PG8_LDA(dst, b, h) do { _Pragma("unroll") for (int m = 0; m < 4; ++m) _Pragma("unroll") for (int k = 0; k < 2; ++k) dst[m][k] = *(const PG8_LAS bf16x8*)(lds + PG8_SA(b, h) + aoff + m * 2048 + k * 1024); } while (0)
#define PG8_LDB(dst, b, h) do { _Pragma("unroll") for (int n = 0; n < 2; ++n) _Pragma("unroll") for (int k = 0; k < 2; ++k) dst[n][k] = *(const PG8_LAS bf16x8*)(lds + PG8_SB(b, h) + boff + n * 2048 + k * 1024); } while (0)
#define PG8_MMA(ai, bj, At, Bt) do { __builtin_amdgcn_s_setprio(1); _Pragma("unroll") for (int m = 0; m < 4; ++m) _Pragma("unroll") for (int n = 0; n < 2; ++n) _Pragma("unroll") for (int k = 0; k < 2; ++k) \
        acc[ai][bj][m][n] = __builtin_amdgcn_mfma_f32_16x16x32_bf16(Bt[n][k], At[m][k], acc[ai][bj][m][n], 0, 0, 0); __builtin_amdgcn_s_setprio(0); } while (0)
#define PG8_WAIT_V(n) asm volatile("s_waitcnt vmcnt(" #n ")" ::: "memory")
#define PG8_WAIT_L(n) asm volatile("s_waitcnt lgkmcnt(" #n ")" ::: "memory")
#define PG8_BAR __builtin_amdgcn_s_barrier()
#define PG8_SCHED __builtin_amdgcn_sched_barrier(0)
    Unit cur, nxt; int ui = 0;
    if (!S.next(0, cur)) return;
    f32x4 acc[2][2][4][2];
#pragma unroll
    for (int a = 0; a < 2; ++a)
#pragma unroll
        for (int b = 0; b < 2; ++b)
#pragma unroll
            for (int m = 0; m < 4; ++m)
#pragma unroll
                for (int n = 0; n < 2; ++n) acc[a][b][m][n] = (f32x4){0.f, 0.f, 0.f, 0.f};
    bf16x8 At[4][2], B0[2][2], B1[2][2];
    const char* cA = (const char*)g.A + (size_t)cur.pm * tstep; const char* cB = (const char*)g.Bt + (size_t)cur.pn * tstep;
    S.a_ready(cur);
    if constexpr (SP2) {
        PG8_STAGE(PG8_SB(0, 0), cB, voffB); PG8_STAGE(PG8_SB(0, 1), cB + hstep, voffB); PG8_STAGE(PG8_SA(0, 0), cA, voffA); PG8_STAGE(PG8_SA(0, 1), cA + hstep, voffA);
        if (wr == 1) PG8_BAR;
        PG8_WAIT_V(2); PG8_BAR;
        PG8_STAGE(PG8_SB(1, 0), cB + kstep, voffB); PG8_STAGE(PG8_SA(1, 0), cA + kstep, voffA); PG8_STAGE(PG8_SB(1, 1), cB + hstep + kstep, voffB);
        PG8_WAIT_V(6); PG8_BAR;
    } else {
        PG8_STAGE(PG8_SB(0, 0), cB, voffB); PG8_STAGE(PG8_SA(0, 0), cA, voffA); PG8_STAGE(PG8_SB(0, 1), cB + hstep, voffB); PG8_STAGE(PG8_SA(0, 1), cA + hstep, voffA);
        if (wr == 1) PG8_BAR;
        PG8_WAIT_V(4); PG8_BAR;
        PG8_STAGE(PG8_SB(1, 0), cB + kstep, voffB); PG8_STAGE(PG8_SA(1, 0), cA + kstep, voffA); PG8_STAGE(PG8_SB(1, 1), cB + hstep + kstep, voffB);
        PG8_WAIT_V(6); PG8_BAR;
    }
    for (;;) {
        const bool has_next = S.next(ui + 1, nxt);
        const char* nA = has_next ? (const char*)g.A + (size_t)nxt.pm * tstep : cA; const char* nB = has_next ? (const char*)g.Bt + (size_t)nxt.pn * tstep : cB;
        for (int t = 0; t < nt; t += 2) {
            const bool last = (t == nt - 2);
            const char* a1 = cA + (size_t)(t + 1) * kstep;
            const char* a2 = last ? nA : cA + (size_t)(t + 2) * kstep; const char* b2 = last ? nB : cB + (size_t)(t + 2) * kstep;
            const char* a3 = a2 + kstep; const char* b3 = b2 + kstep;
            if (last && has_next) S.a_ready(nxt);
            if constexpr (SP2) {
            PG8_LDB(B0, 0, 0); PG8_LDB(B1, 0, 1); PG8_SCHED; PG8_LDA(At, 0, 0); PG8_STAGE(PG8_SA(1, 1), a1 + hstep, voffA);
            PG8_WAIT_V(8); PG8_WAIT_L(0); PG8_BAR; PG8_MMA(0, 0, At, B0); PG8_MMA(0, 1, At, B1); PG8_BAR; PG8_SCHED;
            PG8_LDA(At, 0, 1); PG8_STAGE(PG8_SB(0, 0), b2, voffB); PG8_STAGE(PG8_SB(0, 1), b2 + hstep, voffB); PG8_STAGE(PG8_SA(0, 0), a2, voffA);
            PG8_WAIT_V(8); PG8_WAIT_L(0); PG8_BAR; PG8_MMA(1, 0, At, B0); PG8_MMA(1, 1, At, B1); PG8_BAR; PG8_SCHED;
            PG8_LDB(B0, 1, 0); PG8_LDB(B1, 1, 1); PG8_SCHED; PG8_LDA(At, 1, 0); PG8_STAGE(PG8_SA(0, 1), a2 + hstep, voffA);
            PG8_WAIT_V(8); PG8_WAIT_L(0); PG8_BAR; PG8_MMA(0, 0, At, B0); PG8_MMA(0, 1, At, B1); PG8_BAR; PG8_SCHED;
            PG8_LDA(At, 1, 1); PG8_STAGE(PG8_SB(1, 0), b3, voffB); PG8_STAGE(PG8_SB(1, 1), b3 + hstep, voffB); PG8_STAGE(PG8_SA(1, 0), a3, voffA);
            PG8_WAIT_V(8); PG8_WAIT_L(0); PG8_BAR; PG8_MMA(1, 0, At, B0); PG8_MMA(1, 1, At, B1); PG8_BAR; PG8_SCHED;
            } else {
            PG8_LDB(B0, 0, 0); PG8_SCHED; PG8_LDA(At, 0, 0); PG8_STAGE(PG8_SA(1, 1), a1 + hstep, voffA);
            PG8_WAIT_L(8); PG8_BAR; PG8_WAIT_L(0); PG8_MMA(0, 0, At, B0); PG8_BAR; PG8_SCHED;
            PG8_LDB(B1, 0, 1); PG8_STAGE(PG8_SB(0, 0), b2, voffB);
            PG8_BAR; PG8_WAIT_L(0); PG8_MMA(0, 1, At, B1); PG8_BAR;
            PG8_LDA(At, 0, 1); PG8_STAGE(PG8_SA(0, 0), a2, voffA);
            PG8_BAR; PG8_WAIT_L(0); PG8_MMA(1, 0, At, B0); PG8_BAR; PG8_SCHED;
            PG8_STAGE(PG8_SB(0, 1), b2 + hstep, voffB);
            PG8_WAIT_V(6); PG8_BAR; PG8_MMA(1, 1, At, B1); PG8_BAR;
            PG8_LDB(B0, 1, 0); PG8_SCHED; PG8_LDA(At, 1, 0); PG8_STAGE(PG8_SA(0, 1), a2 + hstep, voffA);
            PG8_WAIT_L(8); PG8_BAR; PG8_WAIT_L(0); PG8_MMA(0, 0, At, B0); PG8_BAR; PG8_SCHED;
            PG8_LDB(B1, 1, 1); PG8_STAGE(PG8_SB(1, 0), b3, voffB);
            PG8_BAR; PG8_WAIT_L(0); PG8_MMA(0, 1, At, B1); PG8_BAR;
            PG8_LDA(At, 1, 1); PG8_STAGE(PG8_SA(1, 0), a3, voffA);
            PG8_BAR; PG8_WAIT_L(0); PG8_MMA(1, 0, At, B0); PG8_BAR; PG8_SCHED;
            PG8_STAGE(PG8_SB(1, 1), b3 + hstep, voffB);
            PG8_WAIT_V(6); PG8_BAR; PG8_MMA(1, 1, At, B1); PG8_BAR;
            }
        }
        if constexpr (ALIGN_EPI) { if (wr == 0) PG8_BAR; }
        if constexpr (!Epi::AFTER_DRAIN) { E(acc, cur, wr, wc, fr, fq); S.done(cur); }
        if (!has_next) break;
#pragma unroll
        for (int a = 0; a < 2; ++a)
#pragma unroll
            for (int b = 0; b < 2; ++b)
#pragma unroll
                for (int m = 0; m < 4; ++m)
#pragma unroll
                    for (int n = 0; n < 2; ++n) acc[a][b][m][n] = (f32x4){0.f, 0.f, 0.f, 0.f};
        cur = nxt; cA = nA; cB = nB; ++ui;
        if constexpr (ALIGN_EPI) { if (wr == 1) PG8_BAR; }
    }
    PG8_WAIT_V(0);
    if constexpr (!ALIGN_EPI) { if (wr == 0) PG8_BAR; }
    PG8_BAR;
    if constexpr (Epi::AFTER_DRAIN) { E.fused(acc, cur, wr, wc, fr, fq, lds, wid, lane); S.done(cur); }
#undef PG8_SA
#undef PG8_SB
#undef PG8_STAGE
#undef PG8_LDA
#undef PG8_LDB
#undef PG8_MMA
#undef PG8_WAIT_V
#undef PG8_WAIT_L
#undef PG8_BAR
#undef PG8_SCHED
}
}

#define LAS __attribute__((address_space(3)))
using pg8::bf16_t; using pg8::bf16x8; using pg8::f32x4; using pg8::u32x4; using pg8::Unit;
typedef float f32x16 __attribute__((ext_vector_type(16)));
typedef short s16x4 __attribute__((ext_vector_type(4)));
typedef unsigned u32x2 __attribute__((ext_vector_type(2)));

constexpr int DM = 1024, NBAT = 8, SEQ = 2048, DBAT = 16, DSEQ = 64, PAST = 2048, ALEN = 512;
constexpr int MP = NBAT * SEQ, MS = DBAT * DSEQ, MTOK = MP + MS;
constexpr int HW = 512;
constexpr int NIN = 5120;
constexpr int DFF = 2816, NUP = 2 * DFF;
constexpr float EPS = 1e-6f, LOG2E = 1.4426950408889634f, QSCALE = 0.125f * LOG2E;

constexpr size_t O_Y = 0;
constexpr size_t O_KA_P = (size_t)MTOK * DM;
constexpr size_t O_VA_P = O_KA_P + (size_t)NBAT * ALEN * HW;
constexpr size_t O_KB_P = O_VA_P + (size_t)NBAT * ALEN * HW;
constexpr size_t O_VB_P = O_KB_P + (size_t)NBAT * SEQ * HW;
constexpr size_t O_LF_P = O_VB_P + (size_t)NBAT * SEQ * HW;
constexpr size_t O_CV_P = O_LF_P + (size_t)NBAT * SEQ * 8;
constexpr size_t O_KA_S = O_CV_P + (size_t)NBAT * 2 * NUP;
constexpr size_t O_VA_S = O_KA_S + (size_t)MS * HW;
constexpr size_t O_KB_S = O_VA_S + (size_t)MS * HW;
constexpr size_t O_VB_S = O_KB_S + (size_t)MS * HW;
constexpr size_t O_LF_S = O_VB_S + (size_t)MS * HW;
constexpr size_t O_CV_S = O_LF_S + (size_t)MS * 8;
constexpr size_t O_END = O_CV_S + (size_t)DBAT * 2 * NUP;
static_assert(O_END == 41304064, "output size");

constexpr size_t MiB = 1u << 20;
constexpr size_t WS_CTL = 0, CTL_BYTES = 131072;
constexpr int CW_CNT1 = 8192, CW_CNT2 = 12288, CW_CNT3 = 16384, CW_TC1 = 20480, CW_TC2 = 21504, CW_TC3 = 22528;
constexpr size_t WS_WIN = 1 * MiB, WS_WUP = 11 * MiB, WS_WDN = 22 * MiB, WS_WOUT = 28 * MiB, WS_WPA = 30 * MiB, WS_WPB = 31 * MiB;
constexpr size_t WS_H = 32 * MiB;
constexpr size_t WS_OA = 264 * MiB, WS_OB = 236 * MiB;
constexpr size_t WS_QKV = 66 * MiB;
constexpr size_t QKV_STRIDE = (size_t)MTOK * HW;
constexpr size_t WS_GA = 168 * MiB, WS_GB = 202 * MiB;
constexpr size_t WS_T = 66 * MiB;
constexpr size_t WS_X1 = 100 * MiB;
constexpr size_t WS_MG = 134 * MiB;
constexpr size_t WS_U = 66 * MiB;
constexpr size_t WS_A2 = 160 * MiB;
constexpr size_t WS_HEAD = 254 * MiB, WS_TAIL = 258 * MiB;
constexpr size_t WS_XB1 = 262 * MiB, WS_XB2 = WS_XB1 + 262144, WS_XB3 = WS_XB2 + 262144;
constexpr size_t WS_XT1 = WS_XB3 + 262144, WS_XT2 = WS_XT1 + 65536, WS_XT3 = WS_XT2 + 65536;
constexpr size_t WS_RS2 = WS_XT3 + 65536;
constexpr size_t WS_RS1 = WS_RS2 + 131072;
constexpr size_t WS_END = 281 * MiB;
static_assert(WS_A2 + (size_t)MTOK * DFF * 2 <= WS_END && WS_U + (size_t)MTOK * DFF * 2 <= WS_A2, "ws map");

constexpr int RING_BYTES = 131072, LDS_BYTES = 147456;

struct Args { const float* in[22]; float* out; unsigned char* ws; int ph_lo, ph_hi, coop, pad; };
enum { I_XP = 0, I_XS, I_CKA, I_CVA, I_CKB, I_CVB, I_CLF, I_CONV, I_G1, I_G2, I_G3, I_G4, I_WIN, I_BF, I_REL, I_WPA, I_WPB, I_WOUT, I_WUP, I_CW, I_CB, I_WDN };

__device__ __forceinline__ void lds_barrier() { asm volatile("s_waitcnt lgkmcnt(0)" ::: "memory"); __builtin_amdgcn_s_barrier(); asm volatile("" ::: "memory"); }
__device__ __forceinline__ int lane_id() { return (int)__builtin_amdgcn_mbcnt_hi(~0u, __builtin_amdgcn_mbcnt_lo(~0u, 0u)); }
__device__ __forceinline__ unsigned f2bf(float f) { unsigned u = __builtin_bit_cast(unsigned, f); return (u + 0x7fffu + ((u >> 16) & 1u)) >> 16; }
__device__ __forceinline__ unsigned pk2(float lo, float hi) { return pg8::cvt_pk_bf16(lo, hi); }
__device__ __forceinline__ float bflo(unsigned w) { return __uint_as_float(w << 16); }
__device__ __forceinline__ float bfhi(unsigned w) { return __uint_as_float(w & 0xffff0000u); }
__device__ __forceinline__ float wave_sum(float v) {
#pragma unroll
    for (int o = 1; o < 64; o <<= 1) v += __shfl_xor(v, o);
    return v;
}
__device__ __forceinline__ float sigmoidf_(float x) { return __builtin_amdgcn_rcpf(1.0f + __builtin_amdgcn_exp2f(-x * LOG2E)); }
__device__ __forceinline__ const float* xrow_ptr(const Args& a, int m) { return m < MP ? a.in[I_XP] + (size_t)m * DM : a.in[I_XS] + (size_t)(m - MP) * DM; }

#define EPI_MAIN_CALL \
    __device__ __forceinline__ void operator()(const f32x4 (&acc)[2][2][4][2], const Unit& u, int wr, int wc, int fr, int fq) const { \
        _Pragma("unroll") for (int ai = 0; ai < 2; ++ai) _Pragma("unroll") for (int m = 0; m < 4; ++m) { \
            const int row = u.pm * 256 + ai * 128 + wr * 64 + m * 16 + fr; \
            _Pragma("unroll") for (int bj = 0; bj < 2; ++bj) store8(row, u.pn * 256 + bj * 128 + wc * 32 + 8 * fq, acc[ai][bj][m][0], acc[ai][bj][m][1]); } }
struct EpiIn {
    static constexpr bool PERM = true, AFTER_DRAIN = false;
    unsigned char* ws; float* out;
    __device__ __forceinline__ void store8(int row, int col, f32x4 v0, f32x4 v1) const {
        const int pn = col >> 8, seg = pn >> 1;
        bf16_t* bdst; int pitch, cl; float sc = 1.f; const bool sig = pn >= 12;
        if (!sig) { bdst = (bf16_t*)(ws + WS_QKV) + (size_t)seg * QKV_STRIDE; pitch = HW; cl = col & 511; if (seg == 0 || seg == 3) sc = QSCALE; }
        else { bdst = (bf16_t*)(ws + (pn < 16 ? WS_GA : WS_GB)); pitch = DM; cl = (col - 3072) & 1023; }
        if (sig) {
#pragma unroll
            for (int e = 0; e < 4; ++e) { v0[e] = sigmoidf_(v0[e]); v1[e] = sigmoidf_(v1[e]); }
        } else { v0 = v0 * sc; v1 = v1 * sc; }
        u32x4 w; w.x = pk2(v0[0], v0[1]); w.y = pk2(v0[2], v0[3]); w.z = pk2(v1[0], v1[1]); w.w = pk2(v1[2], v1[3]);
        *(u32x4*)(bdst + (size_t)row * pitch + cl) = w;
    }
    EPI_MAIN_CALL
};
struct EpiProjA {
    static constexpr bool PERM = true, AFTER_DRAIN = false;
    const bf16_t* G; bf16_t* T;
    __device__ __forceinline__ void store8(int row, int c, f32x4 v0, f32x4 v1) const {
        const u32x4 g = *(const u32x4*)(G + (size_t)row * DM + c);
        v0[0] *= bflo(g.x); v0[1] *= bfhi(g.x); v0[2] *= bflo(g.y); v0[3] *= bfhi(g.y);
        v1[0] *= bflo(g.z); v1[1] *= bfhi(g.z); v1[2] *= bflo(g.w); v1[3] *= bfhi(g.w);
        u32x4 w; w.x = pk2(v0[0], v0[1]); w.y = pk2(v0[2], v0[3]); w.z = pk2(v1[0], v1[1]); w.w = pk2(v1[2], v1[3]);
        *(u32x4*)(T + (size_t)row * DM + c) = w;
    }
    EPI_MAIN_CALL
};
struct EpiProjB {
    static constexpr bool PERM = true, AFTER_DRAIN = false;
    const bf16_t* G; const bf16_t* T; bf16_t* MG;
    __device__ __forceinline__ void store8(int row, int c, f32x4 v0, f32x4 v1) const {
        const u32x4 g = *(const u32x4*)(G + (size_t)row * DM + c);
        const u32x4 tw = *(const u32x4*)(T + (size_t)row * DM + c);
        const f32x4 t0 = {bflo(tw.x), bfhi(tw.x), bflo(tw.y), bfhi(tw.y)}, t1 = {bflo(tw.z), bfhi(tw.z), bflo(tw.w), bfhi(tw.w)};
        v0[0] = t0[0] + v0[0] * bflo(g.x); v0[1] = t0[1] + v0[1] * bfhi(g.x); v0[2] = t0[2] + v0[2] * bflo(g.y); v0[3] = t0[3] + v0[3] * bfhi(g.y);
        v1[0] = t1[0] + v1[0] * bflo(g.z); v1[1] = t1[1] + v1[1] * bfhi(g.z); v1[2] = t1[2] + v1[2] * bflo(g.w); v1[3] = t1[3] + v1[3] * bfhi(g.w);
        u32x4 w; w.x = pk2(v0[0], v0[1]); w.y = pk2(v0[2], v0[3]); w.z = pk2(v1[0], v1[1]); w.w = pk2(v1[2], v1[3]);
        *(u32x4*)(MG + (size_t)row * DM + c) = w;
    }
    EPI_MAIN_CALL
};
struct EpiF32 {
    static constexpr bool PERM = true, AFTER_DRAIN = false;
    bf16_t* T;
    __device__ __forceinline__ void store8(int row, int c, f32x4 v0, f32x4 v1) const {
        u32x4 w; w.x = pk2(v0[0], v0[1]); w.y = pk2(v0[2], v0[3]); w.z = pk2(v1[0], v1[1]); w.w = pk2(v1[2], v1[3]);
        *(u32x4*)(T + (size_t)row * DM + c) = w;
    }
    EPI_MAIN_CALL
};

__device__ __forceinline__ bf16x8 frag_perm(const u32x4 v, const int paddr) {
    u32x4 r; r.x = (unsigned)__builtin_amdgcn_ds_bpermute(paddr, (int)v.x); r.y = (unsigned)__builtin_amdgcn_ds_bpermute(paddr, (int)v.y);
    r.z = (unsigned)__builtin_amdgcn_ds_bpermute(paddr, (int)v.z); r.w = (unsigned)__builtin_amdgcn_ds_bpermute(paddr, (int)v.w);
    return __builtin_bit_cast(bf16x8, r);
}
template <class Epi>
__device__ __forceinline__ void small_gemm_range(LAS unsigned char* lds, const bf16_t* A, const bf16_t* Bt, const int K, const int ubeg, const int uend, const int ustride, const Epi& E, const int wv) {
    int lane_ = lane_id(); asm volatile("" : "+v"(lane_));
    const int lane = lane_, fr = lane & 15, fq = lane >> 4, tid = wv * 64 + lane;
    const int kw = K >> 3;
    LAS float* red = (LAS float*)lds;
    for (int u = ubeg; u < uend; u += ustride) {
        const int rc = u & 15, cc = u >> 4;
        const bf16_t* Ap = A + (size_t)(MP + rc * 64 + (lane >> 2)) * K + wv * kw + 8 * (lane & 3);
        const bf16_t* Bp = Bt + (size_t)(cc * 64 + (lane >> 2)) * K + wv * kw + 8 * (lane & 3);
        const int paddr = ((lane & 15) * 4 + (lane >> 4)) * 4;
        f32x4 acc[4][4];
#pragma unroll
        for (int m = 0; m < 4; ++m)
#pragma unroll
            for (int n = 0; n < 4; ++n) acc[m][n] = (f32x4){0.f, 0.f, 0.f, 0.f};
#pragma unroll 4
        for (int ks = 0; ks < kw; ks += 32) {
            u32x4 ar[4], br[4]; bf16x8 af[4], bfr[4];
#pragma unroll
            for (int m = 0; m < 4; ++m) { ar[m] = *(const u32x4*)(Ap + (size_t)(m * 16) * K + ks); br[m] = *(const u32x4*)(Bp + (size_t)(m * 16) * K + ks); }
#pragma unroll
            for (int m = 0; m < 4; ++m) { af[m] = frag_perm(ar[m], paddr); bfr[m] = frag_perm(br[m], paddr); }
#pragma unroll
            for (int m = 0; m < 4; ++m)
#pragma unroll
                for (int n = 0; n < 4; ++n) acc[m][n] = __builtin_amdgcn_mfma_f32_16x16x32_bf16(bfr[n], af[m], acc[m][n], 0, 0, 0);
        }
#pragma unroll
        for (int m = 0; m < 4; ++m)
#pragma unroll
            for (int n = 0; n < 4; ++n) *(LAS f32x4*)(red + (wv * 64 + 16 * m + fr) * 68 + 16 * n + 4 * fq) = acc[m][n];
        __syncthreads();
        const int r = tid >> 3, c8 = (tid & 7) * 8;
        f32x4 s0 = {0.f, 0.f, 0.f, 0.f}, s1 = {0.f, 0.f, 0.f, 0.f};
#pragma unroll
        for (int w = 0; w < 8; ++w) { s0 += *(const LAS f32x4*)(red + (w * 64 + r) * 68 + c8); s1 += *(const LAS f32x4*)(red + (w * 64 + r) * 68 + c8 + 4); }
        E.store8(MP + rc * 64 + r, cc * 64 + c8, s0, s1);
        __syncthreads();
    }
}
template <class Epi>
__device__ __forceinline__ void small_gemm(LAS unsigned char* lds, const bf16_t* A, const bf16_t* Bt, const int K, const int N, const Epi& E, const int wv) {
    small_gemm_range<Epi>(lds, A, Bt, K, (int)blockIdx.x, 16 * (N >> 6), (int)gridDim.x, E, wv);
}
struct TailStat { float* xs; unsigned* cnt; };
__device__ __forceinline__ float tail_row_stat(const TailStat& st, const float part8, const int rc, const int cc, const int r, const int tid) {
    float p = part8; p += __shfl_xor(p, 1); p += __shfl_xor(p, 2); p += __shfl_xor(p, 4);
    if ((tid & 7) == 0) __hip_atomic_store(st.xs + (size_t)(rc * 64 + r) * 16 + cc, p, __ATOMIC_RELAXED, __HIP_MEMORY_SCOPE_AGENT);
    asm volatile("s_waitcnt vmcnt(0)" ::: "memory"); __syncthreads();
    if (tid == 0) {
        __hip_atomic_fetch_add(st.cnt + 64 * rc, 1u, __ATOMIC_RELAXED, __HIP_MEMORY_SCOPE_AGENT);
        while (__hip_atomic_load(st.cnt + 64 * rc, __ATOMIC_RELAXED, __HIP_MEMORY_SCOPE_AGENT) < 16u) __builtin_amdgcn_s_sleep(1);
        __builtin_amdgcn_fence(__ATOMIC_ACQUIRE, "agent");
    }
    __syncthreads();
    float q = 0.f;
#pragma unroll
    for (int j = 0; j < 16; ++j) q += __hip_atomic_load(st.xs + (size_t)(rc * 64 + r) * 16 + j, __ATOMIC_RELAXED, __HIP_MEMORY_SCOPE_AGENT);
    return 1.0f / sqrtf(q * (1.0f / DM) + EPS);
}
template <int MODE>
__device__ __forceinline__ void small_gemm_norm(LAS unsigned char* lds, const bf16_t* A, const bf16_t* Bt, const int K, const float* xin, float* y, float* RS2, bf16_t* H, const float* ga,
                                                const TailStat st1, const TailStat st2, const int wv) {
    int lane_ = lane_id(); asm volatile("" : "+v"(lane_));
    const int lane = lane_, fr = lane & 15, fq = lane >> 4, tid = wv * 64 + lane;
    const int kw = K >> 3, u = blockIdx.x, rc = u & 15, cc = u >> 4;
    LAS float* red = (LAS float*)lds;
    const bf16_t* Ap = A + (size_t)(MP + rc * 64 + (lane >> 2)) * K + wv * kw + 8 * (lane & 3);
    const bf16_t* Bp = Bt + (size_t)(cc * 64 + (lane >> 2)) * K + wv * kw + 8 * (lane & 3);
    const int paddr = ((lane & 15) * 4 + (lane >> 4)) * 4;
    f32x4 acc[4][4];
#pragma unroll
    for (int m = 0; m < 4; ++m)
#pragma unroll
        for (int n = 0; n < 4; ++n) acc[m][n] = (f32x4){0.f, 0.f, 0.f, 0.f};
#pragma unroll 4
    for (int ks = 0; ks < kw; ks += 32) {
        u32x4 ar[4], br[4]; bf16x8 af[4], bfr[4];
#pragma unroll
        for (int m = 0; m < 4; ++m) { ar[m] = *(const u32x4*)(Ap + (size_t)(m * 16) * K + ks); br[m] = *(const u32x4*)(Bp + (size_t)(m * 16) * K + ks); }
#pragma unroll
        for (int m = 0; m < 4; ++m) { af[m] = frag_perm(ar[m], paddr); bfr[m] = frag_perm(br[m], paddr); }
#pragma unroll
        for (int m = 0; m < 4; ++m)
#pragma unroll
            for (int n = 0; n < 4; ++n) acc[m][n] = __builtin_amdgcn_mfma_f32_16x16x32_bf16(bfr[n], af[m], acc[m][n], 0, 0, 0);
    }
#pragma unroll
    for (int m = 0; m < 4; ++m)
#pragma unroll
        for (int n = 0; n < 4; ++n) *(LAS f32x4*)(red + (wv * 64 + 16 * m + fr) * 68 + 16 * n + 4 * fq) = acc[m][n];
    __syncthreads();
    const int r = tid >> 3, c8 = (tid & 7) * 8;
    f32x4 s0 = {0.f, 0.f, 0.f, 0.f}, s1 = {0.f, 0.f, 0.f, 0.f};
#pragma unroll
    for (int w = 0; w < 8; ++w) { s0 += *(const LAS f32x4*)(red + (w * 64 + r) * 68 + c8); s1 += *(const LAS f32x4*)(red + (w * 64 + r) * 68 + c8 + 4); }
    const int row = rc * 64 + r, col = cc * 64 + c8;
    const float rs1 = tail_row_stat(st1, (s0[0] * s0[0] + s0[1] * s0[1]) + (s0[2] * s0[2] + s0[3] * s0[3]) + (s1[0] * s1[0] + s1[1] * s1[1]) + (s1[2] * s1[2] + s1[3] * s1[3]), rc, cc, r, tid);
    const f32x4 ga0 = *(const f32x4*)(ga + col), ga1 = *(const f32x4*)(ga + col + 4);
    float* yp = y + (size_t)(MP + row) * DM + col;
    if (MODE == 1) {
        const u32x4 xw = *(const u32x4*)(H + (size_t)(MP + row) * DM + col); const float ir2 = 1.0f / RS2[MP + row];
        const f32x4 y0 = (f32x4){bflo(xw.x), bfhi(xw.x), bflo(xw.y), bfhi(xw.y)} * ir2, y1 = (f32x4){bflo(xw.z), bfhi(xw.z), bflo(xw.w), bfhi(xw.w)} * ir2;
        *(f32x4*)yp = y0 + s0 * rs1 * ga0; *(f32x4*)(yp + 4) = y1 + s1 * rs1 * ga1;
    } else {
        const float* xp = xin + (size_t)row * DM + col;
        const f32x4 x0 = *(const f32x4*)xp + s0 * rs1 * ga0, x1 = *(const f32x4*)(xp + 4) + s1 * rs1 * ga1;
        const float rs2 = tail_row_stat(st2, (x0[0] * x0[0] + x0[1] * x0[1]) + (x0[2] * x0[2] + x0[3] * x0[3]) + (x1[0] * x1[0] + x1[1] * x1[1]) + (x1[2] * x1[2] + x1[3] * x1[3]), rc, cc, r, tid);
        if (cc == 0 && (tid & 7) == 0) RS2[MP + row] = rs2;
        const f32x4 h0 = x0 * rs2, h1 = x1 * rs2;
        u32x4 w; w.x = pk2(h0[0], h0[1]); w.y = pk2(h0[2], h0[3]); w.z = pk2(h1[0], h1[1]); w.w = pk2(h1[2], h1[3]);
        *(u32x4*)(H + (size_t)(MP + row) * DM + col) = w;
    }
    __syncthreads();
}
template <class Epi>
__device__ __forceinline__ void small_gemm_a4(LAS unsigned char* lds, const bf16_t* A, const bf16_t* Bt, const int N, const Epi& E, const int wv) {
    constexpr int K = 1024, kw = 128;
    int lane_ = lane_id(); asm volatile("" : "+v"(lane_));
    const int lane = lane_, fr = lane & 15, fq = lane >> 4, tid = wv * 64 + lane;
    const int nunits = 16 * (N >> 6), G = gridDim.x;
    LAS float* red = (LAS float*)lds;
    const int lrow = lane >> 2, lch = 8 * (lane & 3), paddr = ((lane & 15) * 4 + (lane >> 4)) * 4;
    const int rc = blockIdx.x & 15;
    bf16x8 pa[4][4];
    {   const bf16_t* Ap = A + (size_t)(MP + rc * 64 + lrow) * K + wv * kw + lch;
        u32x4 ar[4][4];
#pragma unroll
        for (int ks = 0; ks < 4; ++ks)
#pragma unroll
            for (int m = 0; m < 4; ++m) ar[ks][m] = *(const u32x4*)(Ap + (size_t)(m * 16) * K + ks * 32);
#pragma unroll
        for (int ks = 0; ks < 4; ++ks)
#pragma unroll
            for (int m = 0; m < 4; ++m) pa[ks][m] = frag_perm(ar[ks][m], paddr); }
    u32x4 br[4][4];
    if ((int)blockIdx.x < nunits) { const bf16_t* Bp = Bt + (size_t)((blockIdx.x >> 4) * 64 + lrow) * K + wv * kw + lch;
#pragma unroll
        for (int ks = 0; ks < 4; ++ks)
#pragma unroll
            for (int n = 0; n < 4; ++n) br[ks][n] = *(const u32x4*)(Bp + (size_t)(n * 16) * K + ks * 32); }
    for (int u = blockIdx.x; u < nunits; u += G) {
        const int cc = u >> 4;
        f32x4 acc[4][4];
#pragma unroll
        for (int m = 0; m < 4; ++m)
#pragma unroll
            for (int n = 0; n < 4; ++n) acc[m][n] = (f32x4){0.f, 0.f, 0.f, 0.f};
#pragma unroll
        for (int ks = 0; ks < 4; ++ks) {
            bf16x8 pb[4];
#pragma unroll
            for (int n = 0; n < 4; ++n) pb[n] = frag_perm(br[ks][n], paddr);
#pragma unroll
            for (int m = 0; m < 4; ++m)
#pragma unroll
                for (int n = 0; n < 4; ++n) acc[m][n] = __builtin_amdgcn_mfma_f32_16x16x32_bf16(pb[n], pa[ks][m], acc[m][n], 0, 0, 0);
        }
        { const int un = u + G < nunits ? u + G : u;
          const bf16_t* Bp = Bt + (size_t)((un >> 4) * 64 + lrow) * K + wv * kw + lch;
#pragma unroll
          for (int ks = 0; ks < 4; ++ks)
#pragma unroll
              for (int n = 0; n < 4; ++n) br[ks][n] = *(const u32x4*)(Bp + (size_t)(n * 16) * K + ks * 32); }
#pragma unroll
        for (int m = 0; m < 4; ++m)
#pragma unroll
            for (int n = 0; n < 4; ++n) *(LAS f32x4*)(red + (wv * 64 + 16 * m + fr) * 68 + 16 * n + 4 * fq) = acc[m][n];
        lds_barrier();
        const int r = tid >> 3, c8 = (tid & 7) * 8;
        f32x4 s0 = {0.f, 0.f, 0.f, 0.f}, s1 = {0.f, 0.f, 0.f, 0.f};
#pragma unroll
        for (int w = 0; w < 8; ++w) { s0 += *(const LAS f32x4*)(red + (w * 64 + r) * 68 + c8); s1 += *(const LAS f32x4*)(red + (w * 64 + r) * 68 + c8 + 4); }
        E.store8(MP + rc * 64 + r, cc * 64 + c8, s0, s1);
        lds_barrier();
    }
}
template <class Epi>
__device__ __forceinline__ void small_gemm_k1024(LAS unsigned char* lds, const bf16_t* A, const bf16_t* Bt, const int N, const Epi& E, const int wv) {
    constexpr int K = 1024, kw = 128;
    const int lane = lane_id(), fr = lane & 15, fq = lane >> 4, tid = wv * 64 + lane;
    const int nunits = 16 * (N >> 6), G = gridDim.x;
    LAS float* red = (LAS float*)lds;
    int u = blockIdx.x;
    if (u >= nunits) return;
    u32x4 fa[4][4], fb[4][4];
    const int lrow = lane >> 2, lch = 8 * (lane & 3), paddr = ((lane & 15) * 4 + (lane >> 4)) * 4;
    {   const bf16_t* Ap = A + (size_t)(MP + (u & 15) * 64 + lrow) * K + wv * kw + lch; const bf16_t* Bp = Bt + (size_t)((u >> 4) * 64 + lrow) * K + wv * kw + lch;
#pragma unroll
        for (int ks = 0; ks < 4; ++ks)
#pragma unroll
            for (int m = 0; m < 4; ++m) { fa[ks][m] = *(const u32x4*)(Ap + (size_t)(m * 16) * K + ks * 32); fb[ks][m] = *(const u32x4*)(Bp + (size_t)(m * 16) * K + ks * 32); } }
    for (; u < nunits; u += G) {
        const int rc = u & 15, cc = u >> 4, nu = u + G; const bool has_next = nu < nunits;
        const bf16_t* Ap = A + (size_t)(MP + (nu & 15) * 64 + lrow) * K + wv * kw + lch; const bf16_t* Bp = Bt + (size_t)((nu >> 4) * 64 + lrow) * K + wv * kw + lch;
        f32x4 acc[4][4];
#pragma unroll
        for (int m = 0; m < 4; ++m)
#pragma unroll
            for (int n = 0; n < 4; ++n) acc[m][n] = (f32x4){0.f, 0.f, 0.f, 0.f};
#pragma unroll
        for (int ks = 0; ks < 4; ++ks) {
            bf16x8 pa[4], pb[4];
#pragma unroll
            for (int m = 0; m < 4; ++m) { pa[m] = frag_perm(fa[ks][m], paddr); pb[m] = frag_perm(fb[ks][m], paddr); }
            if (has_next) {
#pragma unroll
                for (int m = 0; m < 4; ++m) { fa[ks][m] = *(const u32x4*)(Ap + (size_t)(m * 16) * K + ks * 32); fb[ks][m] = *(const u32x4*)(Bp + (size_t)(m * 16) * K + ks * 32); }
            }
#pragma unroll
            for (int m = 0; m < 4; ++m)
#pragma unroll
                for (int n = 0; n < 4; ++n) acc[m][n] = __builtin_amdgcn_mfma_f32_16x16x32_bf16(pb[n], pa[m], acc[m][n], 0, 0, 0);
        }
#pragma unroll
        for (int m = 0; m < 4; ++m)
#pragma unroll
            for (int n = 0; n < 4; ++n) *(LAS f32x4*)(red + (wv * 64 + 16 * m + fr) * 68 + 16 * n + 4 * fq) = acc[m][n];
        __syncthreads();
        const int r = tid >> 3, c8 = (tid & 7) * 8;
        f32x4 s0 = {0.f, 0.f, 0.f, 0.f}, s1 = {0.f, 0.f, 0.f, 0.f};
#pragma unroll
        for (int w = 0; w < 8; ++w) { s0 += *(const LAS f32x4*)(red + (w * 64 + r) * 68 + c8); s1 += *(const LAS f32x4*)(red + (w * 64 + r) * 68 + c8 + 4); }
        E.store8(MP + rc * 64 + r, cc * 64 + c8, s0, s1);
        __syncthreads();
    }
}
template <int CTRL> __device__ __forceinline__ float dppf(float old, float src) {
    return __builtin_bit_cast(float, __builtin_amdgcn_update_dpp(__builtin_bit_cast(int, old), __builtin_bit_cast(int, src), CTRL, 0xf, 0xf, false));
}
__device__ __forceinline__ float gelu_tanh(float x) {
    const float u = 1.5957691216057308f * (x + 0.044715f * x * x * x);
    return x * __builtin_amdgcn_rcpf(1.0f + __builtin_amdgcn_exp2f(-u * LOG2E));
}
struct EpiUpFused {
    static constexpr bool PERM = true, AFTER_DRAIN = false;
    bf16_t* A2; float* out; const float* cw; const float* cb; const float* st; float* head; float* tail; LAS float* halo;
    __device__ __forceinline__ void operator()(const f32x4 (&acc)[2][2][4][2], const Unit& u, int wr, int wc, int fr, int fq) const {
        const int pm = u.pm, gt = u.pn; const bool samp = pm >= 64;
        const int colq = wc * 32 + 8 * fq, oc = gt * 128 + colq;
#pragma unroll
        for (int ai = 0; ai < 2; ++ai) {
            const int g = ai * 2 + wr;
            if (fr >= 14) {
                const int r = fr - 14;
                float* cdst = nullptr;
                if (samp) cdst = out + O_CV_S + ((size_t)((pm - 64) * 4 + g) * 2 + r) * NUP;
                else if (g == 3) cdst = ((pm & 7) == 7) ? out + O_CV_P + ((size_t)(pm >> 3) * 2 + r) * NUP : tail + ((size_t)pm * 2 + r) * NUP;
#pragma unroll
                for (int bj = 0; bj < 2; ++bj) {
                    const f32x4 v0 = acc[ai][bj][3][0], v1 = acc[ai][bj][3][1];
                    LAS float* hp = halo + ((g * 2 + r) * 2 + bj) * 128 + colq;
                    *(LAS f32x4*)hp = v0; *(LAS f32x4*)(hp + 4) = v1;
                    if (cdst) { *(f32x4*)(cdst + bj * DFF + oc) = v0; *(f32x4*)(cdst + bj * DFF + oc + 4) = v1; }
                }
            }
        }
        const bool defer = !samp && (pm & 7) != 0;
        if (defer && wr == 0 && fr < 2) {
            float* hd = head + ((size_t)pm * 2 + fr) * NUP;
#pragma unroll
            for (int bj = 0; bj < 2; ++bj) { *(f32x4*)(hd + bj * DFF + oc) = acc[0][bj][0][0]; *(f32x4*)(hd + bj * DFF + oc + 4) = acc[0][bj][0][1]; }
        }
        f32x4 wg[3], wq[3], bg, bq;
#pragma unroll
        for (int k = 0; k < 3; ++k) { wg[k] = *(const f32x4*)(cw + (size_t)k * NUP + oc); wq[k] = *(const f32x4*)(cw + (size_t)k * NUP + DFF + oc); }
        bg = *(const f32x4*)(cb + oc); bq = *(const f32x4*)(cb + DFF + oc);
        asm volatile("s_waitcnt lgkmcnt(0)" ::: "memory"); __builtin_amdgcn_s_barrier(); asm volatile("" ::: "memory");
        u32x2 keep[2][4];
#pragma unroll
        for (int n = 0; n < 2; ++n) {
            if (n == 1) {
#pragma unroll
                for (int k = 0; k < 3; ++k) { wg[k] = *(const f32x4*)(cw + (size_t)k * NUP + oc + 4); wq[k] = *(const f32x4*)(cw + (size_t)k * NUP + DFF + oc + 4); }
                bg = *(const f32x4*)(cb + oc + 4); bq = *(const f32x4*)(cb + DFF + oc + 4);
            }
#pragma unroll
            for (int ai = 0; ai < 2; ++ai) {
                const int g = ai * 2 + wr;
                f32x4 xm1[2];
                xm1[0] = (f32x4){0.f, 0.f, 0.f, 0.f}; xm1[1] = (f32x4){0.f, 0.f, 0.f, 0.f};
                if (fr >= 14) {
                    const int r = fr - 14;
                    if (samp) { const float* sp = st + ((size_t)((pm - 64) * 4 + g) * 2 + r) * NUP; xm1[0] = *(const f32x4*)(sp + oc + 4 * n); xm1[1] = *(const f32x4*)(sp + DFF + oc + 4 * n); }
                    else if (g > 0) { const LAS float* hp = halo + (((g - 1) * 2 + r) * 2) * 128 + colq + 4 * n; xm1[0] = *(const LAS f32x4*)hp; xm1[1] = *(const LAS f32x4*)(hp + 128); }
                }
#pragma unroll
                for (int m = 0; m < 4; ++m) {
                    const size_t row = (size_t)pm * 256 + g * 64 + m * 16 + fr;
                    float res[4];
#pragma unroll
                    for (int e = 0; e < 4; ++e) {
                        const float xg = acc[ai][0][m][n][e], xgp = (m == 0) ? xm1[0][e] : acc[ai][0][m > 0 ? m - 1 : 0][n][e];
                        const float xv = acc[ai][1][m][n][e], xvp = (m == 0) ? xm1[1][e] : acc[ai][1][m > 0 ? m - 1 : 0][n][e];
                        const float g1 = dppf<0x111>(dppf<0x121>(0.f, xgp), xg), g2 = dppf<0x112>(dppf<0x122>(0.f, xgp), xg);
                        const float v1 = dppf<0x111>(dppf<0x121>(0.f, xvp), xv), v2 = dppf<0x112>(dppf<0x122>(0.f, xvp), xv);
                        const float yg = bg[e] + wg[0][e] * g2 + wg[1][e] * g1 + wg[2][e] * xg;
                        const float yv = bq[e] + wq[0][e] * v2 + wq[1][e] * v1 + wq[2][e] * xv;
                        res[e] = gelu_tanh(yg) * yv;
                    }
                    u32x2 w; w.x = pk2(res[0], res[1]); w.y = pk2(res[2], res[3]);
                    if (n == 0) keep[ai][m] = w;
                    else if (!(defer && g == 0 && m == 0 && fr < 2)) { u32x4 ww; ww.x = keep[ai][m].x; ww.y = keep[ai][m].y; ww.z = w.x; ww.w = w.y; *(u32x4*)(A2 + row * DFF + oc) = ww; }
                    asm volatile("" ::: "memory");
                }
            }
        }
    }
};
__device__ __forceinline__ void ffn_fixup(const Args& a, const int pm, const int tid) {
    if (pm >= 64 || (pm & 7) == 0) return;
    const float* head = (const float*)(a.ws + WS_HEAD) + (size_t)pm * 2 * NUP; const float* tail = (const float*)(a.ws + WS_TAIL) + (size_t)(pm - 1) * 2 * NUP;
    const float* cw = a.in[I_CW]; const float* cb = a.in[I_CB]; bf16_t* A2 = (bf16_t*)(a.ws + WS_A2);
    for (int it = tid; it < 704; it += 512) {
        const int r = it >= 352 ? 1 : 0, oc = (it - r * 352) * 8;
        const float* x0 = r == 0 ? tail : tail + NUP; const float* x1 = r == 0 ? tail + NUP : head; const float* x2 = r == 0 ? head : head + NUP;
        float y[2][8];
#pragma unroll
        for (int hh = 0; hh < 2; ++hh) { const int c = hh * DFF + oc;
#pragma unroll
            for (int q = 0; q < 2; ++q) {
                const f32x4 bb = *(const f32x4*)(cb + c + 4 * q), w0 = *(const f32x4*)(cw + c + 4 * q), w1 = *(const f32x4*)(cw + NUP + c + 4 * q), w2 = *(const f32x4*)(cw + 2 * NUP + c + 4 * q);
                const f32x4 a0 = *(const f32x4*)(x0 + c + 4 * q), a1 = *(const f32x4*)(x1 + c + 4 * q), a2 = *(const f32x4*)(x2 + c + 4 * q);
#pragma unroll
                for (int e = 0; e < 4; ++e) y[hh][4 * q + e] = bb[e] + w0[e] * a0[e] + w1[e] * a1[e] + w2[e] * a2[e];
            } }
        float res[8];
#pragma unroll
        for (int e = 0; e < 8; ++e) res[e] = gelu_tanh(y[0][e]) * y[1][e];
        u32x4 w; w.x = pk2(res[0], res[1]); w.y = pk2(res[2], res[3]); w.z = pk2(res[4], res[5]); w.w = pk2(res[6], res[7]);
        *(u32x4*)(A2 + ((size_t)pm * 256 + r) * DFF + oc) = w;
    }
}

struct RowStat {
    float* xbuf; unsigned* cnt;
    __device__ __forceinline__ void run(const f32x4 (&v)[2][2][4][2], const Unit& u, int wr, int wc, int fr, int fq, LAS unsigned char* lds, int wid, int lane) const {
        LAS float* P = (LAS float*)lds; LAS float* S = (LAS float*)(lds + 4096);
#pragma unroll
        for (int ai = 0; ai < 2; ++ai)
#pragma unroll
            for (int m = 0; m < 4; ++m) { float s = 0.f;
#pragma unroll
                for (int bj = 0; bj < 2; ++bj)
#pragma unroll
                    for (int n = 0; n < 2; ++n) { const f32x4 x = v[ai][bj][m][n]; s += (x[0] * x[0] + x[1] * x[1]) + (x[2] * x[2] + x[3] * x[3]); }
                s += __shfl_xor(s, 16); s += __shfl_xor(s, 32);
                if (fq == 0) P[(ai * 128 + wr * 64 + m * 16 + fr) * 4 + wc] = s; }
        asm volatile("s_waitcnt lgkmcnt(0)" ::: "memory"); __builtin_amdgcn_s_barrier(); asm volatile("" ::: "memory");
        const int tid = wid * 64 + lane;
        if (tid < 256) { const f32x4 p = *(const LAS f32x4*)(P + tid * 4);
            __hip_atomic_store(xbuf + ((size_t)u.pm * 256 + tid) * 4 + u.pn, (p[0] + p[1]) + (p[2] + p[3]), __ATOMIC_RELAXED, __HIP_MEMORY_SCOPE_AGENT); }
        asm volatile("s_waitcnt vmcnt(0)" ::: "memory"); __builtin_amdgcn_s_barrier(); asm volatile("" ::: "memory");
        if (tid == 0) {
            __hip_atomic_fetch_add(cnt + 64 * u.pm, 1u, __ATOMIC_RELAXED, __HIP_MEMORY_SCOPE_AGENT);
            while (__hip_atomic_load(cnt + 64 * u.pm, __ATOMIC_RELAXED, __HIP_MEMORY_SCOPE_AGENT) < 4u) __builtin_amdgcn_s_sleep(1);
            __builtin_amdgcn_fence(__ATOMIC_ACQUIRE, "agent");
        }
        asm volatile("s_waitcnt vmcnt(0) lgkmcnt(0)" ::: "memory"); __builtin_amdgcn_s_barrier(); asm volatile("" ::: "memory");
        if (tid < 256) { const float* slot = xbuf + ((size_t)u.pm * 256 + tid) * 4; float q = 0.f;
#pragma unroll
            for (int t = 0; t < 4; ++t) q += __hip_atomic_load(slot + t, __ATOMIC_RELAXED, __HIP_MEMORY_SCOPE_AGENT);
            S[tid] = 1.0f / sqrtf(q * (1.0f / DM) + EPS); }
        asm volatile("s_waitcnt vmcnt(0) lgkmcnt(0)" ::: "memory"); __builtin_amdgcn_s_barrier(); asm volatile("" ::: "memory");
    }
};
struct EpiOutNorm {
    static constexpr bool PERM = true, AFTER_DRAIN = true;
    const float* RS1; float* RS2; bf16_t* H; const float* g2; RowStat st1, st2;
    __device__ __forceinline__ void fused(f32x4 (&acc)[2][2][4][2], const Unit& u, int wr, int wc, int fr, int fq, LAS unsigned char* lds, int wid, int lane) const {
        f32x4 gpre[2][2];
#pragma unroll
        for (int bj = 0; bj < 2; ++bj) { gpre[bj][0] = *(const f32x4*)(g2 + u.pn * 256 + wc * 32 + 8 * fq + bj * 128); gpre[bj][1] = *(const f32x4*)(g2 + u.pn * 256 + wc * 32 + 8 * fq + bj * 128 + 4); }
        st1.run(acc, u, wr, wc, fr, fq, lds, wid, lane);
        const LAS float* S = (const LAS float*)(lds + 4096);
        const int c0 = u.pn * 256 + wc * 32 + 8 * fq;
#pragma unroll
        for (int ai = 0; ai < 2; ++ai)
#pragma unroll
            for (int m = 0; m < 4; ++m) { const int rl = ai * 128 + wr * 64 + m * 16 + fr; const size_t row = (size_t)u.pm * 256 + rl; const float rs = S[rl]; const float ir1 = 1.0f / RS1[row];
#pragma unroll
                for (int bj = 0; bj < 2; ++bj) { const int c = c0 + bj * 128;
                    const u32x4 hw = *(const u32x4*)(H + row * DM + c);
                    const f32x4 xa = (f32x4){bflo(hw.x), bfhi(hw.x), bflo(hw.y), bfhi(hw.y)} * ir1 + acc[ai][bj][m][0] * rs * gpre[bj][0];
                    const f32x4 xb = (f32x4){bflo(hw.z), bfhi(hw.z), bflo(hw.w), bfhi(hw.w)} * ir1 + acc[ai][bj][m][1] * rs * gpre[bj][1];
                    acc[ai][bj][m][0] = xa; acc[ai][bj][m][1] = xb; }
                asm volatile("" : "+v"(acc[ai][0][m][0]), "+v"(acc[ai][0][m][1]), "+v"(acc[ai][1][m][0]), "+v"(acc[ai][1][m][1]));
                asm volatile("" ::: "memory"); }
        st2.run(acc, u, wr, wc, fr, fq, lds, wid, lane);
#pragma unroll
        for (int ai = 0; ai < 2; ++ai)
#pragma unroll
            for (int m = 0; m < 4; ++m) { const int rl = ai * 128 + wr * 64 + m * 16 + fr; const size_t row = (size_t)u.pm * 256 + rl; const float rs = S[rl];
                if (u.pn == 0 && wc == 0 && fq == 0) RS2[row] = rs;
#pragma unroll
                for (int bj = 0; bj < 2; ++bj) { const int c = c0 + bj * 128;
                    const f32x4 v0 = acc[ai][bj][m][0] * rs, v1 = acc[ai][bj][m][1] * rs;
                    u32x4 w; w.x = pk2(v0[0], v0[1]); w.y = pk2(v0[2], v0[3]); w.z = pk2(v1[0], v1[1]); w.w = pk2(v1[2], v1[3]);
                    *(u32x4*)(H + row * DM + c) = w; } }
    }
};
struct EpiDownNorm {
    static constexpr bool PERM = true, AFTER_DRAIN = true;
    const bf16_t* H; const float* RS2; float* y; const float* g4; RowStat st;
    __device__ __forceinline__ void fused(f32x4 (&acc)[2][2][4][2], const Unit& u, int wr, int wc, int fr, int fq, LAS unsigned char* lds, int wid, int lane) const {
        f32x4 gpre[2][2];
#pragma unroll
        for (int bj = 0; bj < 2; ++bj) { gpre[bj][0] = *(const f32x4*)(g4 + u.pn * 256 + wc * 32 + 8 * fq + bj * 128); gpre[bj][1] = *(const f32x4*)(g4 + u.pn * 256 + wc * 32 + 8 * fq + bj * 128 + 4); }
        st.run(acc, u, wr, wc, fr, fq, lds, wid, lane);
        const LAS float* S = (const LAS float*)(lds + 4096);
        const int c0 = u.pn * 256 + wc * 32 + 8 * fq;
#pragma unroll
        for (int ai = 0; ai < 2; ++ai)
#pragma unroll
            for (int m = 0; m < 4; ++m) { const int rl = ai * 128 + wr * 64 + m * 16 + fr; const size_t row = (size_t)u.pm * 256 + rl; const float rs = S[rl]; const float ir2 = 1.0f / RS2[row];
#pragma unroll
                for (int bj = 0; bj < 2; ++bj) { const int c = c0 + bj * 128;
                    const u32x4 xw = *(const u32x4*)(H + row * DM + c);
                    const f32x4 xa = (f32x4){bflo(xw.x), bfhi(xw.x), bflo(xw.y), bfhi(xw.y)} * ir2, xb = (f32x4){bflo(xw.z), bfhi(xw.z), bflo(xw.w), bfhi(xw.w)} * ir2;
                    *(f32x4*)(y + row * DM + c) = xa + acc[ai][bj][m][0] * rs * gpre[bj][0];
                    *(f32x4*)(y + row * DM + c + 4) = xb + acc[ai][bj][m][1] * rs * gpre[bj][1]; }
                asm volatile("" ::: "memory"); }
    }
};

__device__ __forceinline__ void p0_transpose_item(const float* W, int N, int K, bf16_t* WT, int k0, int src_n0, int dst_n0, LAS float* scr, int lane, const float* kscale = nullptr) {
    float tv[32];
#pragma unroll
    for (int i = 0; i < 32; ++i) tv[i] = W[(size_t)(k0 + 2 * i + (lane >> 5)) * N + src_n0 + (lane & 31)];
    if (kscale) {
#pragma unroll
        for (int i = 0; i < 32; ++i) tv[i] *= kscale[k0 + 2 * i + (lane >> 5)];
    }
#pragma unroll
    for (int i = 0; i < 32; ++i) scr[(2 * i + (lane >> 5)) * 33 + (lane & 31)] = tv[i];
    asm volatile("s_waitcnt lgkmcnt(0)" ::: "memory");
    const int c = lane & 7;
#pragma unroll
    for (int j = 0; j < 4; ++j) { const int n = (lane >> 3) + 8 * j; const LAS float* s = scr + (8 * c) * 33 + n;
        u32x4 o; o.x = pk2(s[0 * 33], s[1 * 33]); o.y = pk2(s[2 * 33], s[3 * 33]); o.z = pk2(s[4 * 33], s[5 * 33]); o.w = pk2(s[6 * 33], s[7 * 33]);
        *(u32x4*)(WT + (size_t)(dst_n0 + n) * K + k0 + 8 * c) = o; }
    asm volatile("s_waitcnt lgkmcnt(0)" ::: "memory");
}

constexpr int TI_IN = 16 * 160, TI_PA = 8 * 32, TI_PB = 8 * 32, TI_OUT = 16 * 32, TI_UP = 16 * 176, TI_DN = 44 * 32;
constexpr int TI_ALL = TI_IN + TI_PA + TI_PB + TI_OUT + TI_UP + TI_DN;
__device__ __forceinline__ void transpose_item(const Args& a, const int it, LAS float* scr, const int lane) {
    unsigned char* ws = a.ws; int r = it;
    if (r < TI_IN) { const int kb = r / 160, nb = r % 160, d0 = nb * 32; p0_transpose_item(a.in[I_WIN], 5128, DM, (bf16_t*)(ws + WS_WIN), kb * 64, d0 + (d0 >= 3072 ? 8 : 0), d0, scr, lane, a.in[I_G1]); return; } r -= TI_IN;
    if (r < TI_PA) { const int kb = r / 32, nb = r % 32; p0_transpose_item(a.in[I_WPA], DM, HW, (bf16_t*)(ws + WS_WPA), kb * 64, nb * 32, nb * 32, scr, lane); return; } r -= TI_PA;
    if (r < TI_PB) { const int kb = r / 32, nb = r % 32; p0_transpose_item(a.in[I_WPB], DM, HW, (bf16_t*)(ws + WS_WPB), kb * 64, nb * 32, nb * 32, scr, lane); return; } r -= TI_PB;
    if (r < TI_OUT) { const int kb = r / 32, nb = r % 32; p0_transpose_item(a.in[I_WOUT], DM, DM, (bf16_t*)(ws + WS_WOUT), kb * 64, nb * 32, nb * 32, scr, lane); return; } r -= TI_OUT;
    if (r < TI_UP) { const int kb = r / 176, nb = r % 176, d0 = nb * 32, tile = d0 >> 8, w = d0 & 255; const int s0 = (w < 128) ? tile * 128 + w : DFF + tile * 128 + (w - 128);
        p0_transpose_item(a.in[I_WUP], NUP, DM, (bf16_t*)(ws + WS_WUP), kb * 64, s0, d0, scr, lane, a.in[I_G3]); return; } r -= TI_UP;
    { const int kb = r / 32, nb = r % 32; p0_transpose_item(a.in[I_WDN], DM, DFF, (bf16_t*)(ws + WS_WDN), kb * 64, nb * 32, nb * 32, scr, lane); }
}
__device__ __forceinline__ void phase_prologue(const Args& a, LAS unsigned char* lds, const int wv) {
    const int lane = lane_id(), wave = wv, tid = wv * 64 + lane;
    const int G = gridDim.x, gw = blockIdx.x * 8 + wave, NGW = G * 8;
    unsigned char* ws = a.ws;
    LAS float* scr = (LAS float*)(lds + wave * 8448);
    LAS float* wfg = (LAS float*)(lds + 69632);
    {
        const float* win = a.in[I_WIN]; const float* g1 = a.in[I_G1];
        for (int k = tid; k < DM; k += 512) {
            const f32x4 w0 = *(const f32x4*)(win + (size_t)k * 5128 + 3072), w1 = *(const f32x4*)(win + (size_t)k * 5128 + 3076); const float g = g1[k];
            wfg[0 * DM + k] = w0[0] * g; wfg[1 * DM + k] = w0[1] * g; wfg[2 * DM + k] = w0[2] * g; wfg[3 * DM + k] = w0[3] * g;
            wfg[4 * DM + k] = w1[0] * g; wfg[5 * DM + k] = w1[1] * g; wfg[6 * DM + k] = w1[2] * g; wfg[7 * DM + k] = w1[3] * g;
        }
    }
    __syncthreads();
    for (int it = gw; it < TI_IN; it += NGW) transpose_item(a, it, scr, lane);
    const float* g1 = a.in[I_G1]; const float* bfp = a.in[I_BF];
    f32x4 gv[4];
#pragma unroll
    for (int j = 0; j < 4; ++j) gv[j] = *(const f32x4*)(g1 + 4 * lane + 256 * j);
    bf16_t* H = (bf16_t*)(ws + WS_H);
    constexpr int RB = 4;
    for (int mb = (NGW - 1 - gw) * RB; mb < MTOK; mb += NGW * RB) {
        f32x4 v[RB][4]; float ss[RB], z[RB][8];
#pragma unroll
        for (int i = 0; i < RB; ++i) { const float* xr = xrow_ptr(a, mb + i);
#pragma unroll
            for (int j = 0; j < 4; ++j) v[i][j] = *(const f32x4*)(xr + 4 * lane + 256 * j); }
#pragma unroll
        for (int i = 0; i < RB; ++i) { ss[i] = 0.f;
#pragma unroll
            for (int j = 0; j < 4; ++j) ss[i] += (v[i][j][0] * v[i][j][0] + v[i][j][1] * v[i][j][1]) + (v[i][j][2] * v[i][j][2] + v[i][j][3] * v[i][j][3]); }
#pragma unroll
        for (int q = 0; q < 8; ++q) {
            f32x4 w[4];
#pragma unroll
            for (int j = 0; j < 4; ++j) w[j] = *(const LAS f32x4*)(wfg + q * DM + 4 * lane + 256 * j);
#pragma unroll
            for (int i = 0; i < RB; ++i) { float s = 0.f;
#pragma unroll
                for (int j = 0; j < 4; ++j) s += (v[i][j][0] * w[j][0] + v[i][j][1] * w[j][1]) + (v[i][j][2] * w[j][2] + v[i][j][3] * w[j][3]);
                z[i][q] = s; }
        }
#pragma unroll
        for (int i = 0; i < RB; ++i) {
            const int m = mb + i;
            const float sst = wave_sum(ss[i]);
#pragma unroll
            for (int q = 0; q < 8; ++q) z[i][q] = wave_sum(z[i][q]);
            const float rs = 1.0f / sqrtf(sst * (1.0f / DM) + EPS);
#pragma unroll
            for (int j = 0; j < 4; ++j) {
                u32x2 o; o.x = pk2(v[i][j][0] * rs, v[i][j][1] * rs); o.y = pk2(v[i][j][2] * rs, v[i][j][3] * rs);
                *(u32x2*)(H + (size_t)m * DM + 4 * lane + 256 * j) = o;
            }
            if (lane == 0) ((float*)(ws + WS_RS1))[m] = rs;
            float zz = z[i][0];
#pragma unroll
            for (int q = 1; q < 8; ++q) zz = (lane == q) ? z[i][q] : zz;
            if (lane < 8) {
                const float t = zz * rs + bfp[lane];
                const float lf = fminf(t, 0.f) - log1pf(expf(-fabsf(t)));
                float* dst = m < MP ? a.out + O_LF_P + (size_t)m * 8 : a.out + O_LF_S + (size_t)(m - MP) * 8;
                dst[lane] = lf;
            }
        }
    }
}

__device__ __forceinline__ void phase_rows1(const Args& a, const int wv) {
    const int lane = lane_id(), wave = wv; const int gw = blockIdx.x * 8 + wave, NGW = gridDim.x * 8;
    const bf16_t* T = (const bf16_t*)(a.ws + WS_T); bf16_t* H = (bf16_t*)(a.ws + WS_H);
    f32x4 g2[4], g3[4];
#pragma unroll
    for (int j = 0; j < 4; ++j) { g2[j] = *(const f32x4*)(a.in[I_G2] + 4 * lane + 256 * j); g3[j] = *(const f32x4*)(a.in[I_G3] + 4 * lane + 256 * j); }
    constexpr int RB = 2;
    for (int mb = MP + gw * RB; mb < MTOK; mb += NGW * RB) {
        f32x4 t[RB][4], x[RB][4];
#pragma unroll
        for (int i = 0; i < RB; ++i) { const float* xr = xrow_ptr(a, mb + i); const bf16_t* tr = T + (size_t)(mb + i) * DM;
#pragma unroll
            for (int j = 0; j < 4; ++j) { const u32x2 tw = *(const u32x2*)(tr + 4 * lane + 256 * j); t[i][j] = (f32x4){bflo(tw.x), bfhi(tw.x), bflo(tw.y), bfhi(tw.y)}; x[i][j] = *(const f32x4*)(xr + 4 * lane + 256 * j); } }
#pragma unroll
        for (int i = 0; i < RB; ++i) {
            const int m = mb + i; float ss = 0.f;
#pragma unroll
            for (int j = 0; j < 4; ++j) ss += (t[i][j][0] * t[i][j][0] + t[i][j][1] * t[i][j][1]) + (t[i][j][2] * t[i][j][2] + t[i][j][3] * t[i][j][3]);
            const float rs = 1.0f / sqrtf(wave_sum(ss) * (1.0f / DM) + EPS);
            float s2 = 0.f;
#pragma unroll
            for (int j = 0; j < 4; ++j) { x[i][j] = x[i][j] + t[i][j] * rs * g2[j]; s2 += (x[i][j][0] * x[i][j][0] + x[i][j][1] * x[i][j][1]) + (x[i][j][2] * x[i][j][2] + x[i][j][3] * x[i][j][3]);
                *(f32x4*)(a.out + O_Y + (size_t)m * DM + 4 * lane + 256 * j) = x[i][j]; }
            const float r2 = 1.0f / sqrtf(wave_sum(s2) * (1.0f / DM) + EPS);
#pragma unroll
            for (int j = 0; j < 4; ++j) { u32x2 o; o.x = pk2(x[i][j][0] * r2 * g3[j][0], x[i][j][1] * r2 * g3[j][1]); o.y = pk2(x[i][j][2] * r2 * g3[j][2], x[i][j][3] * r2 * g3[j][3]);
                *(u32x2*)(H + (size_t)m * DM + 4 * lane + 256 * j) = o; }
        }
    }
}
__device__ __forceinline__ void phase_rows2(const Args& a, const int wv) {
    const int lane = lane_id(), wave = wv; const int gw = blockIdx.x * 8 + wave, NGW = gridDim.x * 8;
    const bf16_t* T = (const bf16_t*)(a.ws + WS_T);
    f32x4 g4[4];
#pragma unroll
    for (int j = 0; j < 4; ++j) g4[j] = *(const f32x4*)(a.in[I_G4] + 4 * lane + 256 * j);
    constexpr int RB = 2;
    for (int mb = MP + gw * RB; mb < MTOK; mb += NGW * RB) {
        f32x4 t[RB][4], x[RB][4];
#pragma unroll
        for (int i = 0; i < RB; ++i) { const bf16_t* tr = T + (size_t)(mb + i) * DM; const float* yr = a.out + O_Y + (size_t)(mb + i) * DM;
#pragma unroll
            for (int j = 0; j < 4; ++j) { const u32x2 tw = *(const u32x2*)(tr + 4 * lane + 256 * j); t[i][j] = (f32x4){bflo(tw.x), bfhi(tw.x), bflo(tw.y), bfhi(tw.y)}; x[i][j] = *(const f32x4*)(yr + 4 * lane + 256 * j); } }
#pragma unroll
        for (int i = 0; i < RB; ++i) {
            float* yr = a.out + O_Y + (size_t)(mb + i) * DM; float ss = 0.f;
#pragma unroll
            for (int j = 0; j < 4; ++j) ss += (t[i][j][0] * t[i][j][0] + t[i][j][1] * t[i][j][1]) + (t[i][j][2] * t[i][j][2] + t[i][j][3] * t[i][j][3]);
            const float rs = 1.0f / sqrtf(wave_sum(ss) * (1.0f / DM) + EPS);
#pragma unroll
            for (int j = 0; j < 4; ++j) *(f32x4*)(yr + 4 * lane + 256 * j) = x[i][j] + t[i][j] * rs * g4[j];
        }
    }
}


constexpr int AL_K = 0, AL_KB = 64 * 144, AL_V = 2 * AL_KB, AL_VB = 8192, AL_WS = AL_V + 2 * AL_VB, AL_CS = AL_WS + 8 * 256, AL_TAB = AL_CS + 2112 * 4, AL_MISC = AL_TAB + 260 * 4;
constexpr int N_ATT_UNITS = 1280, N_TR_UNITS = (TI_ALL - TI_IN + 7) / 8;
__device__ __forceinline__ int crow(int r, int hi) { return (r & 3) + 8 * (r >> 2) + 4 * hi; }
__device__ __forceinline__ float halfswap_max(float m) { auto rr = __builtin_amdgcn_permlane32_swap(__float_as_uint(m), __float_as_uint(m), false, false); return fmaxf(__uint_as_float(rr[0]), __uint_as_float(rr[1])); }
__device__ __forceinline__ float halfswap_sum(float m) { auto rr = __builtin_amdgcn_permlane32_swap(__float_as_uint(m), __float_as_uint(m), false, false); return __uint_as_float(rr[0]) + __uint_as_float(rr[1]); }

__device__ __forceinline__ void pv_step(f32x16* o, f32x16& lacc, unsigned vb, bf16x8 pa0, bf16x8 pa1, bf16x8 pa2, bf16x8 pa3) {
#pragma unroll
    for (int d0 = 0; d0 < 2; ++d0) { s16x4 lo[4], hh[4];
#pragma unroll
        for (int ks = 0; ks < 4; ++ks) {
            asm volatile("ds_read_b64_tr_b16 %0,%1 offset:%c2" : "=&v"(lo[ks]) : "v"(vb), "i"(d0 * 4096 + ks * 1024) : "memory");
            asm volatile("ds_read_b64_tr_b16 %0,%1 offset:%c2" : "=&v"(hh[ks]) : "v"(vb), "i"(d0 * 4096 + ks * 1024 + 512) : "memory"); }
        if (d0 == 0) {
            __builtin_amdgcn_sched_barrier(0);
            const u32x4 one4 = {0x3F803F80u, 0x3F803F80u, 0x3F803F80u, 0x3F803F80u}; const bf16x8 ones = __builtin_bit_cast(bf16x8, one4);
            lacc = __builtin_amdgcn_mfma_f32_32x32x16_bf16(pa0, ones, lacc, 0, 0, 0); lacc = __builtin_amdgcn_mfma_f32_32x32x16_bf16(pa1, ones, lacc, 0, 0, 0);
            lacc = __builtin_amdgcn_mfma_f32_32x32x16_bf16(pa2, ones, lacc, 0, 0, 0); lacc = __builtin_amdgcn_mfma_f32_32x32x16_bf16(pa3, ones, lacc, 0, 0, 0);
            __builtin_amdgcn_sched_barrier(0);
        }
        asm volatile("s_waitcnt lgkmcnt(0)" ::: "memory"); __builtin_amdgcn_sched_barrier(0);
#define PK_(k) (bf16x8){lo[k][0], lo[k][1], lo[k][2], lo[k][3], hh[k][0], hh[k][1], hh[k][2], hh[k][3]}
        o[d0] = __builtin_amdgcn_mfma_f32_32x32x16_bf16(pa0, PK_(0), o[d0], 0, 0, 0);
        o[d0] = __builtin_amdgcn_mfma_f32_32x32x16_bf16(pa1, PK_(1), o[d0], 0, 0, 0);
        o[d0] = __builtin_amdgcn_mfma_f32_32x32x16_bf16(pa2, PK_(2), o[d0], 0, 0, 0);
        o[d0] = __builtin_amdgcn_mfma_f32_32x32x16_bf16(pa3, PK_(3), o[d0], 0, 0, 0);
#undef PK_
    }
}

template <int KIND>
__device__ __forceinline__ void attn_unit(const Args& a, LAS unsigned char* lds, int b, int h, int blk, int samp, const int wv, unsigned* qctr, LAS unsigned* qnext) {
    int lane_ = lane_id(); asm volatile("" : "+v"(lane_));
    const int lane = lane_, r32 = lane & 31, hi = lane >> 5, wid = wv, tid = wv * 64 + lane;
    const bf16_t* QKV = (const bf16_t*)(a.ws + WS_QKV);
    const bf16_t* Qb = QKV + (size_t)(KIND == 0 ? 0 : 3) * QKV_STRIDE; const bf16_t* Kb = Qb + QKV_STRIDE; const bf16_t* Vb = Kb + QKV_STRIDE;
    bf16_t* Ob = (bf16_t*)(a.ws + (KIND == 0 ? WS_OA : WS_OB));
    const float* Kc = a.in[KIND == 0 ? I_CKA : I_CKB]; const float* Vc = a.in[KIND == 0 ? I_CVA : I_CVB];
    constexpr int CT = (KIND == 0) ? 8 : 32;
    int t_lo, t_hi, w_lo, w_hi, qrow, cch = 0, qpos = 0;
    if (KIND == 0) {
        if (!samp) { const int c0 = 4 * blk; cch = c0 + (wid >> 1); t_lo = c0 - 8 < 0 ? 0 : c0 - 8; t_hi = c0 + 3; w_lo = cch - 8 < 0 ? 0 : cch - 8; w_hi = cch; qrow = b * SEQ + 64 * cch + 32 * (wid & 1); qpos = 32 * (wid & 1) + r32; }
        else { cch = 8; t_lo = 0; t_hi = 8; w_lo = 0; w_hi = wid < 2 ? 8 : -1; qrow = MP + b * DSEQ + 32 * (wid & 1); qpos = 32 * (wid & 1) + r32; }
    } else {
        if (!samp) { t_lo = 0; t_hi = 4 * blk + 3; w_lo = 0; w_hi = 4 * blk + (wid >> 1); qrow = b * SEQ + 256 * blk + 32 * wid; qpos = 256 * blk + 32 * wid + r32; }
        else { t_lo = 0; t_hi = 32; w_lo = 0; w_hi = wid < 2 ? 32 : -1; qrow = MP + b * DSEQ + 32 * (wid & 1); qpos = PAST + 32 * (wid & 1) + r32; }
    }
    const bool active = w_hi >= w_lo;
    LAS float* wsf = (LAS float*)(lds + AL_WS) + wid * 64;
    LAS float* cs = (LAS float*)(lds + AL_CS);
    LAS float* tab = (LAS float*)(lds + AL_TAB);
    LAS float* misc = (LAS float*)(lds + AL_MISC);
    lds_barrier();
    bf16x8 qr[4];
#pragma unroll
    for (int dk = 0; dk < 4; ++dk) qr[dk] = active ? *(const bf16x8*)(Qb + (size_t)(qrow + r32) * HW + h * 64 + dk * 16 + hi * 8) : (bf16x8){0, 0, 0, 0, 0, 0, 0, 0};
    const int srow = tid >> 3, sch = tid & 7;
    const unsigned kst = AL_K + srow * 144 + sch * 16, vst = AL_V + (sch >> 2) * 4096 + srow * 64 + (sch & 3) * 16;
    struct Stage { u32x4 k, v; f32x4 kf0, kf1, vf0, vf1; bool f; };
    Stage sA, sB; sA.f = false; sB.f = false;
    auto issue = [&](int tq, Stage& s) {
        const int t = tq > t_hi ? t_hi : tq;
        if (samp && t < CT) { const unsigned off = ((unsigned)(b * (64 * CT) + 64 * t + srow) * 8u + h) * 64u + sch * 8;
            s.kf0 = *(const f32x4*)(Kc + off); s.kf1 = *(const f32x4*)(Kc + off + 4); s.vf0 = *(const f32x4*)(Vc + off); s.vf1 = *(const f32x4*)(Vc + off + 4); s.f = true; }
        else { const unsigned row = samp ? (unsigned)(MP + b * DSEQ + srow) : (unsigned)(b * SEQ + 64 * t + srow); const unsigned off = row * HW + h * 64 + sch * 8;
            s.k = *(const u32x4*)(Kb + off); s.v = *(const u32x4*)(Vb + off); s.f = false; }
    };
    auto commit = [&](int buf, int t, Stage& s) {
        u32x4 kreg = s.k, vreg = s.v;
        if (s.f) { kreg.x = pk2(s.kf0[0], s.kf0[1]); kreg.y = pk2(s.kf0[2], s.kf0[3]); kreg.z = pk2(s.kf1[0], s.kf1[1]); kreg.w = pk2(s.kf1[2], s.kf1[3]);
                   vreg.x = pk2(s.vf0[0], s.vf0[1]); vreg.y = pk2(s.vf0[2], s.vf0[3]); vreg.z = pk2(s.vf1[0], s.vf1[1]); vreg.w = pk2(s.vf1[2], s.vf1[3]); }
        *(LAS u32x4*)(lds + kst + buf * AL_KB) = kreg; *(LAS u32x4*)(lds + vst + buf * AL_VB) = vreg;
        float* kd = nullptr; float* vd = nullptr;
        if (samp) { if (t == CT) { const unsigned o = (unsigned)(b * DSEQ + srow) * HW + h * 64 + sch * 8; kd = a.out + (KIND == 0 ? O_KA_S : O_KB_S) + o; vd = a.out + (KIND == 0 ? O_VA_S : O_VB_S) + o; } }
        else if (KIND == 1) { if (t >= 4 * blk) { const unsigned o = (unsigned)(b * SEQ + 64 * t + srow) * HW + h * 64 + sch * 8; kd = a.out + O_KB_P + o; vd = a.out + O_VB_P + o; } }
        else { if (t >= 4 * blk && t >= 24) { const unsigned o = (unsigned)(b * ALEN + 64 * (t - 24) + srow) * HW + h * 64 + sch * 8; kd = a.out + O_KA_P + o; vd = a.out + O_VA_P + o; } }
        if (kd) {
            *(f32x4*)kd = (f32x4){bflo(kreg.x), bfhi(kreg.x), bflo(kreg.y), bfhi(kreg.y)}; *(f32x4*)(kd + 4) = (f32x4){bflo(kreg.z), bfhi(kreg.z), bflo(kreg.w), bfhi(kreg.w)};
            *(f32x4*)vd = (f32x4){bflo(vreg.x), bfhi(vreg.x), bflo(vreg.y), bfhi(vreg.y)}; *(f32x4*)(vd + 4) = (f32x4){bflo(vreg.z), bfhi(vreg.z), bflo(vreg.w), bfhi(vreg.w)};
        }
    };
    issue(t_lo, sA); issue(t_lo + 1, sB);
    if (KIND == 0) {
        for (int i = tid; i < 257; i += 512) tab[i] = a.in[I_REL][h * 257 + i] * LOG2E;
    } else {
        const int n0 = samp ? PAST : 256 * (blk + 1);
        const float* src = samp ? a.in[I_CLF] + (size_t)b * PAST * 8 + h : a.out + O_LF_P + (size_t)b * SEQ * 8 + h;
        float v[4];
#pragma unroll
        for (int j = 0; j < 4; ++j) { const int idx = 4 * tid + j; v[j] = idx < n0 ? src[(size_t)idx * 8] : 0.f; }
        v[1] += v[0]; v[2] += v[1]; v[3] += v[2];
        float inc = v[3];
#pragma unroll
        for (int o = 1; o < 64; o <<= 1) { const float t = __shfl_up(inc, o); if (lane >= o) inc += t; }
        if (lane == 63) misc[wid] = inc;
        __syncthreads();
        float off = inc - v[3];
#pragma unroll
        for (int w = 0; w < 8; ++w) if (w < wid) off += misc[w];
        if (4 * tid < n0) { f32x4 o4 = {(off + v[0]) * LOG2E, (off + v[1]) * LOG2E, (off + v[2]) * LOG2E, (off + v[3]) * LOG2E}; *(LAS f32x4*)(cs + 4 * tid) = o4; }
        if (samp) {
            __syncthreads();
            if (wid == 0) {
                float x = a.out[O_LF_S + (size_t)(b * DSEQ + lane) * 8 + h];
#pragma unroll
                for (int o = 1; o < 64; o <<= 1) { const float t = __shfl_up(x, o); if (lane >= o) x += t; }
                cs[PAST + lane] = cs[PAST - 1] + x * LOG2E;
            }
        }
    }
    commit(0, t_lo, sA);
    __syncthreads();
    f32x16 o[2];
#pragma unroll
    for (int r = 0; r < 16; ++r) { o[0][r] = 0.f; o[1][r] = 0.f; }
    float mhat = (KIND == 1 && active) ? -cs[qpos] : 0.f;
    f32x16 lacc;
#pragma unroll
    for (int r = 0; r < 16; ++r) lacc[r] = 0.f;
    const unsigned lds0 = (unsigned)(uintptr_t)lds;
    const unsigned vb0 = lds0 + AL_V + ((lane >> 4) & 1) * 32 + (lane & 3) * 8 + (4 * hi + ((lane & 15) >> 2)) * 64;
    auto tile = [&](const int t, const int buf) {
        if (active && t >= w_lo && t <= w_hi) {
            const LAS unsigned char* Kt = lds + AL_K + buf * AL_KB + r32 * 144 + hi * 16;
            f32x16 p0, p1; const float nmh = -mhat;
            if (KIND == 0) {
                const int delta = cch - t;
                if (delta >= 3) { const float bb = tab[256] + nmh;
#pragma unroll
                    for (int r = 0; r < 16; ++r) { p0[r] = bb; p1[r] = bb; } }
                else { int base = 64 * delta + qpos - 4 * hi + 128; asm volatile("" : "+v"(base));
#pragma unroll
                    for (int r = 0; r < 16; ++r) { const int kv = (r & 3) + 8 * (r >> 2); int i0 = base - kv, i1 = base - kv - 32;
                        i0 = i0 < 0 ? 0 : (i0 > 256 ? 256 : i0); i1 = i1 < 0 ? 0 : (i1 > 256 ? 256 : i1); p0[r] = tab[i0] + nmh; p1[r] = tab[i1] + nmh; } }
            } else {
                const LAS float* ct = cs + 64 * t + 4 * hi;
#pragma unroll
                for (int g = 0; g < 4; ++g) { const f32x4 c0 = *(const LAS f32x4*)(ct + 8 * g), c1 = *(const LAS f32x4*)(ct + 32 + 8 * g);
#pragma unroll
                    for (int e = 0; e < 4; ++e) { p0[4 * g + e] = nmh - c0[e]; p1[4 * g + e] = nmh - c1[e]; } }
            }
#pragma unroll
            for (int dk = 0; dk < 4; ++dk) {
                const bf16x8 a0 = *(const LAS bf16x8*)(Kt + dk * 32), a1 = *(const LAS bf16x8*)(Kt + 32 * 144 + dk * 32);
                p0 = __builtin_amdgcn_mfma_f32_32x32x16_bf16(a0, qr[dk], p0, 0, 0, 0);
                p1 = __builtin_amdgcn_mfma_f32_32x32x16_bf16(a1, qr[dk], p1, 0, 0, 0);
            }
            if (KIND == 1) {
                if (t == w_hi) { int kb = 64 * t + 4 * hi - qpos; asm volatile("" : "+v"(kb));
#pragma unroll
                    for (int r = 0; r < 16; ++r) { const int kv = kb + (r & 3) + 8 * (r >> 2); if (kv > 0) p0[r] = -INFINITY; if (kv + 32 > 0) p1[r] = -INFINITY; } }
            }
            float mxa = fmaxf(p0[0], p1[0]), mxb = fmaxf(p0[1], p1[1]), mxc = fmaxf(p0[2], p1[2]), mxd = fmaxf(p0[3], p1[3]);
#pragma unroll
            for (int r = 4; r < 16; r += 4) { mxa = fmaxf(mxa, fmaxf(p0[r], p1[r])); mxb = fmaxf(mxb, fmaxf(p0[r + 1], p1[r + 1])); mxc = fmaxf(mxc, fmaxf(p0[r + 2], p1[r + 2])); mxd = fmaxf(mxd, fmaxf(p0[r + 3], p1[r + 3])); }
            float mx = halfswap_max(fmaxf(fmaxf(mxa, mxb), fmaxf(mxc, mxd)));
            if (__any(mx > 8.0f)) {
                const float dl = fmaxf(mx, 0.f); const float al = __builtin_amdgcn_exp2f(-dl); mhat += dl;
#pragma unroll
                for (int r = 0; r < 16; ++r) { p0[r] -= dl; p1[r] -= dl; }
                if (hi == 0) wsf[r32] = al;
#pragma unroll
                for (int g = 0; g < 4; ++g) { const f32x4 f = *(const LAS f32x4*)(wsf + 8 * g + 4 * hi);
#pragma unroll
                    for (int e = 0; e < 4; ++e) { o[0][4 * g + e] *= f[e]; o[1][4 * g + e] *= f[e]; lacc[4 * g + e] *= f[e]; } }
            }
#pragma unroll
            for (int r = 0; r < 16; ++r) { p0[r] = __builtin_amdgcn_exp2f(p0[r]); p1[r] = __builtin_amdgcn_exp2f(p1[r]); }
            u32x4 w0, w1, w2, w3;
            w0.x = pk2(p0[0], p0[1]); w0.y = pk2(p0[2], p0[3]); w0.z = pk2(p0[4], p0[5]); w0.w = pk2(p0[6], p0[7]);
            w1.x = pk2(p0[8], p0[9]); w1.y = pk2(p0[10], p0[11]); w1.z = pk2(p0[12], p0[13]); w1.w = pk2(p0[14], p0[15]);
            w2.x = pk2(p1[0], p1[1]); w2.y = pk2(p1[2], p1[3]); w2.z = pk2(p1[4], p1[5]); w2.w = pk2(p1[6], p1[7]);
            w3.x = pk2(p1[8], p1[9]); w3.y = pk2(p1[10], p1[11]); w3.z = pk2(p1[12], p1[13]); w3.w = pk2(p1[14], p1[15]);
            pv_step(o, lacc, vb0 + buf * AL_VB, __builtin_bit_cast(bf16x8, w0), __builtin_bit_cast(bf16x8, w1), __builtin_bit_cast(bf16x8, w2), __builtin_bit_cast(bf16x8, w3));
        }
    };
    for (int t = t_lo;;) {
        issue(t + 2, sA);
        tile(t, 0);
        if (t < t_hi) commit(1, t + 1, sB);
        lds_barrier();
        if (++t > t_hi) break;
        issue(t + 2, sB);
        tile(t, 1);
        if (t < t_hi) commit(0, t + 1, sA);
        lds_barrier();
        if (++t > t_hi) break;
    }
    unsigned nxt = 0u;
    if (tid == 0) nxt = atomicAdd(qctr, 1u);
    if (active) {
        float rl[16];
#pragma unroll
        for (int r = 0; r < 16; ++r) rl[r] = __builtin_amdgcn_rcpf(lacc[r]);
        LAS bf16_t* stg = (LAS bf16_t*)(lds + AL_K + wid * 4096);
#pragma unroll
        for (int r = 0; r < 16; ++r) { const int orow = crow(r, hi); stg[orow * 64 + r32] = (bf16_t)f2bf(o[0][r] * rl[r]); stg[orow * 64 + 32 + r32] = (bf16_t)f2bf(o[1][r] * rl[r]); }
#pragma unroll
        for (int i = 0; i < 4; ++i) { const int row = i * 8 + (lane >> 3), ch = lane & 7; const u32x4 v = *(const LAS u32x4*)(stg + row * 64 + ch * 8);
            *(u32x4*)(Ob + (size_t)(qrow + row) * HW + h * 64 + ch * 8) = v; }
    }
    if (tid == 0) *qnext = nxt;
}

__device__ __forceinline__ void phase_attention(const Args& a, LAS unsigned char* lds, const int wv) {
    const int tid = wv * 64 + lane_id();
    unsigned* ctr = (unsigned*)(a.ws + WS_CTL);
    LAS unsigned* sidx = (LAS unsigned*)(lds + AL_MISC + 64);
    __syncthreads();
    if (tid == 0) *sidx = atomicAdd(ctr, 1u);
    for (;;) {
        lds_barrier();
        const int i = (int)*sidx;
        if (i >= N_ATT_UNITS + N_TR_UNITS) break;
        if (i >= N_ATT_UNITS) {
            const int it = TI_IN + (i - N_ATT_UNITS) * 8 + wv;
            __syncthreads();
            int l2 = lane_id(); asm volatile("" : "+v"(l2));
            if (it < TI_ALL) transpose_item(a, it, (LAS float*)(lds + wv * 8448), l2);
            __syncthreads();
            if (tid == 0) *sidx = atomicAdd(ctr, 1u);
            continue;
        }
        if (i < 128) attn_unit<1>(a, lds, i >> 3, i & 7, 0, 1, wv, ctr, sidx);
        else if (i < 448) { const int j = i - 128; attn_unit<1>(a, lds, (j & 63) >> 3, j & 7, 7 - (j >> 6), 0, wv, ctr, sidx); }
        else if (i < 832) { const int j = i - 448; attn_unit<0>(a, lds, (j & 63) >> 3, j & 7, 7 - (j >> 6), 0, wv, ctr, sidx); }
        else if (i < 896) { const int j = i - 832; attn_unit<1>(a, lds, j >> 3, j & 7, 2, 0, wv, ctr, sidx); }
        else if (i < 1024) { const int j = i - 896; attn_unit<0>(a, lds, j >> 3, j & 7, 0, 1, wv, ctr, sidx); }
        else if (i < 1088) { const int j = i - 1024; attn_unit<0>(a, lds, j >> 3, j & 7, 1, 0, wv, ctr, sidx); }
        else if (i < 1152) { const int j = i - 1088; attn_unit<1>(a, lds, j >> 3, j & 7, 1, 0, wv, ctr, sidx); }
        else if (i < 1216) { const int j = i - 1152; attn_unit<1>(a, lds, j >> 3, j & 7, 0, 0, wv, ctr, sidx); }
        else { const int j = i - 1216; attn_unit<0>(a, lds, j >> 3, j & 7, 0, 0, wv, ctr, sidx); }
    }
}

#define XB_TMO      128
#define XB_XCNT(j)  (256  + 64 * (j))
#define XB_XSUB(j)  (1280 + 64 * (j))
#define XB_XGEN(j)  (2304 + 64 * (j))
#define XB_TOP      3328
#define XB_TOPGEN   3392
#define XCD_BAR_WORDS 3456
#define XB_SPIN_CAP (1u << 18)

__device__ __forceinline__ unsigned xb_ld(unsigned* p)              { return __hip_atomic_load(p, __ATOMIC_RELAXED, __HIP_MEMORY_SCOPE_AGENT); }
__device__ __forceinline__ unsigned xb_add(unsigned* p, unsigned v) { return __hip_atomic_fetch_add(p, v, __ATOMIC_RELAXED, __HIP_MEMORY_SCOPE_AGENT); }
__device__ __forceinline__ unsigned xb_xcc_id() { return (unsigned)__builtin_amdgcn_s_getreg((3 << 11) | 20) & 0xFu; }
#define XB_SPIN(cond, bar) do { unsigned _sp = 0; while (cond) { __builtin_amdgcn_s_sleep(1); \
    if ((++_sp & 255u) == 0u) { if (xb_ld(&(bar)[XB_TMO])) break; if (_sp > XB_SPIN_CAP) { atomicAdd(&(bar)[XB_TMO], 1u); break; } } } } while (0)

struct XcdBarrier {
    unsigned* bar; unsigned x; bool leader;
    volatile LAS unsigned* st;
};

__device__ __forceinline__ XcdBarrier xcd_barrier_post(unsigned* bar, volatile LAS unsigned* st, const bool leader) {
    XcdBarrier b; b.bar = bar; b.x = xb_xcc_id(); b.st = st; b.leader = leader;
    if (leader) (void)xb_add(&bar[XB_XCNT(b.x)], 1u);
    return b;
}
__device__ __forceinline__ void xcd_barrier_complete(unsigned* bar, unsigned x, unsigned& nloc, unsigned& nx) {
    const unsigned G = gridDim.x * gridDim.y * gridDim.z;
    unsigned sum, cnt, mine, sp = 0u;
    for (;;) {
        sum = 0u; cnt = 0u; mine = 0u;
#pragma unroll
        for (unsigned j = 0; j < 16; ++j) { const unsigned c = xb_ld(&bar[XB_XCNT(j)]); sum += c; cnt += (c > 0u) ? 1u : 0u; mine = (j == x) ? c : mine; }
        if (sum == G) break;
        __builtin_amdgcn_s_sleep(1);
        if ((++sp & 255u) == 0u) { if (xb_ld(&bar[XB_TMO])) break; if (sp > XB_SPIN_CAP) { atomicAdd(&bar[XB_TMO], 1u); break; } }
    }
    nloc = mine > 0u ? mine : 1u; nx = cnt > 0u ? cnt : 1u;
}

__device__ __forceinline__ void xcd_barrier(const XcdBarrier& b, const bool leader_now) {
    asm volatile("s_waitcnt vmcnt(0)" ::: "memory");
    __syncthreads();
    if (leader_now) {
        unsigned* bar = b.bar;
        __builtin_amdgcn_s_waitcnt(0);
        unsigned nloc = b.st[0], nx = b.st[1];
        if (nloc == 0u) { xcd_barrier_complete(bar, b.x, nloc, nx); b.st[0] = nloc; b.st[1] = nx; }
        const unsigned old = xb_add(&bar[XB_XSUB(b.x)], 1u);
        const unsigned gen = old / nloc;
        if (old + 1u == (gen + 1u) * nloc) {
            __builtin_amdgcn_fence(__ATOMIC_RELEASE, "agent");
            asm volatile("s_waitcnt vmcnt(0)" ::: "memory");
            const unsigned og = xb_add(&bar[XB_TOP], 1u);
            const unsigned tg = og / nx;
            if (og + 1u == (tg + 1u) * nx) xb_add(&bar[XB_TOPGEN], 1u);
            else XB_SPIN(xb_ld(&bar[XB_TOPGEN]) == tg, bar);
            __builtin_amdgcn_fence(__ATOMIC_ACQUIRE, "agent");
            xb_add(&bar[XB_XGEN(b.x)], 1u);
            asm volatile("s_waitcnt vmcnt(0)" ::: "memory");
        } else {
            XB_SPIN(xb_ld(&bar[XB_XGEN(b.x)]) == gen, bar);
            __builtin_amdgcn_fence(__ATOMIC_ACQUIRE, "agent");
            asm volatile("s_waitcnt vmcnt(0)" ::: "memory");
        }
    }
    __syncthreads();
}

constexpr int N_PHASES = 7;
__device__ __forceinline__ void grid_bar(unsigned* bar, unsigned& epoch, const int wv, const unsigned nblocks) {
    __syncthreads();
    epoch += 1;
    if (wv == 0 && lane_id() == 0) {
        __builtin_amdgcn_fence(__ATOMIC_RELEASE, "agent");
        asm volatile("s_waitcnt vmcnt(0)" ::: "memory");
        __hip_atomic_fetch_add(bar, 1u, __ATOMIC_RELAXED, __HIP_MEMORY_SCOPE_AGENT);
        const unsigned target = epoch * nblocks;
        while (__hip_atomic_load(bar, __ATOMIC_RELAXED, __HIP_MEMORY_SCOPE_AGENT) < target) __builtin_amdgcn_s_sleep(2);
        __builtin_amdgcn_fence(__ATOMIC_ACQUIRE, "agent");
        asm volatile("s_waitcnt vmcnt(0)" ::: "memory");
    }
    __syncthreads();
}
__global__ void __launch_bounds__(512, 2) mega_fwd(Args a) {
    extern __shared__ __attribute__((aligned(16))) unsigned char lds_raw[];
    LAS unsigned char* lds = (LAS unsigned char*)lds_raw;
    unsigned char* ws = a.ws;
    const int lo = a.ph_lo, hi = a.ph_hi, G = gridDim.x, c = (int)blockIdx.x;
    const int wv = __builtin_amdgcn_readfirstlane((int)threadIdx.x >> 6);
    volatile LAS unsigned* bst = (volatile LAS unsigned*)(lds + RING_BYTES + 12288);
    if (threadIdx.x < 2) bst[threadIdx.x] = 0u;
    __syncthreads();
    XcdBarrier xbar; xbar.bar = (unsigned*)(ws + WS_CTL) + 1024; xbar.x = 0; xbar.st = bst; xbar.leader = false;
    if (a.coop == 2) cg::this_grid().sync();
    if (a.coop) xbar = xcd_barrier_post((unsigned*)(ws + WS_CTL) + 1024, bst, wv == 0 && lane_id() == 0);
#define IN(k) (lo <= (k) && (k) < hi)
#define SEAM(k) do { if (IN(k) && IN((k) + 1)) { if (a.coop) { xcd_barrier(xbar, wv == 0 && lane_id() == 0); } } } while (0)
    if (IN(0)) phase_prologue(a, lds, wv);
    SEAM(0);
    if (IN(1)) {
        pg8::Gemm g{(const bf16_t*)(ws + WS_H), (const bf16_t*)(ws + WS_WIN), MP, NIN, DM}; pg8::StaticOrder S; S.init(MP, NIN, G, c);
        EpiIn E{ws, a.out};
        pg8::gemm_phase<EpiIn, pg8::StaticOrder, true, true>(lds, g, S, E, wv);
        small_gemm_a4<EpiIn>(lds, g.A, g.Bt, NIN, E, wv);
    }
    SEAM(1);
    if (IN(2)) phase_attention(a, lds, wv);
    SEAM(2);
    if (IN(3)) {
        { pg8::Gemm g{(const bf16_t*)(ws + WS_OA), (const bf16_t*)(ws + WS_WPA), MP, DM, HW}; pg8::StaticOrder S; S.init(MP, DM, G, c);
          EpiProjA E{(const bf16_t*)(ws + WS_GA), (bf16_t*)(ws + WS_T)};
          pg8::gemm_phase<EpiProjA, pg8::StaticOrder, true, true>(lds, g, S, E, wv);
          small_gemm<EpiProjA>(lds, g.A, g.Bt, HW, DM, E, wv); }
        { pg8::Gemm g{(const bf16_t*)(ws + WS_OB), (const bf16_t*)(ws + WS_WPB), MP, DM, HW}; pg8::StaticOrder S; S.init(MP, DM, G, c);
          EpiProjB E{(const bf16_t*)(ws + WS_GB), (const bf16_t*)(ws + WS_T), (bf16_t*)(ws + WS_MG)};
          pg8::gemm_phase<EpiProjB, pg8::StaticOrder, true, true>(lds, g, S, E, wv);
          small_gemm<EpiProjB>(lds, g.A, g.Bt, HW, DM, E, wv); }
    }
    SEAM(3);
    if (IN(4)) {
        pg8::Gemm g{(const bf16_t*)(ws + WS_MG), (const bf16_t*)(ws + WS_WOUT), MP, DM, DM}; pg8::StaticOrder S; S.init(MP, DM, G, c);
        EpiOutNorm EN{(const float*)(ws + WS_RS1), (float*)(ws + WS_RS2), (bf16_t*)(ws + WS_H), a.in[I_G2], RowStat{(float*)(ws + WS_XB1), (unsigned*)(ws + WS_CTL) + CW_CNT1}, RowStat{(float*)(ws + WS_XB2), (unsigned*)(ws + WS_CTL) + CW_CNT2}};
        pg8::gemm_phase<EpiOutNorm, pg8::StaticOrder, false, true>(lds, g, S, EN, wv);
        __syncthreads();
        small_gemm_norm<0>(lds, g.A, g.Bt, DM, a.in[I_XS], a.out + O_Y, (float*)(ws + WS_RS2), (bf16_t*)(ws + WS_H), a.in[I_G2],
                           TailStat{(float*)(ws + WS_XT1), (unsigned*)(ws + WS_CTL) + CW_TC1}, TailStat{(float*)(ws + WS_XT2), (unsigned*)(ws + WS_CTL) + CW_TC2}, wv);
    }
    SEAM(4);
    if (IN(5)) {
        pg8::Gemm g{(const bf16_t*)(ws + WS_H), (const bf16_t*)(ws + WS_WUP), MTOK, NUP, DM}; pg8::StaticOrder S; S.init(MTOK, NUP, G, c);
        EpiUpFused E{(bf16_t*)(ws + WS_A2), a.out, a.in[I_CW], a.in[I_CB], a.in[I_CONV], (float*)(ws + WS_HEAD), (float*)(ws + WS_TAIL), (LAS float*)(lds + RING_BYTES)};
        pg8::gemm_phase<EpiUpFused, pg8::StaticOrder, true, true>(lds, g, S, E, wv);
    }
    SEAM(5);
    if (IN(6)) {
        pg8::Gemm g{(const bf16_t*)(ws + WS_A2), (const bf16_t*)(ws + WS_WDN), MP, DM, DFF}; pg8::StaticOrder S; S.init(MP, DM, G, c);
        { Unit fu; for (int i = 0; S.next(i, fu); ++i) ffn_fixup(a, fu.pm, wv * 64 + lane_id()); }
        __syncthreads();
        EpiDownNorm EN{(const bf16_t*)(ws + WS_H), (const float*)(ws + WS_RS2), a.out + O_Y, a.in[I_G4], RowStat{(float*)(ws + WS_XB3), (unsigned*)(ws + WS_CTL) + CW_CNT3}};
        pg8::gemm_phase<EpiDownNorm, pg8::StaticOrder, false, true>(lds, g, S, EN, wv);
        __syncthreads();
        small_gemm_norm<1>(lds, g.A, g.Bt, DFF, nullptr, a.out + O_Y, (float*)(ws + WS_RS2), (bf16_t*)(ws + WS_H), a.in[I_G4],
                           TailStat{(float*)(ws + WS_XT3), (unsigned*)(ws + WS_CTL) + CW_TC3}, TailStat{nullptr, nullptr}, wv);
    }
#undef IN
#undef SEAM
}

#ifndef MK_N_LAUNCHES
#define MK_N_LAUNCHES 1
#endif
extern "C" void kernel_launch(void* const* d_in, const int* in_sizes, int n_in, void* d_out, int out_size, void* d_ws, size_t ws_size, hipStream_t stream) {
    static int grid = 0;
    if (grid == 0) {
        if (n_in != 22 || (size_t)out_size != O_END || ws_size < WS_END) { fprintf(stderr, "kernel_launch: unexpected sizes n_in %d out %d ws %zu\n", n_in, out_size, ws_size); grid = -1; return; }
        int dev = 0, cus = 0, per_cu = 0;
        hipGetDevice(&dev);
        hipDeviceGetAttribute(&cus, hipDeviceAttributeMultiprocessorCount, dev);
        hipFuncSetAttribute((const void*)mega_fwd, hipFuncAttributeMaxDynamicSharedMemorySize, LDS_BYTES);
        hipOccupancyMaxActiveBlocksPerMultiprocessor(&per_cu, (const void*)mega_fwd, 512, LDS_BYTES);
        if (per_cu < 1) { fprintf(stderr, "kernel_launch: occupancy query says %d blocks/CU\n", per_cu); per_cu = 1; }
        (void)hipGetLastError();
        grid = cus;
        if (grid != 256) { fprintf(stderr, "kernel_launch: built for 256 CUs (one 256x256 unit per workgroup in the fused-norm GEMMs), device has %d\n", grid); grid = -1; return; }
    }
    if (grid < 0) return;
    hipMemsetAsync((char*)d_ws + WS_CTL, 0, CTL_BYTES, stream);
    Args a{};
    for (int i = 0; i < 22; ++i) a.in[i] = (const float*)d_in[i];
    a.out = (float*)d_out; a.ws = (unsigned char*)d_ws;
#if MK_N_LAUNCHES == 1
    a.ph_lo = 0; a.ph_hi = N_PHASES; a.coop = 1; a.pad = 0;
    void* args[] = {&a};
    hipError_t e = hipLaunchCooperativeKernel((const void*)mega_fwd, dim3(grid), dim3(512), args, LDS_BYTES, stream);
    if (e != hipSuccess) fprintf(stderr, "cooperative launch failed: %s (grid %d)\n", hipGetErrorString(e), grid);
#else
    for (int p = 0; p < N_PHASES; ++p) {
        a.ph_lo = p; a.ph_hi = p + 1; a.coop = 0; a.pad = 0;
        hipLaunchKernelGGL(mega_fwd, dim3(grid), dim3(512), LDS_BYTES, stream, a);
    }
#endif
}
```
